# Optimizing an MI355X kernel written in HIP

```python
import jax, jax.numpy as jnp
from jax import lax
import numpy as np

D_MODEL = 1024
BATCH = 1
SEQ = 16384
DEPTH = 1
DEC_BATCH = 8
DEC_SEQ = 16
PAST_LEN = 4096

CHUNK = 64
FOX_HEADS = 8
FOX_HEAD_DIM = 64
FOX_WIDTH = FOX_HEADS * FOX_HEAD_DIM
FOX_Q_BLOCK = 128
HG_HEADS = 4
HG_KEY_DIM = 128
HG_VAL_DIM = 128
HG_WIDTH = HG_HEADS * HG_KEY_DIM
D_FF = 2816
FFN_CONV_WIDTH = 3
N_BRANCHES = 2
RMS_EPS = 1e-6
NEG_INF = -1e30
IN_SIZES = [FOX_WIDTH, FOX_WIDTH, FOX_WIDTH, FOX_HEADS,
            HG_WIDTH, HG_WIDTH, HG_HEADS * HG_VAL_DIM, HG_HEADS * HG_VAL_DIM,
            D_MODEL, D_MODEL]
N_IN = sum(IN_SIZES)

kernel_name = "fox_hgrn2_convffn_stream_step"


def rmsnorm(x, gain):
    xf = x.astype(jnp.float32)
    inv = lax.rsqrt(jnp.mean(xf * xf, axis=-1, keepdims=True) + RMS_EPS)
    return (xf * inv).astype(x.dtype) * gain


def split_in(z):
    offs = np.cumsum(IN_SIZES)[:-1].tolist()
    return jnp.split(z, offs, axis=-1)


def fox_block(q, k, v, cq, ck, qpos, kpos):
    scale = q.shape[-1] ** -0.5
    logits = jnp.einsum('bqhd,bkhd->bhqk', q, k).astype(jnp.float32) * scale
    bias = jnp.transpose(cq, (0, 2, 1))[..., :, None] - jnp.transpose(ck, (0, 2, 1))[..., None, :]
    mask = kpos[None, :] <= qpos[:, None]
    logits = jnp.where(mask, logits + bias, NEG_INF)
    p = jax.nn.softmax(logits, axis=-1)
    return jnp.einsum('bhqk,bkhd->bqhd', p.astype(v.dtype), v)


def fox_prompt(q, k, v, logf):
    B, S, H, Dh = q.shape
    cum = jnp.cumsum(logf.astype(jnp.float32), axis=1)
    kpos = jnp.arange(S)

    def block(n):
        start = n * FOX_Q_BLOCK
        qb = lax.dynamic_slice_in_dim(q, start, FOX_Q_BLOCK, axis=1)
        cb = lax.dynamic_slice_in_dim(cum, start, FOX_Q_BLOCK, axis=1)
        qpos = start + jnp.arange(FOX_Q_BLOCK)
        return fox_block(qb, k, v, cb, cum, qpos, kpos)

    out = lax.map(block, jnp.arange(S // FOX_Q_BLOCK))
    return jnp.moveaxis(out, 0, 1).reshape(B, S, H, Dh)


def fox_sample(q, k, v, logf, ck, cv, clogf):
    P = ck.shape[1]
    T = q.shape[1]
    k_all = jnp.concatenate([ck.astype(k.dtype), k], axis=1)
    v_all = jnp.concatenate([cv.astype(v.dtype), v], axis=1)
    cum = jnp.cumsum(jnp.concatenate([clogf.astype(jnp.float32), logf.astype(jnp.float32)], axis=1), axis=1)
    qpos = P + jnp.arange(T)
    kpos = jnp.arange(P + T)
    return fox_block(q, k_all, v_all, cum[:, P:], cum, qpos, kpos)


def hgrn_chunk(S0, q, k, i, logf):
    T = q.shape[1]
    b = jnp.cumsum(logf, axis=1)
    causal = jnp.tril(jnp.ones((T, T), dtype=bool))
    diff = b[:, :, None] - b[:, None, :]
    decay = jnp.exp(jnp.where(causal[None, :, :, None, None], diff, -jnp.inf))
    A = jnp.einsum('bthd,bshd,btshd->bhts', q, k, decay)
    o = jnp.einsum('bhts,bshv->bthv', A, i) + jnp.einsum('bthd,bhdv->bthv', q * jnp.exp(b), S0)
    b_last = b[:, -1]
    S_new = jnp.exp(b_last)[..., None] * S0 + jnp.einsum('bshd,bshv->bhdv', k * jnp.exp(b_last[:, None] - b), i)
    return S_new, o


def hgrn_scan(S0, q, k, i, logf):
    B, T, H, dk = q.shape
    blk = CHUNK if T % CHUNK == 0 else T
    nc = T // blk

    def to_chunks(a):
        return jnp.moveaxis(a.reshape(B, nc, blk, *a.shape[2:]), 1, 0)

    S_fin, o = lax.scan(lambda s, c: hgrn_chunk(s, *c), S0,
                        (to_chunks(q), to_chunks(k), to_chunks(i), to_chunks(logf)))
    return S_fin, jnp.moveaxis(o, 0, 1).reshape(B, T, H, i.shape[-1])


def token_mixer(h, fox_ctx, S0, w_in, fox_f_bias, lb, hgrn_norm, w_bf, w_bh, w_out):
    B, T, _ = h.shape
    fq, fk, fv, ff, hq, hf, hi, hg, ga, gb = split_in(jnp.einsum('btd,dn->btn', h, w_in))
    q = fq.reshape(B, T, FOX_HEADS, FOX_HEAD_DIM)
    k = fk.reshape(B, T, FOX_HEADS, FOX_HEAD_DIM)
    v = fv.reshape(B, T, FOX_HEADS, FOX_HEAD_DIM)
    logf = jax.nn.log_sigmoid((ff + fox_f_bias).astype(jnp.float32))
    if fox_ctx is None:
        o_fox = fox_prompt(q, k, v, logf)
    else:
        o_fox = fox_sample(q, k, v, logf, *fox_ctx)
    f = lb + (1.0 - lb) * jax.nn.sigmoid(hf.astype(jnp.float32).reshape(B, T, HG_HEADS, HG_KEY_DIM))
    hq4 = hq.astype(jnp.float32).reshape(B, T, HG_HEADS, HG_KEY_DIM)
    hi4 = hi.astype(jnp.float32).reshape(B, T, HG_HEADS, HG_VAL_DIM)
    if S0 is None:
        S0 = jnp.zeros((B, HG_HEADS, HG_KEY_DIM, HG_VAL_DIM), jnp.float32)
    S_new, o_hg = hgrn_scan(S0.astype(jnp.float32), hq4, 1.0 - f, hi4, jnp.log(f))
    o_hg = rmsnorm(o_hg, hgrn_norm.astype(jnp.float32)) * jax.nn.sigmoid(
        hg.astype(jnp.float32).reshape(B, T, HG_HEADS, HG_VAL_DIM))
    br_f = jnp.einsum('btk,kd->btd', o_fox.reshape(B, T, FOX_WIDTH), w_bf)
    br_h = jnp.einsum('btk,kd->btd', o_hg.reshape(B, T, HG_HEADS * HG_VAL_DIM).astype(h.dtype), w_bh)
    merged = jax.nn.sigmoid(ga) * br_f + jax.nn.sigmoid(gb) * br_h
    out = jnp.einsum('btd,de->bte', merged, w_out)
    return out, k, v, logf, S_new


def conv_ffn(h, hist, w_up, conv_w, conv_b, w_down):
    up = jnp.einsum('btd,df->btf', h, w_up)
    a, g = jnp.split(up, 2, axis=-1)
    T = a.shape[1]
    a_pad = jnp.concatenate([hist.astype(a.dtype), a], axis=1)
    c = conv_b + sum(conv_w[j] * a_pad[:, j:j + T] for j in range(FFN_CONV_WIDTH))
    out = jnp.einsum('btf,fd->btd', jax.nn.gelu(c) * g, w_down)
    return out, a_pad[:, -(FFN_CONV_WIDTH - 1):]


def setup_inputs(seed: int = 0) -> dict:
    key = jax.random.key(seed)
    ks = jax.random.split(key, 24)
    n = jax.random.normal
    f32 = jnp.float32
    return {
        "x_prompt": n(ks[0], (BATCH, SEQ, D_MODEL), f32),
        "x_sample": n(ks[1], (DEC_BATCH, DEC_SEQ, D_MODEL), f32),
        "cache_fox_k": n(ks[2], (DEPTH, DEC_BATCH, PAST_LEN, FOX_HEADS, FOX_HEAD_DIM), f32),
        "cache_fox_v": n(ks[3], (DEPTH, DEC_BATCH, PAST_LEN, FOX_HEADS, FOX_HEAD_DIM), f32),
        "cache_fox_logf": jax.nn.log_sigmoid(3.0 + n(ks[4], (DEPTH, DEC_BATCH, PAST_LEN, FOX_HEADS), f32)),
        "state_hgrn": 0.5 * n(ks[5], (DEPTH, DEC_BATCH, HG_HEADS, HG_KEY_DIM, HG_VAL_DIM), f32),
        "state_ffn_conv": n(ks[6], (DEPTH, DEC_BATCH, FFN_CONV_WIDTH - 1, D_FF), f32),
        "norm_mix_pre": 1.0 + 0.02 * n(ks[7], (DEPTH, D_MODEL), f32),
        "norm_mix_post": 1.0 + 0.02 * n(ks[8], (DEPTH, D_MODEL), f32),
        "w_in": n(ks[9], (DEPTH, D_MODEL, N_IN), f32) * D_MODEL ** -0.5,
        "fox_f_bias": 3.0 + 0.5 * n(ks[10], (DEPTH, FOX_HEADS), f32),
        "hgrn_lb_logits": n(ks[11], (DEPTH + 1, HG_WIDTH), f32),
        "hgrn_norm": 1.0 + 0.02 * n(ks[12], (DEPTH, HG_VAL_DIM), f32),
        "w_branch_fox": n(ks[13], (DEPTH, FOX_WIDTH, D_MODEL), f32) * FOX_WIDTH ** -0.5,
        "w_branch_hgrn": n(ks[14], (DEPTH, HG_HEADS * HG_VAL_DIM, D_MODEL), f32) * (HG_HEADS * HG_VAL_DIM) ** -0.5,
        "w_out": n(ks[15], (DEPTH, D_MODEL, D_MODEL), f32) * D_MODEL ** -0.5,
        "norm_ffn_pre": 1.0 + 0.02 * n(ks[16], (DEPTH, D_MODEL), f32),
        "norm_ffn_post": 1.0 + 0.02 * n(ks[17], (DEPTH, D_MODEL), f32),
        "w_up": n(ks[18], (DEPTH, D_MODEL, 2 * D_FF), f32) * D_MODEL ** -0.5,
        "ffn_conv_w": n(ks[19], (DEPTH, FFN_CONV_WIDTH, D_FF), f32) * FFN_CONV_WIDTH ** -0.5,
        "ffn_conv_b": 0.02 * n(ks[20], (DEPTH, D_FF), f32),
        "w_down": n(ks[21], (DEPTH, D_FF, D_MODEL), f32) * D_FF ** -0.5,
    }


def reference(x_prompt, x_sample, cache_fox_k, cache_fox_v, cache_fox_logf, state_hgrn, state_ffn_conv,
              norm_mix_pre, norm_mix_post, w_in, fox_f_bias, hgrn_lb_logits, hgrn_norm,
              w_branch_fox, w_branch_hgrn, w_out, norm_ffn_pre, norm_ffn_post,
              w_up, ffn_conv_w, ffn_conv_b, w_down):
    xp, xs = x_prompt, x_sample
    lb_all = jnp.cumsum(jax.nn.softmax(hgrn_lb_logits.astype(jnp.float32), axis=0), axis=0)
    pk_l, pv_l, plf_l, ps_l, pc_l = [], [], [], [], []
    sk_l, sv_l, slf_l, ss_l, sc_l = [], [], [], [], []
    for l in range(DEPTH):
        lb = lb_all[l].reshape(HG_HEADS, HG_KEY_DIM)
        mix_w = (w_in[l], fox_f_bias[l], lb, hgrn_norm[l], w_branch_fox[l], w_branch_hgrn[l], w_out[l])
        ffn_w = (w_up[l], ffn_conv_w[l], ffn_conv_b[l], w_down[l])
        h = rmsnorm(xp, norm_mix_pre[l])
        mix, pk, pv, plf, pS = token_mixer(h, None, None, *mix_w)
        xp = xp + rmsnorm(mix, norm_mix_post[l])
        h = rmsnorm(xp, norm_ffn_pre[l])
        hist0 = jnp.zeros((xp.shape[0], FFN_CONV_WIDTH - 1, D_FF), xp.dtype)
        ff, pconv = conv_ffn(h, hist0, *ffn_w)
        xp = xp + rmsnorm(ff, norm_ffn_post[l])
        h = rmsnorm(xs, norm_mix_pre[l])
        mix, sk, sv, slf, sS = token_mixer(h, (cache_fox_k[l], cache_fox_v[l], cache_fox_logf[l]),
                                           state_hgrn[l], *mix_w)
        xs = xs + rmsnorm(mix, norm_mix_post[l])
        h = rmsnorm(xs, norm_ffn_pre[l])
        ff, sconv = conv_ffn(h, state_ffn_conv[l], *ffn_w)
        xs = xs + rmsnorm(ff, norm_ffn_post[l])
        pk_l.append(pk); pv_l.append(pv); plf_l.append(plf); ps_l.append(pS); pc_l.append(pconv)
        sk_l.append(sk); sv_l.append(sv); slf_l.append(slf); ss_l.append(sS); sc_l.append(sconv)
    p_fox_k = jnp.stack(pk_l); p_fox_v = jnp.stack(pv_l); p_fox_logf = jnp.stack(plf_l)
    p_hgrn = jnp.stack(ps_l); p_ffn_conv = jnp.stack(pc_l)
    s_fox_k = jnp.stack(sk_l); s_fox_v = jnp.stack(sv_l); s_fox_logf = jnp.stack(slf_l)
    s_hgrn = jnp.stack(ss_l); s_ffn_conv = jnp.stack(sc_l)
    return (xp, xs, p_fox_k, p_fox_v, p_fox_logf, p_hgrn, p_ffn_conv,
            s_fox_k, s_fox_v, s_fox_logf, s_hgrn, s_ffn_conv)
```

```cpp
#include <hip/hip_runtime.h>
#include <cstdio>
#include <cstdint>
namespace pg8 {
#define PG8_LAS __attribute__((address_space(3)))
typedef unsigned short bf16_t;
typedef short bf16x8 __attribute__((ext_vector_type(8)));
typedef float f32x4 __attribute__((ext_vector_type(4)));
typedef unsigned u32x4 __attribute__((ext_vector_type(4)));
constexpr int BM = 256, BK = 64, HALF = 128, HTB = HALF * BK * 2  , STAGE_BYTES = 8 * HTB, NXCD = 8, WGM = 8;

__host__ __device__ __forceinline__ int lds_byte(int r, int c) { const int st = (r >> 4) * 2 + (c >> 5), rr = r & 15, cc = c & 31, ob = rr * 64 + cc * 2; return st * 1024 + (ob ^ (((ob >> 9) & 1) << 5)); }
__host__ __device__ __forceinline__ void stage_rc(int b, int& R, int& C) { const int st = b / 1024, sb = b % 1024, swz = sb ^ (((sb >> 9) & 1) << 5); R = (st >> 1) * 16 + swz / 64; C = (st & 1) * 32 + (swz % 64) / 2; }
__host__ __device__ __forceinline__ int perm32(int rho) { const int n = rho >> 4, i = rho & 15; return 8 * (i >> 2) + 4 * n + (i & 3); }

struct Unit { int pm, pn; };
struct Gemm { const bf16_t* A; const bf16_t* Bt; int M, N, K; };

struct StaticOrder {
    int nM, nN, nwg, G, c;
    __host__ __device__ void init(int M, int N, int G_, int c_) { nM = M / BM; nN = N / BM; nwg = nM * nN; G = G_; c = c_; }
    __host__ __device__ bool next(int i, Unit& u) const {
        const long L = (long)i * G + c; if (L >= nwg) return false;
        int wgid = (int)L; { const int q = nwg / NXCD, r = nwg % NXCD, xcd = wgid % NXCD, off = wgid / NXCD; wgid = (xcd < r ? xcd * (q + 1) : r * (q + 1) + (xcd - r) * q) + off; }
        const int nig = WGM * nN, gid = wgid / nig, fm = gid * WGM, gsz = (nM - fm) < WGM ? (nM - fm) : WGM;
        u.pm = fm + ((wgid % nig) % gsz); u.pn = (wgid % nig) / gsz; return true;
    }
    __device__ __forceinline__ void a_ready(const Unit&) const {}
    __device__ __forceinline__ void done(const Unit&) const {}
};

__device__ __forceinline__ unsigned cvt_pk_bf16(float lo, float hi) { unsigned r; asm volatile("v_cvt_pk_bf16_f32 %0, %1, %2" : "=v"(r) : "v"(lo), "v"(hi)); return r; }
typedef float f32x2 __attribute__((ext_vector_type(2)));
__device__ __forceinline__ f32x2 gelu_pk(f32x2 v) {
    const f32x2 av = __builtin_elementwise_abs(v), d = av * 0.2316418882f + 1.0f;
    f32x2 t; t.x = __builtin_amdgcn_rcpf(d.x); t.y = __builtin_amdgcn_rcpf(d.y);
    f32x2 q = t * 0.5307027145f + (-0.7265760135f); q = q * t + 0.7107068705f; q = q * t + (-0.142248368f); q = q * t + 0.127414796f; q = q * t;
    const f32x2 s = (v * v) * (-0.72134752044f);
    f32x2 e; e.x = __builtin_amdgcn_exp2f(s.x); e.y = __builtin_amdgcn_exp2f(s.y);
    const f32x2 m = v * (q * e), r = v - m;
    f32x2 o; o.x = v.x < 0.f ? m.x : r.x; o.y = v.y < 0.f ? m.y : r.y; return o;
}

template <int ACT  > struct EpiBf16 {
    static constexpr bool PERM = true, AFTER_DRAIN = false; static_assert(ACT == 0 || ACT == 1, "EpiBf16: ACT is 0 (none) or 1 (gelu_pk)");
    bf16_t* O; int ldc; const float* bias; int split_cols; size_t split_stride; float scale0;
    __device__ __forceinline__ void operator()(const f32x4 (&acc)[2][2][4][2], const Unit& u, int wr, int wc, int fr, int fq) const {
        const int row0 = u.pm * BM + wr * 64 + fr; int colt = u.pn * BM; bf16_t* base = O;
        float sc = 1.f; if (split_cols) { const int t = colt / split_cols; base += (size_t)t * split_stride; colt -= t * split_cols; if (t == 0) sc = scale0; }
        const int col0 = colt + wc * 32 + 8 * fq, bcol0 = u.pn * BM + wc * 32 + 8 * fq;
        f32x4 bv[2][2];
#pragma unroll
        for (int bj = 0; bj < 2; ++bj)
#pragma unroll
            for (int n = 0; n < 2; ++n) bv[bj][n] = bias ? *(const f32x4*)(bias + bcol0 + bj * HALF + 4 * n) : (f32x4){0.f, 0.f, 0.f, 0.f};
#pragma unroll
        for (int ai = 0; ai < 2; ++ai)
#pragma unroll
            for (int m = 0; m < 4; ++m) { bf16_t* rowp = base + (size_t)(row0 + ai * HALF + m * 16) * ldc + col0;
#pragma unroll
                for (int bj = 0; bj < 2; ++bj) { f32x4 v0 = acc[ai][bj][m][0] + bv[bj][0], v1 = acc[ai][bj][m][1] + bv[bj][1];
                    if (ACT == 1) { f32x2 a = gelu_pk((f32x2){v0[0], v0[1]}), b = gelu_pk((f32x2){v0[2], v0[3]}), c = gelu_pk((f32x2){v1[0], v1[1]}), d = gelu_pk((f32x2){v1[2], v1[3]});
                        v0 = (f32x4){a.x, a.y, b.x, b.y}; v1 = (f32x4){c.x, c.y, d.x, d.y}; }
                    v0 = v0 * sc; v1 = v1 * sc; u32x4 w; w.x = cvt_pk_bf16(v0[0], v0[1]); w.y = cvt_pk_bf16(v0[2], v0[3]); w.z = cvt_pk_bf16(v1[0], v1[1]); w.w = cvt_pk_bf16(v1[2], v1[3]);
                    *(u32x4*)(rowp + bj * HALF) = w; } }
    }
};

struct PanelStats {
    unsigned* xbuf;
    unsigned* cnt;
    unsigned* tmo;
    int ntn; float eps;
    unsigned code;
    __device__ __forceinline__ bool run(const f32x4 (&v)[2][2][4][2], const Unit& u, int wr, int wc, int fr, int fq, PG8_LAS unsigned char* lds, int wid, int lane) const {
        typedef float f32x2v __attribute__((ext_vector_type(2)));
        PG8_LAS f32x2v* P = (PG8_LAS f32x2v*)lds;
        PG8_LAS f32x2v* S = (PG8_LAS f32x2v*)(lds + 8192);
        PG8_LAS unsigned* flag = (PG8_LAS unsigned*)(lds + 8192 + 2048);
#pragma unroll
        for (int ai = 0; ai < 2; ++ai)
#pragma unroll
            for (int m = 0; m < 4; ++m) {
                float s = 0.f;
#pragma unroll
                for (int bj = 0; bj < 2; ++bj)
#pragma unroll
                    for (int n = 0; n < 2; ++n) { const f32x4 x = v[ai][bj][m][n]; s += (x[0] + x[1]) + (x[2] + x[3]); }
                s += __shfl_xor(s, 16); s += __shfl_xor(s, 32);
                const float mw = s * (1.0f / 64.0f); float q = 0.f;
#pragma unroll
                for (int bj = 0; bj < 2; ++bj)
#pragma unroll
                    for (int n = 0; n < 2; ++n) { const f32x4 d = v[ai][bj][m][n] - mw; q += (d[0] * d[0] + d[1] * d[1]) + (d[2] * d[2] + d[3] * d[3]); }
                q += __shfl_xor(q, 16); q += __shfl_xor(q, 32);
                if (fq == 0) P[(ai * HALF + wr * 64 + m * 16 + fr) * 4 + wc] = (f32x2v){mw, q};
            }
        asm volatile("s_waitcnt lgkmcnt(0)" ::: "memory"); __builtin_amdgcn_s_barrier(); asm volatile("" ::: "memory");
#if defined(BROKEN_EXCHANGE_NO_WAIT)
#warning BROKEN CONTROL BUILD: the row-statistics exchange does not wait; results are wrong by design
        if (blockIdx.x >= 64) { const long long t0_ = clock64(); while (clock64() - t0_ < 60000) __builtin_amdgcn_s_sleep(8); }
#endif
        const int row = wid * 32 + (lane & 31);
        if (lane < 32) {
            const f32x2v a = P[row * 4 + 0], b = P[row * 4 + 1], c = P[row * 4 + 2], d = P[row * 4 + 3];
            const float mt = (a.x + b.x + c.x + d.x) * 0.25f;
            const float da = a.x - mt, db = b.x - mt, dc = c.x - mt, dd = d.x - mt;
            const float m2 = (a.y + b.y) + (c.y + d.y) + 64.0f * ((da * da + db * db) + (dc * dc + dd * dd));
            unsigned long long* slot = (unsigned long long*)xbuf + ((size_t)(u.pm * BM + row) * 4 + u.pn);
            __hip_atomic_store(slot, ((unsigned long long)__float_as_uint(m2) << 32) | __float_as_uint(mt), __ATOMIC_RELAXED, __HIP_MEMORY_SCOPE_AGENT);
        }
        asm volatile("s_waitcnt vmcnt(0)" ::: "memory");
        if (lane == 0) __hip_atomic_fetch_add(cnt + 64 * u.pm, 1u, __ATOMIC_RELAXED, __HIP_MEMORY_SCOPE_AGENT);
        if (wid == 0) {
            bool dead = false; const unsigned long long t0 = __builtin_amdgcn_s_memrealtime(); const unsigned want = 8u * (unsigned)ntn;
            for (;;) {
#if defined(BROKEN_EXCHANGE_NO_WAIT)
                break;
#endif
                if ((unsigned)__builtin_amdgcn_readfirstlane(__hip_atomic_load(cnt + 64 * u.pm, __ATOMIC_RELAXED, __HIP_MEMORY_SCOPE_AGENT)) >= want) break;
                if (__builtin_amdgcn_s_memrealtime() - t0 > 2000000ull) {
                    if (lane == 0) { unsigned expect = 0u; __hip_atomic_compare_exchange_strong(tmo + 1, &expect, code | (unsigned)(u.pm & 0xff), __ATOMIC_RELAXED, __ATOMIC_RELAXED, __HIP_MEMORY_SCOPE_AGENT);
                                     __hip_atomic_store(tmo, 1u, __ATOMIC_RELAXED, __HIP_MEMORY_SCOPE_AGENT); }
                    dead = true; break; }
                __builtin_amdgcn_s_sleep(2);
            }
            __builtin_amdgcn_fence(__ATOMIC_ACQUIRE, "agent");
            if (lane == 0) flag[0] = dead ? 1u : 0u;
        }
        asm volatile("s_waitcnt vmcnt(0) lgkmcnt(0)" ::: "memory"); __builtin_amdgcn_s_barrier(); asm volatile("" ::: "memory");
        const bool bad = flag[0] != 0u;
        if (lane < 32) {
            const unsigned long long* slot = (const unsigned long long*)xbuf + (size_t)(u.pm * BM + row) * 4; float mt[4], m2[4]; float ms = 0.f;
#pragma unroll
            for (int t = 0; t < 4; ++t) { if (t < ntn) { const unsigned long long w = __hip_atomic_load(slot + t, __ATOMIC_RELAXED, __HIP_MEMORY_SCOPE_AGENT); mt[t] = __uint_as_float((unsigned)w); m2[t] = __uint_as_float((unsigned)(w >> 32)); } else { mt[t] = 0.f; m2[t] = 0.f; } ms += mt[t]; }
            const float mean = ms / (float)ntn; float q = 0.f;
#pragma unroll
            for (int t = 0; t < 4; ++t) if (t < ntn) { const float dm = mt[t] - mean; q += m2[t] + 256.0f * dm * dm; }
            S[row] = (f32x2v){mean, 1.0f / sqrtf(q / (256.0f * (float)ntn) + eps)};
        }
        asm volatile("s_waitcnt lgkmcnt(0)" ::: "memory"); __builtin_amdgcn_s_barrier(); asm volatile("" ::: "memory");
        return bad;
    }
};
struct EpiLnRes {
    static constexpr bool PERM = false, AFTER_DRAIN = true;
    const float* base; float* out; int ldc; const float* bias; PanelStats st; unsigned poison;
    __device__ __forceinline__ void fused(f32x4 (&acc)[2][2][4][2], const Unit& u, int wr, int wc, int fr, int fq, PG8_LAS unsigned char* lds, int wid, int lane) const {
        typedef float f32x2v __attribute__((ext_vector_type(2)));
        const PG8_LAS f32x2v* S = (const PG8_LAS f32x2v*)(lds + 8192);
        const int col0 = u.pn * BM + wc * 32 + 4 * fq;
#pragma unroll
        for (int bj = 0; bj < 2; ++bj)
#pragma unroll
            for (int n = 0; n < 2; ++n) { const f32x4 bv = bias ? *(const f32x4*)(bias + col0 + bj * HALF + n * 16) : (f32x4){0.f, 0.f, 0.f, 0.f};
#pragma unroll
                for (int ai = 0; ai < 2; ++ai)
#pragma unroll
                    for (int m = 0; m < 4; ++m) acc[ai][bj][m][n] += bv; }
        f32x4 pre[4][2][2];
#pragma unroll
        for (int m = 0; m < 4; ++m) { const size_t off = (size_t)(u.pm * BM + wr * 64 + m * 16 + fr) * ldc + col0;
#pragma unroll
            for (int bj = 0; bj < 2; ++bj)
#pragma unroll
                for (int n = 0; n < 2; ++n) pre[m][bj][n] = *(const f32x4*)(base + off + bj * HALF + n * 16); }
        const bool bad = st.run(acc, u, wr, wc, fr, fq, lds, wid, lane) || poison != 0u;
        const float qnan = __builtin_nanf("");
#pragma unroll
        for (int ai = 0; ai < 2; ++ai)
#pragma unroll
            for (int m = 0; m < 4; ++m) { const int r = ai * HALF + wr * 64 + m * 16 + fr; const f32x2v sr = S[r]; const size_t off = (size_t)(u.pm * BM + r) * ldc + col0;
#pragma unroll
                for (int bj = 0; bj < 2; ++bj)
#pragma unroll
                    for (int n = 0; n < 2; ++n) { const f32x4 bs = ai == 0 ? pre[m][bj][n] : *(const f32x4*)(base + off + bj * HALF + n * 16); f32x4 o = bs + (acc[ai][bj][m][n] - sr.x) * sr.y;
                        if (bad) o = (f32x4){qnan, qnan, qnan, qnan}; *(f32x4*)(out + off + bj * HALF + n * 16) = o; }
                if (m & 1) asm volatile("" ::: "memory"); }
    }
};
struct EpiLnResLn {
    static constexpr bool PERM = false, AFTER_DRAIN = true;
    const float* base; float* out; bf16_t* xn; int ldc; const float* bias; PanelStats st1, st2; unsigned poison;
    __device__ __forceinline__ void fused(f32x4 (&acc)[2][2][4][2], const Unit& u, int wr, int wc, int fr, int fq, PG8_LAS unsigned char* lds, int wid, int lane) const {
        typedef float f32x2v __attribute__((ext_vector_type(2))); typedef unsigned u32x2v __attribute__((ext_vector_type(2)));
        const PG8_LAS f32x2v* S = (const PG8_LAS f32x2v*)(lds + 8192);
        const int col0 = u.pn * BM + wc * 32 + 4 * fq;
#pragma unroll
        for (int bj = 0; bj < 2; ++bj)
#pragma unroll
            for (int n = 0; n < 2; ++n) { const f32x4 bv = bias ? *(const f32x4*)(bias + col0 + bj * HALF + n * 16) : (f32x4){0.f, 0.f, 0.f, 0.f};
#pragma unroll
                for (int ai = 0; ai < 2; ++ai)
#pragma unroll
                    for (int m = 0; m < 4; ++m) acc[ai][bj][m][n] += bv; }
        bool bad = st1.run(acc, u, wr, wc, fr, fq, lds, wid, lane) || poison != 0u;
        const float qnan = __builtin_nanf("");
#pragma unroll
        for (int ai = 0; ai < 2; ++ai)
#pragma unroll
            for (int m = 0; m < 4; ++m) { const int r = ai * HALF + wr * 64 + m * 16 + fr; const f32x2v sr = S[r]; const size_t off = (size_t)(u.pm * BM + r) * ldc + col0;
#pragma unroll
                for (int bj = 0; bj < 2; ++bj)
#pragma unroll
                    for (int n = 0; n < 2; ++n) { const f32x4 bs = *(const f32x4*)(base + off + bj * HALF + n * 16); acc[ai][bj][m][n] = bs + (acc[ai][bj][m][n] - sr.x) * sr.y; }
                asm volatile("" : "+v"(acc[ai][0][m][0]), "+v"(acc[ai][0][m][1]), "+v"(acc[ai][1][m][0]), "+v"(acc[ai][1][m][1]));
                if (m & 1) asm volatile("" ::: "memory"); }
        const bool bad1 = bad;
        bad = st2.run(acc, u, wr, wc, fr, fq, lds, wid, lane) || bad;
#pragma unroll
        for (int ai = 0; ai < 2; ++ai)
#pragma unroll
            for (int m = 0; m < 4; ++m) { const int r = ai * HALF + wr * 64 + m * 16 + fr; const f32x2v sr = S[r]; const size_t off = (size_t)(u.pm * BM + r) * ldc + col0;
#pragma unroll
                for (int bj = 0; bj < 2; ++bj)
#pragma unroll
                    for (int n = 0; n < 2; ++n) { const f32x4 x1 = acc[ai][bj][m][n]; *(f32x4*)(out + off + bj * HALF + n * 16) = bad1 ? (f32x4){qnan, qnan, qnan, qnan} : x1;
                        const f32x4 o = (x1 - sr.x) * sr.y; u32x2v w; w.x = cvt_pk_bf16(o[0], o[1]); w.y = cvt_pk_bf16(o[2], o[3]);
                        if (bad) { w.x = 0x7fc07fc0u; w.y = 0x7fc07fc0u; } *(u32x2v*)(xn + off + bj * HALF + n * 16) = w; }
                asm volatile("" ::: "memory"); }
    }
};

template <class Epi, class Sched, bool ALIGN_EPI = false, bool SP2 = false>
__device__ __forceinline__ void gemm_phase(PG8_LAS unsigned char* lds, const Gemm g, const Sched& S, const Epi& E) {
    const int tid = threadIdx.x, wid = __builtin_amdgcn_readfirstlane(tid >> 6), lane = tid & 63, wr = wid >> 2, wc = wid & 3, fr = lane & 15, fq = lane >> 4;
    const int K = g.K, nt = K / BK;
    unsigned voffA[2], voffB[2];
#pragma unroll
    for (int i = 0; i < 2; ++i) { int R, C; stage_rc(tid * 16 + i * 8192, R, C); const int Rb = Epi::PERM ? ((R & ~31) + perm32(R & 31)) : R;
        voffA[i] = (unsigned)(R * K + C) * 2u; voffB[i] = (unsigned)(Rb * K + C) * 2u; }
    const size_t kstep = (size_t)(BK * 2);
    const size_t hstep = (size_t)HALF * K * 2;
    const size_t tstep = 2 * hstep;
    const unsigned ldsw = (unsigned)wid * 1024u;
    const int aoff = lds_byte(wr * 64 + fr, fq * 8), boff = lds_byte(wc * 32 + fr, fq * 8);
#define PG8_SA(b, h) (((b) * 2 + (h)) * HTB)
#define PG8_SB(b, h) ((4 + (b) * 2 + (h)) * HTB)
#define PG8_STAGE(bufoff, gbase, voff) do { _Pragma("unroll") for (int _i = 0; _i < 2; ++_i) \
        __builtin_amdgcn_global_load_lds((const unsigned*)((const char*)(gbase) + (voff)[_i]), (PG8_LAS unsigned*)(lds + (bufoff) + ldsw + _i * 8192), 16, 0, 0); } while (0)
#define PG8_LDA(dst, b, h) do { _Pragma("unroll") for (int m = 0; m < 4; ++m) _Pragma("unroll") for (int k = 0; k < 2; ++k) dst[m][k] = *(const PG8_LAS bf16x8*)(lds + PG8_SA(b, h) + aoff + m * 2048 + k * 1024); } while (0)
#define PG8_LDB(dst, b, h) do { _Pragma("unroll") for (int n = 0; n < 2; ++n) _Pragma("unroll") for (int k = 0; k < 2; ++k) dst[n][k] = *(const PG8_LAS bf16x8*)(lds + PG8_SB(b, h) + boff + n * 2048 + k * 1024); } while (0)
#define PG8_MMA(ai, bj, At, Bt) do { __builtin_amdgcn_s_setprio(1); _Pragma("unroll") for (int m = 0; m < 4; ++m) _Pragma("unroll") for (int n = 0; n < 2; ++n) _Pragma("unroll") for (int k = 0; k < 2; ++k) \
        acc[ai][bj][m][n] = __builtin_amdgcn_mfma_f32_16x16x32_bf16(Bt[n][k], At[m][k], acc[ai][bj][m][n], 0, 0, 0); __builtin_amdgcn_s_setprio(0); } while (0)
#define PG8_WAIT_V(n) asm volatile("s_waitcnt vmcnt(" #n ")" ::: "memory")
#define PG8_WAIT_L(n) asm volatile("s_waitcnt lgkmcnt(" #n ")" ::: "memory")
#define PG8_BAR __builtin_amdgcn_s_barrier()
#define PG8_SCHED __builtin_amdgcn_sched_barrier(0)
    Unit cur, nxt; int ui = 0;
    if (!S.next(0, cur)) return;
    f32x4 acc[2][2][4][2];
#pragma unroll
    for (int a = 0; a < 2; ++a)
#pragma unroll
        for (int b = 0; b < 2; ++b)
#pragma unroll
            for (int m = 0; m < 4; ++m)
#pragma unroll
                for (int n = 0; n < 2; ++n) acc[a][b][m][n] = (f32x4){0.f, 0.f, 0.f, 0.f};
    bf16x8 At[4][2], B0[2][2], B1[2][2];
    const char* cA = (const char*)g.A + (size_t)cur.pm * tstep; const char* cB = (const char*)g.Bt + (size_t)cur.pn * tstep;
    S.a_ready(cur);
    if constexpr (SP2) {
        PG8_STAGE(PG8_SB(0, 0), cB, voffB); PG8_STAGE(PG8_SB(0, 1), cB + hstep, voffB); PG8_STAGE(PG8_SA(0, 0), cA, voffA); PG8_STAGE(PG8_SA(0, 1), cA + hstep, voffA);
        if (wr == 1) PG8_BAR;
        PG8_WAIT_V(2); PG8_BAR;
        PG8_STAGE(PG8_SB(1, 0), cB + kstep, voffB); PG8_STAGE(PG8_SA(1, 0), cA + kstep, voffA); PG8_STAGE(PG8_SB(1, 1), cB + hstep + kstep, voffB);
        PG8_WAIT_V(6); PG8_BAR;
    } else {
        PG8_STAGE(PG8_SB(0, 0), cB, voffB); PG8_STAGE(PG8_SA(0, 0), cA, voffA); PG8_STAGE(PG8_SB(0, 1), cB + hstep, voffB); PG8_STAGE(PG8_SA(0, 1), cA + hstep, voffA);
        if (wr == 1) PG8_BAR;
        PG8_WAIT_V(4); PG8_BAR;
        PG8_STAGE(PG8_SB(1, 0), cB + kstep, voffB); PG8_STAGE(PG8_SA(1, 0), cA + kstep, voffA); PG8_STAGE(PG8_SB(1, 1), cB + hstep + kstep, voffB);
        PG8_WAIT_V(6); PG8_BAR;
    }
    for (;;) {
        const bool has_next = S.next(ui + 1, nxt);
        const char* nA = has_next ? (const char*)g.A + (size_t)nxt.pm * tstep : cA; const char* nB = has_next ? (const char*)g.Bt + (size_t)nxt.pn * tstep : cB;
        for (int t = 0; t < nt; t += 2) {
            const bool last = (t == nt - 2);
            const char* a1 = cA + (size_t)(t + 1) * kstep;
            const char* a2 = last ? nA : cA + (size_t)(t + 2) * kstep; const char* b2 = last ? nB : cB + (size_t)(t + 2) * kstep;
            const char* a3 = a2 + kstep; const char* b3 = b2 + kstep;
            if (last && has_next) S.a_ready(nxt);
            if constexpr (SP2) {
            PG8_LDB(B0, 0, 0); PG8_LDB(B1, 0, 1); PG8_SCHED; PG8_LDA(At, 0, 0); PG8_STAGE(PG8_SA(1, 1), a1 + hstep, voffA);
            PG8_WAIT_V(8); PG8_WAIT_L(0); PG8_BAR; PG8_MMA(0, 0, At, B0); PG8_MMA(0, 1, At, B1); PG8_BAR; PG8_SCHED;
            PG8_LDA(At, 0, 1); PG8_STAGE(PG8_SB(0, 0), b2, voffB); PG8_STAGE(PG8_SB(0, 1), b2 + hstep, voffB); PG8_STAGE(PG8_SA(0, 0), a2, voffA);
            PG8_WAIT_V(8); PG8_WAIT_L(0); PG8_BAR; PG8_MMA(1, 0, At, B0); PG8_MMA(1, 1, At, B1); PG8_BAR; PG8_SCHED;
            PG8_LDB(B0, 1, 0); PG8_LDB(B1, 1, 1); PG8_SCHED; PG8_LDA(At, 1, 0); PG8_STAGE(PG8_SA(0, 1), a2 + hstep, voffA);
            PG8_WAIT_V(8); PG8_WAIT_L(0); PG8_BAR; PG8_MMA(0, 0, At, B0); PG8_MMA(0, 1, At, B1); PG8_BAR; PG8_SCHED;
            PG8_LDA(At, 1, 1); PG8_STAGE(PG8_SB(1, 0), b3, voffB); PG8_STAGE(PG8_SB(1, 1), b3 + hstep, voffB); PG8_STAGE(PG8_SA(1, 0), a3, voffA);
            PG8_WAIT_V(8); PG8_WAIT_L(0); PG8_BAR; PG8_MMA(1, 0, At, B0); PG8_MMA(1, 1, At, B1); PG8_BAR; PG8_SCHED;
            } else {
            PG8_LDB(B0, 0, 0); PG8_SCHED; PG8_LDA(At, 0, 0); PG8_STAGE(PG8_SA(1, 1), a1 + hstep, voffA);
            PG8_WAIT_L(8); PG8_BAR; PG8_WAIT_L(0); PG8_MMA(0, 0, At, B0); PG8_BAR; PG8_SCHED;
            PG8_LDB(B1, 0, 1); PG8_STAGE(PG8_SB(0, 0), b2, voffB);
            PG8_BAR; PG8_WAIT_L(0); PG8_MMA(0, 1, At, B1); PG8_BAR;
            PG8_LDA(At, 0, 1); PG8_STAGE(PG8_SA(0, 0), a2, voffA);
            PG8_BAR; PG8_WAIT_L(0); PG8_MMA(1, 0, At, B0); PG8_BAR; PG8_SCHED;
            PG8_STAGE(PG8_SB(0, 1), b2 + hstep, voffB);
            PG8_WAIT_V(6); PG8_BAR; PG8_MMA(1, 1, At, B1); PG8_BAR;
            PG8_LDB(B0, 1, 0); PG8_SCHED; PG8_LDA(At, 1, 0); PG8_STAGE(PG8_SA(0, 1), a2 + hstep, voffA);
            PG8_WAIT_L(8); PG8_BAR; PG8_WAIT_L(0); PG8_MMA(0, 0, At, B0); PG8_BAR; PG8_SCHED;
            PG8_LDB(B1, 1, 1); PG8_STAGE(PG8_SB(1, 0), b3, voffB);
            PG8_BAR; PG8_WAIT_L(0); PG8_MMA(0, 1, At, B1); PG8_BAR;
            PG8_LDA(At, 1, 1); PG8_STAGE(PG8_SA(1, 0), a3, voffA);
            PG8_BAR; PG8_WAIT_L(0); PG8_MMA(1, 0, At, B0); PG8_BAR; PG8_SCHED;
            PG8_STAGE(PG8_SB(1, 1), b3 + hstep, voffB);
            PG8_WAIT_V(6); PG8_BAR; PG8_MMA(1, 1, At, B1); PG8_BAR;
            }
        }
        if constexpr (ALIGN_EPI) { if (wr == 0) PG8_BAR; }
        if constexpr (!Epi::AFTER_DRAIN) { E(acc, cur, wr, wc, fr, fq); S.done(cur); }
        if (!has_next) break;
#pragma unroll
        for (int a = 0; a < 2; ++a)
#pragma unroll
            for (int b = 0; b < 2; ++b)
#pragma unroll
                for (int m = 0; m < 4; ++m)
#pragma unroll
                    for (int n = 0; n < 2; ++n) acc[a][b][m][n] = (f32x4){0.f, 0.f, 0.f, 0.f};
        cur = nxt; cA = nA; cB = nB; ++ui;
        if constexpr (ALIGN_EPI) { if (wr == 1) PG8_BAR; }
    }
    PG8_WAIT_V(0);
    if constexpr (!ALIGN_EPI) { if (wr == 0) PG8_BAR; }
    PG8_BAR;
    if constexpr (Epi::AFTER_DRAIN) { E.fused(acc, cur, wr, wc, fr, fq, lds, wid, lane); S.done(cur); }
#undef PG8_SA
#undef PG8_SB
#undef PG8_STAGE
#undef PG8_LDA
#undef PG8_LDB
#undef PG8_MMA
#undef PG8_WAIT_V
#undef PG8_WAIT_L
#undef PG8_BAR
#undef PG8_SCHED
}
}

namespace pg8 {
__device__ __forceinline__ float sigm(float x) { return 1.0f / (1.0f + __expf(-x)); }
__device__ __forceinline__ u32x4 pack8(const f32x4 a, const f32x4 b) { u32x4 w; w.x = cvt_pk_bf16(a[0], a[1]); w.y = cvt_pk_bf16(a[2], a[3]); w.z = cvt_pk_bf16(b[0], b[1]); w.w = cvt_pk_bf16(b[2], b[3]); return w; }

struct EpiF32 {
    static constexpr bool PERM = false, AFTER_DRAIN = false;
    float* C; int ldc;
    __device__ __forceinline__ void operator()(const f32x4 (&acc)[2][2][4][2], const Unit& u, int wr, int wc, int fr, int fq) const {
        const int row0 = u.pm * BM + wr * 64 + fr, col0 = u.pn * BM + wc * 32 + 4 * fq;
#pragma unroll
        for (int ai = 0; ai < 2; ++ai)
#pragma unroll
            for (int m = 0; m < 4; ++m) { float* rowp = C + (size_t)(row0 + ai * HALF + m * 16) * ldc + col0;
#pragma unroll
                for (int bj = 0; bj < 2; ++bj)
#pragma unroll
                    for (int n = 0; n < 2; ++n) *(f32x4*)(rowp + bj * HALF + n * 16) = acc[ai][bj][m][n]; }
    }
};

constexpr int MPROMPT = 16384;
struct EpiIn {
    static constexpr bool PERM = true, AFTER_DRAIN = false;
    bf16_t *Q, *K, *V, *HQ, *KK, *HI, *HG; float* LF; bf16_t *GA, *GB, *GAs, *GBs; float *okp, *ovp, *oks, *ovs; const float* lb; float qscale;
    template <int TYPE> __device__ __forceinline__ void tile(const f32x4 (&acc)[2][2][4][2], const Unit& u, int ct, int wr, int wc, int fr, int fq) const {
        const bool samp = (u.pm == MPROMPT / BM);
        const int colb = ct * BM + wc * 32 + 8 * fq;
        f32x4 lbv[2][2];
        if (TYPE == 4) {
#pragma unroll
            for (int bj = 0; bj < 2; ++bj) { lbv[bj][0] = *(const f32x4*)(lb + colb + bj * HALF); lbv[bj][1] = *(const f32x4*)(lb + colb + bj * HALF + 4); }
        }
#pragma unroll
        for (int ai = 0; ai < 2; ++ai)
#pragma unroll
            for (int m = 0; m < 4; ++m) {
                const int row = u.pm * BM + ai * HALF + wr * 64 + m * 16 + fr; const int lrow = row - MPROMPT;
#pragma unroll
                for (int bj = 0; bj < 2; ++bj) {
                    const int col = colb + bj * HALF; f32x4 v0 = acc[ai][bj][m][0], v1 = acc[ai][bj][m][1];
                    if (TYPE == 0) { *(u32x4*)(Q + (size_t)row * 512 + col) = pack8(v0 * qscale, v1 * qscale); }
                    else if (TYPE == 1 || TYPE == 2) {
                        bf16_t* B = TYPE == 1 ? K : V; *(u32x4*)(B + (size_t)row * 512 + col) = pack8(v0, v1);
                        float* o = nullptr;
                        if (!samp) o = (TYPE == 1 ? okp : ovp) + (size_t)row * 512 + col; else if (lrow < 128) o = (TYPE == 1 ? oks : ovs) + (size_t)lrow * 512 + col;
                        if (o) { *(f32x4*)o = v0; *(f32x4*)(o + 4) = v1; }
                    }
                    else if (TYPE == 3) { *(u32x4*)(HQ + (size_t)row * 512 + col) = pack8(v0, v1); }
                    else if (TYPE == 4) {
                        f32x4 f0, f1, l0, l1;
#pragma unroll
                        for (int j = 0; j < 4; ++j) { const float a = lbv[bj][0][j], b = lbv[bj][1][j];
                            f0[j] = a + (1.0f - a) * sigm(v0[j]); f1[j] = b + (1.0f - b) * sigm(v1[j]); l0[j] = __logf(f0[j]); l1[j] = __logf(f1[j]); }
                        float* lp = LF + (size_t)row * 512 + col; *(f32x4*)lp = l0; *(f32x4*)(lp + 4) = l1;
                        *(u32x4*)(KK + (size_t)row * 512 + col) = pack8(1.0f - f0, 1.0f - f1);
                    }
                    else if (TYPE == 5) { *(u32x4*)(HI + (size_t)row * 512 + col) = pack8(v0, v1); }
                    else {
                        f32x4 s0, s1;
#pragma unroll
                        for (int j = 0; j < 4; ++j) { s0[j] = sigm(v0[j]); s1[j] = sigm(v1[j]); }
                        if (TYPE == 6) *(u32x4*)(HG + (size_t)row * 512 + col) = pack8(s0, s1);
                        else { bf16_t* G = samp ? ((TYPE == 7 ? GAs : GBs) + (size_t)lrow * 1024) : ((TYPE == 7 ? GA : GB) + (size_t)row * 1024); *(u32x4*)(G + col) = pack8(s0, s1); }
                    }
                }
            }
    }
    __device__ __forceinline__ void operator()(const f32x4 (&acc)[2][2][4][2], const Unit& u, int wr, int wc, int fr, int fq) const {
        const int pn = u.pn;
        if (pn < 14) { const int ct = pn & 1;
            switch (pn >> 1) { case 0: tile<0>(acc, u, ct, wr, wc, fr, fq); break; case 1: tile<1>(acc, u, ct, wr, wc, fr, fq); break; case 2: tile<2>(acc, u, ct, wr, wc, fr, fq); break;
                               case 3: tile<3>(acc, u, ct, wr, wc, fr, fq); break; case 4: tile<4>(acc, u, ct, wr, wc, fr, fq); break; case 5: tile<5>(acc, u, ct, wr, wc, fr, fq); break;
                               default: tile<6>(acc, u, ct, wr, wc, fr, fq); break; } }
        else if (pn < 18) tile<7>(acc, u, pn - 14, wr, wc, fr, fq);
        else tile<8>(acc, u, pn - 18, wr, wc, fr, fq);
    }
};

constexpr int DFF = 2816;
struct EpiUpSplit {
    static constexpr bool PERM = true, AFTER_DRAIN = false;
    bf16_t *A, *G; float *cp, *cs;
    __device__ __forceinline__ void operator()(const f32x4 (&acc)[2][2][4][2], const Unit& u, int wr, int wc, int fr, int fq) const {
        const int cidx = 128 * u.pn + wc * 32 + 8 * fq;
#pragma unroll
        for (int ai = 0; ai < 2; ++ai)
#pragma unroll
            for (int m = 0; m < 4; ++m) {
                const int row = u.pm * BM + ai * HALF + wr * 64 + m * 16 + fr; const int lrow = row - MPROMPT;
                *(u32x4*)(A + (size_t)row * DFF + cidx) = pack8(acc[ai][0][m][0], acc[ai][0][m][1]);
                *(u32x4*)(G + (size_t)row * DFF + cidx) = pack8(acc[ai][1][m][0], acc[ai][1][m][1]);
                float* o = nullptr;
                if (row == MPROMPT - 2 || row == MPROMPT - 1) o = cp + (size_t)(row - (MPROMPT - 2)) * DFF + cidx;
                else if (lrow >= 0 && lrow < 128 && (lrow & 15) >= 14) o = cs + (size_t)((lrow >> 4) * 2 + ((lrow & 15) - 14)) * DFF + cidx;
                if (o) { *(f32x4*)o = acc[ai][0][m][0]; *(f32x4*)(o + 4) = acc[ai][0][m][1]; }
            }
    }
};
}

constexpr int NWAVES = 8, NTHR = 512;
constexpr int DMODEL = 1024, MP = 16384, MS = 128, MTOT = MP + MS, MPAD = 16640;
constexpr int FW = 512, NINP = 5632, NIN = 5640, DFF = 2816, PAST = 4096, SKS = 4112;
constexpr float RMS_EPS = 1e-6f, LOG2E = 1.4426950408889634f, C2 = 0.125f * 1.4426950408889634f;
constexpr size_t OFF_Y = 0, OFF_YS = 16777216, OFF_PK = 16908288, OFF_PV = 25296896, OFF_PLF = 33685504, OFF_PH = 33816576, OFF_PC = 33882112,
                 OFF_SK = 33887744, OFF_SV = 33953280, OFF_SLF = 34018816, OFF_SH = 34019840, OFF_SC = 34544128, OUT_TOTAL = 34589184;
constexpr size_t MiB = 1u << 20;
constexpr size_t SZ512 = (size_t)MPAD * 512 * 2, SZ1024 = (size_t)MPAD * 1024 * 2;
constexpr size_t WS_CTL = 0, CTL_ZERO_BYTES = 1 * MiB;
constexpr size_t WS_LB = 1 * MiB, WS_KB = WS_LB + 65536, WS_SKB = WS_KB + 524288;
constexpr size_t WS_GAS = 3 * MiB, WS_GBS = WS_GAS + 524288;
constexpr size_t WS_WIN = 4 * MiB, WS_WBF = 15 * MiB, WS_WBH = 16 * MiB, WS_WOUT = 17 * MiB, WS_WUP = 19 * MiB, WS_WDN = 30 * MiB;
constexpr size_t WS_H1 = 36 * MiB;
constexpr size_t WS_Q = WS_H1 + SZ1024, WS_OH = WS_Q + SZ512, WS_K = WS_OH + SZ512, WS_V = WS_K + SZ512, WS_HQ = WS_V + SZ512, WS_KK = WS_HQ + SZ512,
                 WS_HI = WS_KK + SZ512, WS_HG = WS_HI + SZ512, WS_LF = WS_HG + SZ512, WS_END1 = WS_LF + 2 * SZ512;
constexpr size_t WS_BRF = WS_K, WS_BRH = WS_K + 4 * SZ512, WS_MERGED = WS_H1, WS_MIX = WS_K, WS_H2 = WS_H1;
constexpr size_t WS_ABUF = WS_Q, WS_GBUF = WS_ABUF + (size_t)MPAD * DFF * 2, WS_FFN = WS_Q, WS_END = WS_GBUF + (size_t)MPAD * DFF * 2;
static_assert(WS_END <= 256 * MiB && WS_END1 <= 256 * MiB, "d_ws map");
constexpr int CW_TMO = 0, CW_CODE = 1, CW_BAR = 4096;
constexpr int RING_OFF = 0, RING_BYTES = 131072, LDSCTL_OFF = RING_BYTES, MISC_OFF = LDSCTL_OFF + 320, LDS_BYTES = 147456;

#define GAS __attribute__((address_space(1)))
#define LAS __attribute__((address_space(3)))
typedef unsigned short bf16;
typedef unsigned v4u __attribute__((ext_vector_type(4)));
typedef float f32x4 __attribute__((ext_vector_type(4)));
typedef short bf16x8 __attribute__((ext_vector_type(8)));
typedef GAS unsigned gu32;
typedef GAS unsigned long long gu64;
#define RLX_AGENT __ATOMIC_RELAXED, __HIP_MEMORY_SCOPE_AGENT
#define LDS_WAIT() asm volatile("s_waitcnt lgkmcnt(0)" ::: "memory")
#define VM_WAIT() asm volatile("s_waitcnt vmcnt(0)" ::: "memory")
__device__ __forceinline__ unsigned long long rt() { return __builtin_amdgcn_s_memrealtime(); }
__device__ __forceinline__ unsigned f2bf(float f) { unsigned u = __builtin_bit_cast(unsigned, f); return (u + 0x7fffu + ((u >> 16) & 1u)) >> 16; }
__device__ __forceinline__ unsigned pk2(float lo, float hi) { return f2bf(lo) | (f2bf(hi) << 16); }

#define XB_TMO      128
#define XB_XCNT(j)  (256  + 64 * (j))
#define XB_XSUB(j)  (1280 + 64 * (j))
#define XB_XGEN(j)  (2304 + 64 * (j))
#define XB_TOP      3328
#define XB_TOPGEN   3392
#define XCD_BAR_WORDS 3456
#define XB_SPIN_CAP (1u << 18)

__device__ __forceinline__ unsigned xb_ld(unsigned* p)              { return __hip_atomic_load(p, __ATOMIC_RELAXED, __HIP_MEMORY_SCOPE_AGENT); }
__device__ __forceinline__ unsigned xb_add(unsigned* p, unsigned v) { return __hip_atomic_fetch_add(p, v, __ATOMIC_RELAXED, __HIP_MEMORY_SCOPE_AGENT); }
__device__ __forceinline__ unsigned xb_xcc_id() { return (unsigned)__builtin_amdgcn_s_getreg((3 << 11) | 20) & 0xFu; }
#define XB_SPIN(cond, bar) do { unsigned _sp = 0; while (cond) { __builtin_amdgcn_s_sleep(1); \
    if ((++_sp & 255u) == 0u) { if (xb_ld(&(bar)[XB_TMO])) break; if (_sp > XB_SPIN_CAP) { atomicAdd(&(bar)[XB_TMO], 1u); break; } } } } while (0)

struct XcdBarrier {
    unsigned* bar; unsigned x;
    volatile LAS unsigned* st;
};

__device__ __forceinline__ XcdBarrier xcd_barrier_post(unsigned* bar, volatile LAS unsigned* st) {
    XcdBarrier b; b.bar = bar; b.x = xb_xcc_id(); b.st = st;
    if (threadIdx.x == 0) (void)xb_add(&bar[XB_XCNT(b.x)], 1u);
    return b;
}
__device__ __forceinline__ void xcd_barrier_complete(unsigned* bar, unsigned x, unsigned& nloc, unsigned& nx) {
    const unsigned G = gridDim.x * gridDim.y * gridDim.z;
    unsigned sum, cnt, mine, sp = 0u;
    for (;;) {
        sum = 0u; cnt = 0u; mine = 0u;
#pragma unroll
        for (unsigned j = 0; j < 16; ++j) { const unsigned c = xb_ld(&bar[XB_XCNT(j)]); sum += c; cnt += (c > 0u) ? 1u : 0u; mine = (j == x) ? c : mine; }
        if (sum == G) break;
        __builtin_amdgcn_s_sleep(1);
        if ((++sp & 255u) == 0u) { if (xb_ld(&bar[XB_TMO])) break; if (sp > XB_SPIN_CAP) { atomicAdd(&bar[XB_TMO], 1u); break; } }
    }
    nloc = mine > 0u ? mine : 1u; nx = cnt > 0u ? cnt : 1u;
}

__device__ __forceinline__ void xcd_barrier(const XcdBarrier& b) {
    asm volatile("s_waitcnt vmcnt(0)" ::: "memory");
    __syncthreads();
    if (threadIdx.x == 0) {
        unsigned* bar = b.bar;
        __builtin_amdgcn_s_waitcnt(0);
        unsigned nloc = b.st[0], nx = b.st[1];
        if (nloc == 0u) { xcd_barrier_complete(bar, b.x, nloc, nx); b.st[0] = nloc; b.st[1] = nx; }
        const unsigned old = xb_add(&bar[XB_XSUB(b.x)], 1u);
        const unsigned gen = old / nloc;
        if (old + 1u == (gen + 1u) * nloc) {
            __builtin_amdgcn_fence(__ATOMIC_RELEASE, "agent");
            asm volatile("s_waitcnt vmcnt(0)" ::: "memory");
            const unsigned og = xb_add(&bar[XB_TOP], 1u);
            const unsigned tg = og / nx;
            if (og + 1u == (tg + 1u) * nx) xb_add(&bar[XB_TOPGEN], 1u);
            else XB_SPIN(xb_ld(&bar[XB_TOPGEN]) == tg, bar);
            __builtin_amdgcn_fence(__ATOMIC_ACQUIRE, "agent");
            xb_add(&bar[XB_XGEN(b.x)], 1u);
            asm volatile("s_waitcnt vmcnt(0)" ::: "memory");
        } else {
            XB_SPIN(xb_ld(&bar[XB_XGEN(b.x)]) == gen, bar);
            __builtin_amdgcn_fence(__ATOMIC_ACQUIRE, "agent");
            asm volatile("s_waitcnt vmcnt(0)" ::: "memory");
        }
    }
    __syncthreads();
}


__device__ __forceinline__ float wave_sum(float v) {
#pragma unroll
    for (int o = 1; o < 64; o <<= 1) v += __shfl_xor(v, o);
    return v;
}
__device__ __forceinline__ float bf2f(unsigned short b) { return __builtin_bit_cast(float, (unsigned)b << 16); }
__device__ __forceinline__ float bflo(unsigned u) { return __builtin_bit_cast(float, u << 16); }
__device__ __forceinline__ float bfhi(unsigned u) { return __builtin_bit_cast(float, u & 0xffff0000u); }
__device__ __forceinline__ float sigm(float x) { return 1.0f / (1.0f + __expf(-x)); }

struct Frame {
    LAS unsigned char* lds; volatile LAS unsigned* MISC; gu32* ctl;
    int tid, lane, wave, vcu, G;
    const float *xp, *xs, *ck, *cv, *clf, *sh, *sc, *g_pre, *g_post, *w_in, *fbias, *lbl, *hgn, *w_bf, *w_bh, *w_out, *g_pre2, *g_post2, *w_up, *cw, *cb, *w_dn;
    float* out; unsigned char* ws;
};
#define WSP(T, off) ((T*)(F.ws + (off)))

__device__ __forceinline__ void tr_item(const float* W, int ldW, bf16* WT, int Kd, int k0, int nsrc0, int drow0, LAS float* scr, int lane) {
#pragma unroll 8
    for (int i = 0; i < 32; ++i) { const int kk = 2 * i + (lane >> 5); scr[kk * 33 + (lane & 31)] = W[(size_t)(k0 + kk) * ldW + nsrc0 + (lane & 31)]; }
    LDS_WAIT(); asm volatile("" ::: "memory");
    const int c = lane & 7;
#pragma unroll
    for (int j = 0; j < 4; ++j) { const int n = (lane >> 3) + 8 * j; const LAS float* s = scr + (8 * c) * 33 + n;
        v4u o; o.x = pk2(s[0 * 33], s[1 * 33]); o.y = pk2(s[2 * 33], s[3 * 33]); o.z = pk2(s[4 * 33], s[5 * 33]); o.w = pk2(s[6 * 33], s[7 * 33]);
        *(GAS v4u*)(WT + (size_t)(drow0 + n) * Kd + k0 + 8 * c) = o; }
    LDS_WAIT(); asm volatile("" ::: "memory");
}
__device__ __forceinline__ void p0_prologue(Frame& F) {
    LAS float* scr = (LAS float*)(F.lds + RING_OFF + F.wave * 16384);
    const int gw = F.vcu * NWAVES + F.wave, NGW = F.G * NWAVES;
    constexpr int I0 = 16 * 48, I1 = 16 * 128, I2 = 8 * 32, I3 = 8 * 32, I4 = 16 * 32, I5 = 16 * 176, I6 = 44 * 32, NITEMS = I0 + I1 + I2 + I3 + I4 + I5 + I6;
    for (int it = gw; it < NITEMS; it += NGW) {
        int r = it;
        if (r < I0) { const int kb = r / 48, nb = r % 48; tr_item(F.w_in, NIN, WSP(bf16, WS_WIN), 1024, 64 * kb, 32 * nb, 32 * nb, scr, F.lane); continue; } r -= I0;
        if (r < I1) { const int kb = r / 128, nb = r % 128; tr_item(F.w_in, NIN, WSP(bf16, WS_WIN), 1024, 64 * kb, 1544 + 32 * nb, 1536 + 32 * nb, scr, F.lane); continue; } r -= I1;
        if (r < I2) { const int kb = r / 32, nb = r % 32; tr_item(F.w_bf, 1024, WSP(bf16, WS_WBF), 512, 64 * kb, 32 * nb, 32 * nb, scr, F.lane); continue; } r -= I2;
        if (r < I3) { const int kb = r / 32, nb = r % 32; tr_item(F.w_bh, 1024, WSP(bf16, WS_WBH), 512, 64 * kb, 32 * nb, 32 * nb, scr, F.lane); continue; } r -= I3;
        if (r < I4) { const int kb = r / 32, nb = r % 32; tr_item(F.w_out, 1024, WSP(bf16, WS_WOUT), 1024, 64 * kb, 32 * nb, 32 * nb, scr, F.lane); continue; } r -= I4;
        if (r < I5) { const int kb = r / 176, nb = r % 176; const int drow = nb < 88 ? (nb >> 2) * 256 + (nb & 3) * 32 : ((nb - 88) >> 2) * 256 + 128 + ((nb - 88) & 3) * 32;
                      tr_item(F.w_up, 2 * DFF, WSP(bf16, WS_WUP), 1024, 64 * kb, 32 * nb, drow, scr, F.lane); continue; } r -= I5;
        { const int kb = r / 32, nb = r % 32; tr_item(F.w_dn, 1024, WSP(bf16, WS_WDN), DFF, 64 * kb, 32 * nb, 32 * nb, scr, F.lane); }
    }
    __syncthreads();
    LAS float* wf = (LAS float*)(F.lds + RING_OFF);
    for (int i = F.tid; i < 8192; i += NTHR) wf[i] = F.w_in[(size_t)(i >> 3) * NIN + 1536 + (i & 7)];
    __syncthreads();
    bf16* H1 = WSP(bf16, WS_H1);
    for (int m = gw; m < MTOT; m += NGW) {
        const float* xr = m < MP ? F.xp + (size_t)m * DMODEL : F.xs + (size_t)(m - MP) * DMODEL;
        f32x4 v[4]; float s = 0.f;
#pragma unroll
        for (int j = 0; j < 4; ++j) { v[j] = ((const GAS f32x4*)xr)[F.lane + 64 * j]; s += (v[j].x * v[j].x + v[j].y * v[j].y) + (v[j].z * v[j].z + v[j].w * v[j].w); }
        const float inv = 1.0f / sqrtf(wave_sum(s) * (1.f / DMODEL) + RMS_EPS);
        float ff[8];
#pragma unroll
        for (int i = 0; i < 8; ++i) ff[i] = 0.f;
#pragma unroll
        for (int j = 0; j < 4; ++j) { const f32x4 g = ((const GAS f32x4*)F.g_pre)[F.lane + 64 * j]; v[j] = (v[j] * inv) * g;
            GAS unsigned long long* o8 = (GAS unsigned long long*)(H1 + (size_t)m * DMODEL) + F.lane + 64 * j;
            *o8 = (unsigned long long)pk2(v[j].x, v[j].y) | ((unsigned long long)pk2(v[j].z, v[j].w) << 32);
#pragma unroll
            for (int e = 0; e < 4; ++e) { const LAS f32x4* wr = (const LAS f32x4*)(wf + (size_t)(4 * (F.lane + 64 * j) + e) * 8); const f32x4 a = wr[0], b = wr[1]; const float hv = v[j][e];
                ff[0] += hv * a.x; ff[1] += hv * a.y; ff[2] += hv * a.z; ff[3] += hv * a.w; ff[4] += hv * b.x; ff[5] += hv * b.y; ff[6] += hv * b.z; ff[7] += hv * b.w; } }
#pragma unroll
        for (int i = 0; i < 8; ++i) ff[i] = wave_sum(ff[i]);
        float mine = ff[0];
#pragma unroll
        for (int i = 1; i < 8; ++i) mine = (F.lane == i) ? ff[i] : mine;
        if (F.lane < 8) { const float xv = mine + F.fbias[F.lane]; const float ls = fminf(xv, 0.f) - log1pf(__expf(-fabsf(xv)));
            float* o = m < MP ? F.out + OFF_PLF + (size_t)m * 8 : F.out + OFF_SLF + (size_t)(m - MP) * 8; o[F.lane] = ls; }
    }
    { const int gt = F.vcu * NTHR + F.tid; const int n16 = (MPAD - MTOT) * DMODEL * 2 / 16; for (int i = gt; i < n16; i += F.G * NTHR) ((GAS v4u*)(H1 + (size_t)MTOT * DMODEL))[i] = (v4u){0u, 0u, 0u, 0u}; }
    if (blockIdx.x == 0) { float* LB = WSP(float, WS_LB); for (int c = F.tid; c < 512; c += NTHR) LB[c] = sigm(F.lbl[c] - F.lbl[512 + c]); }
}

__device__ __forceinline__ void ph_cum(Frame& F) {
    const int bid = blockIdx.x; LAS double* ld = (LAS double*)(F.lds + RING_OFF);
    if (bid == 0) {
        const float* plf = F.out + OFF_PLF; float* KB = WSP(float, WS_KB); const int h = F.tid & 7, c = F.tid >> 3;
        double s = 0.0; for (int t = 256 * c; t < 256 * c + 256; ++t) s += (double)plf[(size_t)t * 8 + h];
        ld[c * 8 + h] = s; __syncthreads();
        double run = 0.0; for (int cc = 0; cc < c; ++cc) run += ld[cc * 8 + h];
        for (int t = 256 * c; t < 256 * c + 256; ++t) { run += (double)plf[(size_t)t * 8 + h]; KB[(size_t)h * MP + t] = (float)(-run * 1.4426950408889634); }
    } else if (bid <= 8) {
        const int b = bid - 1, h = F.tid & 7, c = F.tid >> 3; const float* cl = F.clf + (size_t)b * PAST * 8; float* SKB = WSP(float, WS_SKB) + (size_t)(b * 8 + h) * SKS;
        double s = 0.0; for (int j = 64 * c; j < 64 * c + 64; ++j) s += (double)cl[(size_t)j * 8 + h];
        ld[c * 8 + h] = s; __syncthreads();
        double run = 0.0; for (int cc = c + 1; cc < 64; ++cc) run += ld[cc * 8 + h];
        for (int j = 64 * c + 63; j >= 64 * c; --j) { SKB[j] = (float)(run * 1.4426950408889634); run += (double)cl[(size_t)j * 8 + h]; }
        if (c == 0) { const float* slf = F.out + OFF_SLF + (size_t)b * 16 * 8; double r2 = 0.0; for (int i = 0; i < 16; ++i) { r2 += (double)slf[i * 8 + h]; SKB[PAST + i] = (float)(-r2 * 1.4426950408889634); } }
    }
}

__device__ __forceinline__ void ph_attn_naive(Frame& F) {
    const bf16* Q = WSP(bf16, WS_Q); const bf16* K = WSP(bf16, WS_K); const bf16* V = WSP(bf16, WS_V); bf16* O = WSP(bf16, WS_Q); const float* KB = WSP(float, WS_KB);
    for (int unit = blockIdx.x; unit < 256; unit += F.G) {
        const int h = unit >> 5, qb = unit & 31, qi = qb * 512 + F.tid;
        float q[64], o[64];
        { const v4u* qr = (const v4u*)(Q + (size_t)qi * 512 + h * 64);
#pragma unroll
          for (int c = 0; c < 8; ++c) { const v4u w = qr[c]; q[8 * c] = bflo(w.x); q[8 * c + 1] = bfhi(w.x); q[8 * c + 2] = bflo(w.y); q[8 * c + 3] = bfhi(w.y); q[8 * c + 4] = bflo(w.z); q[8 * c + 5] = bfhi(w.z); q[8 * c + 6] = bflo(w.w); q[8 * c + 7] = bfhi(w.w); } }
#pragma unroll
        for (int d = 0; d < 64; ++d) o[d] = 0.f;
        float m = -1e30f, l = 0.f; const int kend = qb * 512 + 511;
        for (int k = 0; k <= kend; ++k) {
            const v4u* kr = (const v4u*)(K + (size_t)k * 512 + h * 64); float s = 0.f;
#pragma unroll
            for (int c = 0; c < 8; ++c) { const v4u w = kr[c]; s += q[8 * c] * bflo(w.x) + q[8 * c + 1] * bfhi(w.x) + q[8 * c + 2] * bflo(w.y) + q[8 * c + 3] * bfhi(w.y) + q[8 * c + 4] * bflo(w.z) + q[8 * c + 5] * bfhi(w.z) + q[8 * c + 6] * bflo(w.w) + q[8 * c + 7] * bfhi(w.w); }
            s += KB[(size_t)h * MP + k];
            if (k <= qi) {
                const float mn = fmaxf(m, s), a = __builtin_amdgcn_exp2f(m - mn), p = __builtin_amdgcn_exp2f(s - mn); l = l * a + p; m = mn;
                const v4u* vr = (const v4u*)(V + (size_t)k * 512 + h * 64);
#pragma unroll
                for (int c = 0; c < 8; ++c) { const v4u w = vr[c];
                    o[8 * c] = o[8 * c] * a + p * bflo(w.x); o[8 * c + 1] = o[8 * c + 1] * a + p * bfhi(w.x); o[8 * c + 2] = o[8 * c + 2] * a + p * bflo(w.y); o[8 * c + 3] = o[8 * c + 3] * a + p * bfhi(w.y);
                    o[8 * c + 4] = o[8 * c + 4] * a + p * bflo(w.z); o[8 * c + 5] = o[8 * c + 5] * a + p * bfhi(w.z); o[8 * c + 6] = o[8 * c + 6] * a + p * bflo(w.w); o[8 * c + 7] = o[8 * c + 7] * a + p * bfhi(w.w); }
            }
        }
        const float rl = 1.0f / l; v4u* orow = (v4u*)(O + (size_t)qi * 512 + h * 64);
#pragma unroll
        for (int c = 0; c < 8; ++c) { v4u w; w.x = pk2(o[8 * c] * rl, o[8 * c + 1] * rl); w.y = pk2(o[8 * c + 2] * rl, o[8 * c + 3] * rl); w.z = pk2(o[8 * c + 4] * rl, o[8 * c + 5] * rl); w.w = pk2(o[8 * c + 6] * rl, o[8 * c + 7] * rl); orow[c] = w; }
    }
}
__device__ __forceinline__ void ph_attn_sample_naive(Frame& F) {
    const bf16* Q = WSP(bf16, WS_Q); const bf16* K = WSP(bf16, WS_K); const bf16* V = WSP(bf16, WS_V); bf16* O = WSP(bf16, WS_Q);
    const int task = blockIdx.x * NWAVES + F.wave; if (task >= 64) return;
    const int b = task >> 3, h = task & 7, qi = F.lane & 15; const size_t row = (size_t)MP + b * 16 + qi; const float* SKB = WSP(float, WS_SKB) + (size_t)(b * 8 + h) * SKS;
    float q[64], o[64];
    { const v4u* qr = (const v4u*)(Q + row * 512 + h * 64);
#pragma unroll
      for (int c = 0; c < 8; ++c) { const v4u w = qr[c]; q[8 * c] = bflo(w.x); q[8 * c + 1] = bfhi(w.x); q[8 * c + 2] = bflo(w.y); q[8 * c + 3] = bfhi(w.y); q[8 * c + 4] = bflo(w.z); q[8 * c + 5] = bfhi(w.z); q[8 * c + 6] = bflo(w.w); q[8 * c + 7] = bfhi(w.w); } }
#pragma unroll
    for (int d = 0; d < 64; ++d) o[d] = 0.f;
    float m = -1e30f, l = 0.f;
    for (int k = 0; k < PAST; ++k) {
        const f32x4* kr = (const f32x4*)(F.ck + ((size_t)(b * PAST + k) * 8 + h) * 64); float s = 0.f;
#pragma unroll
        for (int c = 0; c < 16; ++c) { const f32x4 w = kr[c]; s += q[4 * c] * w.x + q[4 * c + 1] * w.y + q[4 * c + 2] * w.z + q[4 * c + 3] * w.w; }
        s += SKB[k];
        const float mn = fmaxf(m, s), a = __builtin_amdgcn_exp2f(m - mn), p = __builtin_amdgcn_exp2f(s - mn); l = l * a + p; m = mn;
        const f32x4* vr = (const f32x4*)(F.cv + ((size_t)(b * PAST + k) * 8 + h) * 64);
#pragma unroll
        for (int c = 0; c < 16; ++c) { const f32x4 w = vr[c]; o[4 * c] = o[4 * c] * a + p * w.x; o[4 * c + 1] = o[4 * c + 1] * a + p * w.y; o[4 * c + 2] = o[4 * c + 2] * a + p * w.z; o[4 * c + 3] = o[4 * c + 3] * a + p * w.w; }
    }
    for (int i = 0; i < 16; ++i) {
        const size_t kr_ = (size_t)MP + b * 16 + i; const v4u* kr = (const v4u*)(K + kr_ * 512 + h * 64); float s = 0.f;
#pragma unroll
        for (int c = 0; c < 8; ++c) { const v4u w = kr[c]; s += q[8 * c] * bflo(w.x) + q[8 * c + 1] * bfhi(w.x) + q[8 * c + 2] * bflo(w.y) + q[8 * c + 3] * bfhi(w.y) + q[8 * c + 4] * bflo(w.z) + q[8 * c + 5] * bfhi(w.z) + q[8 * c + 6] * bflo(w.w) + q[8 * c + 7] * bfhi(w.w); }
        s += SKB[PAST + i];
        if (i <= qi) {
            const float mn = fmaxf(m, s), a = __builtin_amdgcn_exp2f(m - mn), p = __builtin_amdgcn_exp2f(s - mn); l = l * a + p; m = mn;
            const v4u* vr = (const v4u*)(V + kr_ * 512 + h * 64);
#pragma unroll
            for (int c = 0; c < 8; ++c) { const v4u w = vr[c];
                o[8 * c] = o[8 * c] * a + p * bflo(w.x); o[8 * c + 1] = o[8 * c + 1] * a + p * bfhi(w.x); o[8 * c + 2] = o[8 * c + 2] * a + p * bflo(w.y); o[8 * c + 3] = o[8 * c + 3] * a + p * bfhi(w.y);
                o[8 * c + 4] = o[8 * c + 4] * a + p * bflo(w.z); o[8 * c + 5] = o[8 * c + 5] * a + p * bfhi(w.z); o[8 * c + 6] = o[8 * c + 6] * a + p * bflo(w.w); o[8 * c + 7] = o[8 * c + 7] * a + p * bfhi(w.w); }
        }
    }
    if (F.lane < 16) { const float rl = 1.0f / l; v4u* orow = (v4u*)(O + row * 512 + h * 64);
#pragma unroll
        for (int c = 0; c < 8; ++c) { v4u w; w.x = pk2(o[8 * c] * rl, o[8 * c + 1] * rl); w.y = pk2(o[8 * c + 2] * rl, o[8 * c + 3] * rl); w.z = pk2(o[8 * c + 4] * rl, o[8 * c + 5] * rl); w.w = pk2(o[8 * c + 6] * rl, o[8 * c + 7] * rl); orow[c] = w; } }
}

__device__ __forceinline__ void hgrn_chain(Frame& F, size_t row0, int T, int h, int v, float& S0, float& S1) {
    const bf16* HQ = WSP(bf16, WS_HQ); const bf16* KK = WSP(bf16, WS_KK); const bf16* HI = WSP(bf16, WS_HI); const float* LF = WSP(float, WS_LF); bf16* OH = WSP(bf16, WS_OH);
    const int d0 = F.lane, d1 = F.lane + 64;
    for (int t = 0; t < T; ++t) {
        const size_t base = (row0 + t) * 512 + h * 128;
        const float q0 = bf2f(HQ[base + d0]), q1 = bf2f(HQ[base + d1]), k0 = bf2f(KK[base + d0]), k1 = bf2f(KK[base + d1]), l0 = LF[base + d0], l1 = LF[base + d1], iv = bf2f(HI[base + v]);
        S0 = __expf(l0) * S0 + k0 * iv; S1 = __expf(l1) * S1 + k1 * iv;
        const float p = wave_sum(q0 * S0 + q1 * S1);
        if (F.lane == 0) OH[base + v] = (bf16)f2bf(p);
    }
}
__device__ __forceinline__ void ph_hgrn_naive(Frame& F) {
    const int gw = blockIdx.x * NWAVES + F.wave, NGW = F.G * NWAVES;
    if (gw < 512) { const int h = gw >> 7, v = gw & 127; float S0 = 0.f, S1 = 0.f; hgrn_chain(F, 0, MP, h, v, S0, S1);
        float* ph = F.out + OFF_PH; ph[((size_t)h * 128 + F.lane) * 128 + v] = S0; ph[((size_t)h * 128 + F.lane + 64) * 128 + v] = S1; }
    for (int task = gw; task < 4096; task += NGW) { const int bh = task >> 7, v = task & 127, b = bh >> 2, h = bh & 3;
        const float* st = F.sh + (size_t)bh * 16384; float S0 = st[(size_t)F.lane * 128 + v], S1 = st[(size_t)(F.lane + 64) * 128 + v];
        hgrn_chain(F, (size_t)MP + b * 16, 16, h, v, S0, S1);
        float* so = F.out + OFF_SH + (size_t)bh * 16384; so[(size_t)F.lane * 128 + v] = S0; so[(size_t)(F.lane + 64) * 128 + v] = S1; }
}
__device__ __forceinline__ void ph_hgnorm(Frame& F) {
    const int gw = F.vcu * NWAVES + F.wave, NGW = F.G * NWAVES; unsigned* OH = WSP(unsigned, WS_OH); const unsigned* HG = WSP(unsigned, WS_HG);
    const float g0 = F.hgn[2 * F.lane], g1 = F.hgn[2 * F.lane + 1];
    for (int task = gw; task < MTOT * 4; task += NGW) { const size_t idx = (size_t)task * 64 + F.lane; const unsigned w = OH[idx], g = HG[idx];
        const float a = bflo(w), b = bfhi(w); const float inv = 1.0f / sqrtf(wave_sum(a * a + b * b) * (1.f / 128) + RMS_EPS);
        OH[idx] = pk2(a * inv * g0 * bflo(g), b * inv * g1 * bfhi(g)); }
}
__device__ __forceinline__ void ph_merge(Frame& F) {
    const float* BRF = WSP(float, WS_BRF); const float* BRH = WSP(float, WS_BRH); bf16* MG = WSP(bf16, WS_MERGED);
    const size_t n8 = (size_t)MTOT * DMODEL / 8;
    for (size_t i = (size_t)F.vcu * NTHR + F.tid; i < n8; i += (size_t)F.G * NTHR) { const size_t m = i >> 7, c = (i & 127) * 8;
        const bf16* ga = m < MP ? (const bf16*)F.out + m * DMODEL + c : WSP(bf16, WS_GAS) + (m - MP) * DMODEL + c;
        const bf16* gb = m < MP ? (const bf16*)F.out + (size_t)MP * DMODEL + m * DMODEL + c : WSP(bf16, WS_GBS) + (m - MP) * DMODEL + c;
        const v4u a = *(const v4u*)ga, b = *(const v4u*)gb; const f32x4 f0 = *(const f32x4*)(BRF + m * DMODEL + c), f1 = *(const f32x4*)(BRF + m * DMODEL + c + 4), h0 = *(const f32x4*)(BRH + m * DMODEL + c), h1 = *(const f32x4*)(BRH + m * DMODEL + c + 4);
        v4u o; o.x = pk2(bflo(a.x) * f0.x + bflo(b.x) * h0.x, bfhi(a.x) * f0.y + bfhi(b.x) * h0.y); o.y = pk2(bflo(a.y) * f0.z + bflo(b.y) * h0.z, bfhi(a.y) * f0.w + bfhi(b.y) * h0.w);
        o.z = pk2(bflo(a.z) * f1.x + bflo(b.z) * h1.x, bfhi(a.z) * f1.y + bfhi(b.z) * h1.y); o.w = pk2(bflo(a.w) * f1.z + bflo(b.w) * h1.z, bfhi(a.w) * f1.w + bfhi(b.w) * h1.w);
        *(v4u*)(MG + m * DMODEL + c) = o; }
}
__device__ __forceinline__ void ph_norm1(Frame& F) {
    const int gw = F.vcu * NWAVES + F.wave, NGW = F.G * NWAVES; const float* MIX = WSP(float, WS_MIX); bf16* H2 = WSP(bf16, WS_H2);
    for (int m = gw; m < MTOT; m += NGW) {
        const float* xr = m < MP ? F.xp + (size_t)m * DMODEL : F.xs + (size_t)(m - MP) * DMODEL; float* yr = m < MP ? F.out + OFF_Y + (size_t)m * DMODEL : F.out + OFF_YS + (size_t)(m - MP) * DMODEL;
        f32x4 v[4]; float s = 0.f;
#pragma unroll
        for (int j = 0; j < 4; ++j) { v[j] = ((const GAS f32x4*)(MIX + (size_t)m * DMODEL))[F.lane + 64 * j]; s += (v[j].x * v[j].x + v[j].y * v[j].y) + (v[j].z * v[j].z + v[j].w * v[j].w); }
        const float inv = 1.0f / sqrtf(wave_sum(s) * (1.f / DMODEL) + RMS_EPS); float s2 = 0.f;
#pragma unroll
        for (int j = 0; j < 4; ++j) { const f32x4 g = ((const GAS f32x4*)F.g_post)[F.lane + 64 * j], x = ((const GAS f32x4*)xr)[F.lane + 64 * j]; v[j] = x + (v[j] * inv) * g;
            ((GAS f32x4*)yr)[F.lane + 64 * j] = v[j]; s2 += (v[j].x * v[j].x + v[j].y * v[j].y) + (v[j].z * v[j].z + v[j].w * v[j].w); }
        const float inv2 = 1.0f / sqrtf(wave_sum(s2) * (1.f / DMODEL) + RMS_EPS);
#pragma unroll
        for (int j = 0; j < 4; ++j) { const f32x4 g = ((const GAS f32x4*)F.g_pre2)[F.lane + 64 * j]; const f32x4 hv = (v[j] * inv2) * g;
            GAS unsigned long long* o8 = (GAS unsigned long long*)(H2 + (size_t)m * DMODEL) + F.lane + 64 * j; *o8 = (unsigned long long)pk2(hv.x, hv.y) | ((unsigned long long)pk2(hv.z, hv.w) << 32); }
    }
}
__device__ __forceinline__ float gelu_tanh(float c) { const float u = 0.7978845608028654f * (c + 0.044715f * c * c * c); const float t = 1.0f - 2.0f / (__expf(2.0f * u) + 1.0f); return 0.5f * c * (1.0f + t); }
__device__ __forceinline__ void ph_conv(Frame& F) {
    const bf16* A = WSP(bf16, WS_ABUF); bf16* G = WSP(bf16, WS_GBUF); constexpr int NG = DFF / 8; const size_t n8 = (size_t)MTOT * NG;
    for (size_t i = (size_t)F.vcu * NTHR + F.tid; i < n8; i += (size_t)F.G * NTHR) { const size_t m = i / NG; const int c = (int)(i % NG) * 8;
        float a0[8], a1[8], a2[8];
        { const v4u w = *(const v4u*)(A + m * DFF + c); a0[0] = bflo(w.x); a0[1] = bfhi(w.x); a0[2] = bflo(w.y); a0[3] = bfhi(w.y); a0[4] = bflo(w.z); a0[5] = bfhi(w.z); a0[6] = bflo(w.w); a0[7] = bfhi(w.w); }
        int t, b = 0; const bool samp = m >= MP; if (samp) { t = (int)(m - MP) & 15; b = (int)(m - MP) >> 4; } else t = (int)(m < 2 ? m : 2);
        if (t >= 1) { const v4u w = *(const v4u*)(A + (m - 1) * DFF + c); a1[0] = bflo(w.x); a1[1] = bfhi(w.x); a1[2] = bflo(w.y); a1[3] = bfhi(w.y); a1[4] = bflo(w.z); a1[5] = bfhi(w.z); a1[6] = bflo(w.w); a1[7] = bfhi(w.w); }
        else {
#pragma unroll
            for (int e = 0; e < 8; ++e) a1[e] = samp ? F.sc[((size_t)b * 2 + 1) * DFF + c + e] : 0.f; }
        if (t >= 2) { const v4u w = *(const v4u*)(A + (m - 2) * DFF + c); a2[0] = bflo(w.x); a2[1] = bfhi(w.x); a2[2] = bflo(w.y); a2[3] = bfhi(w.y); a2[4] = bflo(w.z); a2[5] = bfhi(w.z); a2[6] = bflo(w.w); a2[7] = bfhi(w.w); }
        else {
#pragma unroll
            for (int e = 0; e < 8; ++e) a2[e] = samp ? F.sc[((size_t)b * 2 + t) * DFF + c + e] : 0.f; }
        const v4u gw_ = *(const v4u*)(G + m * DFF + c); float g[8] = {bflo(gw_.x), bfhi(gw_.x), bflo(gw_.y), bfhi(gw_.y), bflo(gw_.z), bfhi(gw_.z), bflo(gw_.w), bfhi(gw_.w)}; float u[8];
#pragma unroll
        for (int e = 0; e < 8; ++e) { const float cv_ = F.cb[c + e] + F.cw[c + e] * a2[e] + F.cw[DFF + c + e] * a1[e] + F.cw[2 * DFF + c + e] * a0[e]; u[e] = gelu_tanh(cv_) * g[e]; }
        v4u o; o.x = pk2(u[0], u[1]); o.y = pk2(u[2], u[3]); o.z = pk2(u[4], u[5]); o.w = pk2(u[6], u[7]); *(v4u*)(G + m * DFF + c) = o; }
}
__device__ __forceinline__ void ph_norm2(Frame& F) {
    const int gw = F.vcu * NWAVES + F.wave, NGW = F.G * NWAVES; const float* FFN = WSP(float, WS_FFN);
    for (int m = gw; m < MTOT; m += NGW) {
        float* yr = m < MP ? F.out + OFF_Y + (size_t)m * DMODEL : F.out + OFF_YS + (size_t)(m - MP) * DMODEL;
        f32x4 v[4]; float s = 0.f;
#pragma unroll
        for (int j = 0; j < 4; ++j) { v[j] = ((const GAS f32x4*)(FFN + (size_t)m * DMODEL))[F.lane + 64 * j]; s += (v[j].x * v[j].x + v[j].y * v[j].y) + (v[j].z * v[j].z + v[j].w * v[j].w); }
        const float inv = 1.0f / sqrtf(wave_sum(s) * (1.f / DMODEL) + RMS_EPS);
#pragma unroll
        for (int j = 0; j < 4; ++j) { const f32x4 g = ((const GAS f32x4*)F.g_post2)[F.lane + 64 * j]; GAS f32x4* y4 = (GAS f32x4*)yr + F.lane + 64 * j; *y4 = *y4 + (v[j] * inv) * g; }
    }
}

struct Args { const float* in[22]; float* out; unsigned char* ws; int ph_lo, ph_hi, li, pad; };
constexpr int NPHASE = 15;
__global__ void __launch_bounds__(NTHR, 2) skel_fwd(Args args) {
    extern __shared__ __attribute__((aligned(16))) unsigned char lds[];
    Frame F;
    F.lds = (LAS unsigned char*)lds; F.MISC = (volatile LAS unsigned*)(F.lds + MISC_OFF);
    F.tid = threadIdx.x; F.lane = F.tid & 63; F.wave = __builtin_amdgcn_readfirstlane(F.tid >> 6);
    F.G = gridDim.x; { const int bx = blockIdx.x; F.vcu = (F.G % 8 == 0) ? (bx % 8) * (F.G / 8) + bx / 8 : bx; }
    F.ws = args.ws; F.out = args.out; F.ctl = (gu32*)(args.ws + WS_CTL);
    F.xp = args.in[0]; F.xs = args.in[1]; F.ck = args.in[2]; F.cv = args.in[3]; F.clf = args.in[4]; F.sh = args.in[5]; F.sc = args.in[6]; F.g_pre = args.in[7]; F.g_post = args.in[8];
    F.w_in = args.in[9]; F.fbias = args.in[10]; F.lbl = args.in[11]; F.hgn = args.in[12]; F.w_bf = args.in[13]; F.w_bh = args.in[14]; F.w_out = args.in[15]; F.g_pre2 = args.in[16]; F.g_post2 = args.in[17];
    F.w_up = args.in[18]; F.cw = args.in[19]; F.cb = args.in[20]; F.w_dn = args.in[21];
    const int lo = args.ph_lo, hi = args.ph_hi;
#define IN(k) (lo <= (k) && (k) < hi)
    typedef pg8::bf16_t pbf;
    if (IN(0)) p0_prologue(F);
    if (IN(1)) ph_cum(F);
    if (IN(2)) {
        pg8::Gemm g{WSP(pbf, WS_H1), WSP(pbf, WS_WIN), MPAD, NINP, DMODEL}; pg8::StaticOrder S; S.init(MPAD, NINP, F.G, (int)blockIdx.x);
        pg8::EpiIn E{WSP(pbf, WS_Q), WSP(pbf, WS_K), WSP(pbf, WS_V), WSP(pbf, WS_HQ), WSP(pbf, WS_KK), WSP(pbf, WS_HI), WSP(pbf, WS_HG), WSP(float, WS_LF),
                     (pbf*)F.out, (pbf*)F.out + (size_t)MP * DMODEL, WSP(pbf, WS_GAS), WSP(pbf, WS_GBS), F.out + OFF_PK, F.out + OFF_PV, F.out + OFF_SK, F.out + OFF_SV, WSP(float, WS_LB), C2};
        pg8::gemm_phase<pg8::EpiIn, pg8::StaticOrder, true, true>(F.lds + RING_OFF, g, S, E);
    }
    if (IN(3)) { ph_attn_sample_naive(F); ph_attn_naive(F); }
    if (IN(4)) ph_hgrn_naive(F);
    if (IN(5)) ph_hgnorm(F);
    if (IN(6)) { pg8::Gemm g{WSP(pbf, WS_Q), WSP(pbf, WS_WBF), MPAD, DMODEL, 512}; pg8::StaticOrder S; S.init(MPAD, DMODEL, F.G, (int)blockIdx.x); pg8::EpiF32 E{WSP(float, WS_BRF), DMODEL};
                 pg8::gemm_phase<pg8::EpiF32, pg8::StaticOrder, true, true>(F.lds + RING_OFF, g, S, E); }
    if (IN(7)) { pg8::Gemm g{WSP(pbf, WS_OH), WSP(pbf, WS_WBH), MPAD, DMODEL, 512}; pg8::StaticOrder S; S.init(MPAD, DMODEL, F.G, (int)blockIdx.x); pg8::EpiF32 E{WSP(float, WS_BRH), DMODEL};
                 pg8::gemm_phase<pg8::EpiF32, pg8::StaticOrder, true, true>(F.lds + RING_OFF, g, S, E); }
    if (IN(8)) ph_merge(F);
    if (IN(9)) { pg8::Gemm g{WSP(pbf, WS_MERGED), WSP(pbf, WS_WOUT), MPAD, DMODEL, DMODEL}; pg8::StaticOrder S; S.init(MPAD, DMODEL, F.G, (int)blockIdx.x); pg8::EpiF32 E{WSP(float, WS_MIX), DMODEL};
                 pg8::gemm_phase<pg8::EpiF32, pg8::StaticOrder, true, true>(F.lds + RING_OFF, g, S, E); }
    if (IN(10)) ph_norm1(F);
    if (IN(11)) { pg8::Gemm g{WSP(pbf, WS_H2), WSP(pbf, WS_WUP), MPAD, 2 * DFF, DMODEL}; pg8::StaticOrder S; S.init(MPAD, 2 * DFF, F.G, (int)blockIdx.x);
                  pg8::EpiUpSplit E{WSP(pbf, WS_ABUF), WSP(pbf, WS_GBUF), F.out + OFF_PC, F.out + OFF_SC};
                  pg8::gemm_phase<pg8::EpiUpSplit, pg8::StaticOrder, true, true>(F.lds + RING_OFF, g, S, E); }
    if (IN(12)) ph_conv(F);
    if (IN(13)) { pg8::Gemm g{WSP(pbf, WS_GBUF), WSP(pbf, WS_WDN), MPAD, DMODEL, DFF}; pg8::StaticOrder S; S.init(MPAD, DMODEL, F.G, (int)blockIdx.x); pg8::EpiF32 E{WSP(float, WS_FFN), DMODEL};
                  pg8::gemm_phase<pg8::EpiF32, pg8::StaticOrder, true, true>(F.lds + RING_OFF, g, S, E); }
    if (IN(14)) ph_norm2(F);
#undef IN
}

extern "C" void kernel_launch(void* const* d_in, const int* in_sizes, int n_in, void* d_out, int out_size, void* d_ws, size_t ws_size, hipStream_t stream) {
    static int grid = 0;
    if (grid == 0) {
        if (n_in != 22 || out_size != (int)OUT_TOTAL || ws_size < WS_END) { fprintf(stderr, "kernel_launch: unexpected shapes (n_in %d out %d ws %zu)\n", n_in, out_size, ws_size); grid = -1; return; }
        if (hipFuncSetAttribute((const void*)skel_fwd, hipFuncAttributeMaxDynamicSharedMemorySize, LDS_BYTES) != hipSuccess) { fprintf(stderr, "kernel_launch: hipFuncSetAttribute failed\n"); grid = -1; return; }
        grid = 256;
    }
    if (grid < 0) return;
    (void)hipMemsetAsync((char*)d_ws + WS_CTL, 0, CTL_ZERO_BYTES, stream);
    Args a{};
    for (int i = 0; i < 22; ++i) a.in[i] = (const float*)d_in[i];
    a.out = (float*)d_out; a.ws = (unsigned char*)d_ws;
    for (int p = 0; p < NPHASE; ++p) { a.ph_lo = p; a.ph_hi = p + 1; a.li = 0; hipLaunchKernelGGL(skel_fwd, dim3(grid), dim3(NTHR), LDS_BYTES, stream, a); }
}
```

```cpp
#include <hip/hip_runtime.h>
#include <cstdio>
#include <cstdint>
namespace pg8 {
#define PG8_LAS __attribute__((address_space(3)))
typedef unsigned short bf16_t;
typedef short bf16x8 __attribute__((ext_vector_type(8)));
typedef float f32x4 __attribute__((ext_vector_type(4)));
typedef unsigned u32x4 __attribute__((ext_vector_type(4)));
constexpr int BM = 256, BK = 64, HALF = 128, HTB = HALF * BK * 2  , STAGE_BYTES = 8 * HTB, NXCD = 8, WGM = 8;

__host__ __device__ __forceinline__ int lds_byte(int r, int c) { const int st = (r >> 4) * 2 + (c >> 5), rr = r & 15, cc = c & 31, ob = rr * 64 + cc * 2; return st * 1024 + (ob ^ (((ob >> 9) & 1) << 5)); }
__host__ __device__ __forceinline__ void stage_rc(int b, int& R, int& C) { const int st = b / 1024, sb = b % 1024, swz = sb ^ (((sb >> 9) & 1) << 5); R = (st >> 1) * 16 + swz / 64; C = (st & 1) * 32 + (swz % 64) / 2; }
__host__ __device__ __forceinline__ int perm32(int rho) { const int n = rho >> 4, i = rho & 15; return 8 * (i >> 2) + 4 * n + (i & 3); }

struct Unit { int pm, pn; };
struct Gemm { const bf16_t* A; const bf16_t* Bt; int M, N, K; };

struct StaticOrder {
    int nM, nN, nwg, G, c;
    __host__ __device__ void init(int M, int N, int G_, int c_) { nM = M / BM; nN = N / BM; nwg = nM * nN; G = G_; c = c_; }
    __host__ __device__ bool next(int i, Unit& u) const {
        const long L = (long)i * G + c; if (L >= nwg) return false;
        int wgid = (int)L; { const int q = nwg / NXCD, r = nwg % NXCD, xcd = wgid % NXCD, off = wgid / NXCD; wgid = (xcd < r ? xcd * (q + 1) : r * (q + 1) + (xcd - r) * q) + off; }
        const int nig = WGM * nN, gid = wgid / nig, fm = gid * WGM, gsz = (nM - fm) < WGM ? (nM - fm) : WGM;
        u.pm = fm + ((wgid % nig) % gsz); u.pn = (wgid % nig) / gsz; return true;
    }
    __device__ __forceinline__ void a_ready(const Unit&) const {}
    __device__ __forceinline__ void done(const Unit&) const {}
};

__device__ __forceinline__ unsigned cvt_pk_bf16(float lo, float hi) { unsigned r; asm volatile("v_cvt_pk_bf16_f32 %0, %1, %2" : "=v"(r) : "v"(lo), "v"(hi)); return r; }
typedef float f32x2 __attribute__((ext_vector_type(2)));
__device__ __forceinline__ f32x2 gelu_pk(f32x2 v) {
    const f32x2 av = __builtin_elementwise_abs(v), d = av * 0.2316418882f + 1.0f;
    f32x2 t; t.x = __builtin_amdgcn_rcpf(d.x); t.y = __builtin_amdgcn_rcpf(d.y);
    f32x2 q = t * 0.5307027145f + (-0.7265760135f); q = q * t + 0.7107068705f; q = q * t + (-0.142248368f); q = q * t + 0.127414796f; q = q * t;
    const f32x2 s = (v * v) * (-0.72134752044f);
    f32x2 e; e.x = __builtin_amdgcn_exp2f(s.x); e.y = __builtin_amdgcn_exp2f(s.y);
    const f32x2 m = v * (q * e), r = v - m;
    f32x2 o; o.x = v.x < 0.f ? m.x : r.x; o.y = v.y < 0.f ? m.y : r.y; return o;
}

template <int ACT  > struct EpiBf16 {
    static constexpr bool PERM = true, AFTER_DRAIN = false; static_assert(ACT == 0 || ACT == 1, "EpiBf16: ACT is 0 (none) or 1 (gelu_pk)");
    bf16_t* O; int ldc; const float* bias; int split_cols; size_t split_stride; float scale0;
    __device__ __forceinline__ void operator()(const f32x4 (&acc)[2][2][4][2], const Unit& u, int wr, int wc, int fr, int fq) const {
        const int row0 = u.pm * BM + wr * 64 + fr; int colt = u.pn * BM; bf16_t* base = O;
        float sc = 1.f; if (split_cols) { const int t = colt / split_cols; base += (size_t)t * split_stride; colt -= t * split_cols; if (t == 0) sc = scale0; }
        const int col0 = colt + wc * 32 + 8 * fq, bcol0 = u.pn * BM + wc * 32 + 8 * fq;
        f32x4 bv[2][2];
#pragma unroll
        for (int bj = 0; bj < 2; ++bj)
#pragma unroll
            for (int n = 0; n < 2; ++n) bv[bj][n] = bias ? *(const f32x4*)(bias + bcol0 + bj * HALF + 4 * n) : (f32x4){0.f, 0.f, 0.f, 0.f};
#pragma unroll
        for (int ai = 0; ai < 2; ++ai)
#pragma unroll
            for (int m = 0; m < 4; ++m) { bf16_t* rowp = base + (size_t)(row0 + ai * HALF + m * 16) * ldc + col0;
#pragma unroll
                for (int bj = 0; bj < 2; ++bj) { f32x4 v0 = acc[ai][bj][m][0] + bv[bj][0], v1 = acc[ai][bj][m][1] + bv[bj][1];
                    if (ACT == 1) { f32x2 a = gelu_pk((f32x2){v0[0], v0[1]}), b = gelu_pk((f32x2){v0[2], v0[3]}), c = gelu_pk((f32x2){v1[0], v1[1]}), d = gelu_pk((f32x2){v1[2], v1[3]});
                        v0 = (f32x4){a.x, a.y, b.x, b.y}; v1 = (f32x4){c.x, c.y, d.x, d.y}; }
                    v0 = v0 * sc; v1 = v1 * sc; u32x4 w; w.x = cvt_pk_bf16(v0[0], v0[1]); w.y = cvt_pk_bf16(v0[2], v0[3]); w.z = cvt_pk_bf16(v1[0], v1[1]); w.w = cvt_pk_bf16(v1[2], v1[3]);
                    *(u32x4*)(rowp + bj * HALF) = w; } }
    }
};

struct PanelStats {
    unsigned* xbuf;
    unsigned* cnt;
    unsigned* tmo;
    int ntn; float eps;
    unsigned code;
    __device__ __forceinline__ bool run(const f32x4 (&v)[2][2][4][2], const Unit& u, int wr, int wc, int fr, int fq, PG8_LAS unsigned char* lds, int wid, int lane) const {
        typedef float f32x2v __attribute__((ext_vector_type(2)));
        PG8_LAS f32x2v* P = (PG8_LAS f32x2v*)lds;
        PG8_LAS f32x2v* S = (PG8_LAS f32x2v*)(lds + 8192);
        PG8_LAS unsigned* flag = (PG8_LAS unsigned*)(lds + 8192 + 2048);
#pragma unroll
        for (int ai = 0; ai < 2; ++ai)
#pragma unroll
            for (int m = 0; m < 4; ++m) {
                float s = 0.f;
#pragma unroll
                for (int bj = 0; bj < 2; ++bj)
#pragma unroll
                    for (int n = 0; n < 2; ++n) { const f32x4 x = v[ai][bj][m][n]; s += (x[0] + x[1]) + (x[2] + x[3]); }
                s += __shfl_xor(s, 16); s += __shfl_xor(s, 32);
                const float mw = s * (1.0f / 64.0f); float q = 0.f;
#pragma unroll
                for (int bj = 0; bj < 2; ++bj)
#pragma unroll
                    for (int n = 0; n < 2; ++n) { const f32x4 d = v[ai][bj][m][n] - mw; q += (d[0] * d[0] + d[1] * d[1]) + (d[2] * d[2] + d[3] * d[3]); }
                q += __shfl_xor(q, 16); q += __shfl_xor(q, 32);
                if (fq == 0) P[(ai * HALF + wr * 64 + m * 16 + fr) * 4 + wc] = (f32x2v){mw, q};
            }
        asm volatile("s_waitcnt lgkmcnt(0)" ::: "memory"); __builtin_amdgcn_s_barrier(); asm volatile("" ::: "memory");
#if defined(BROKEN_EXCHANGE_NO_WAIT)
#warning BROKEN CONTROL BUILD: the row-statistics exchange does not wait; results are wrong by design
        if (blockIdx.x >= 64) { const long long t0_ = clock64(); while (clock64() - t0_ < 60000) __builtin_amdgcn_s_sleep(8); }
#endif
        const int row = wid * 32 + (lane & 31);
        if (lane < 32) {
            const f32x2v a = P[row * 4 + 0], b = P[row * 4 + 1], c = P[row * 4 + 2], d = P[row * 4 + 3];
            const float mt = (a.x + b.x + c.x + d.x) * 0.25f;
            const float da = a.x - mt, db = b.x - mt, dc = c.x - mt, dd = d.x - mt;
            const float m2 = (a.y + b.y) + (c.y + d.y) + 64.0f * ((da * da + db * db) + (dc * dc + dd * dd));
            unsigned long long* slot = (unsigned long long*)xbuf + ((size_t)(u.pm * BM + row) * 4 + u.pn);
            __hip_atomic_store(slot, ((unsigned long long)__float_as_uint(m2) << 32) | __float_as_uint(mt), __ATOMIC_RELAXED, __HIP_MEMORY_SCOPE_AGENT);
        }
        asm volatile("s_waitcnt vmcnt(0)" ::: "memory");
        if (lane == 0) __hip_atomic_fetch_add(cnt + 64 * u.pm, 1u, __ATOMIC_RELAXED, __HIP_MEMORY_SCOPE_AGENT);
        if (wid == 0) {
            bool dead = false; const unsigned long long t0 = __builtin_amdgcn_s_memrealtime(); const unsigned want = 8u * (unsigned)ntn;
            for (;;) {
#if defined(BROKEN_EXCHANGE_NO_WAIT)
                break;
#endif
                if ((unsigned)__builtin_amdgcn_readfirstlane(__hip_atomic_load(cnt + 64 * u.pm, __ATOMIC_RELAXED, __HIP_MEMORY_SCOPE_AGENT)) >= want) break;
                if (__builtin_amdgcn_s_memrealtime() - t0 > 2000000ull) {
                    if (lane == 0) { unsigned expect = 0u; __hip_atomic_compare_exchange_strong(tmo + 1, &expect, code | (unsigned)(u.pm & 0xff), __ATOMIC_RELAXED, __ATOMIC_RELAXED, __HIP_MEMORY_SCOPE_AGENT);
                                     __hip_atomic_store(tmo, 1u, __ATOMIC_RELAXED, __HIP_MEMORY_SCOPE_AGENT); }
                    dead = true; break; }
                __builtin_amdgcn_s_sleep(2);
            }
            __builtin_amdgcn_fence(__ATOMIC_ACQUIRE, "agent");
            if (lane == 0) flag[0] = dead ? 1u : 0u;
        }
        asm volatile("s_waitcnt vmcnt(0) lgkmcnt(0)" ::: "memory"); __builtin_amdgcn_s_barrier(); asm volatile("" ::: "memory");
        const bool bad = flag[0] != 0u;
        if (lane < 32) {
            const unsigned long long* slot = (const unsigned long long*)xbuf + (size_t)(u.pm * BM + row) * 4; float mt[4], m2[4]; float ms = 0.f;
#pragma unroll
            for (int t = 0; t < 4; ++t) { if (t < ntn) { const unsigned long long w = __hip_atomic_load(slot + t, __ATOMIC_RELAXED, __HIP_MEMORY_SCOPE_AGENT); mt[t] = __uint_as_float((unsigned)w); m2[t] = __uint_as_float((unsigned)(w >> 32)); } else { mt[t] = 0.f; m2[t] = 0.f; } ms += mt[t]; }
            const float mean = ms / (float)ntn; float q = 0.f;
#pragma unroll
            for (int t = 0; t < 4; ++t) if (t < ntn) { const float dm = mt[t] - mean; q += m2[t] + 256.0f * dm * dm; }
            S[row] = (f32x2v){mean, 1.0f / sqrtf(q / (256.0f * (float)ntn) + eps)};
        }
        asm volatile("s_waitcnt lgkmcnt(0)" ::: "memory"); __builtin_amdgcn_s_barrier(); asm volatile("" ::: "memory");
        return bad;
    }
};
struct EpiLnRes {
    static constexpr bool PERM = false, AFTER_DRAIN = true;
    const float* base; float* out; int ldc; const float* bias; PanelStats st; unsigned poison;
    __device__ __forceinline__ void fused(f32x4 (&acc)[2][2][4][2], const Unit& u, int wr, int wc, int fr, int fq, PG8_LAS unsigned char* lds, int wid, int lane) const {
        typedef float f32x2v __attribute__((ext_vector_type(2)));
        const PG8_LAS f32x2v* S = (const PG8_LAS f32x2v*)(lds + 8192);
        const int col0 = u.pn * BM + wc * 32 + 4 * fq;
#pragma unroll
        for (int bj = 0; bj < 2; ++bj)
#pragma unroll
            for (int n = 0; n < 2; ++n) { const f32x4 bv = bias ? *(const f32x4*)(bias + col0 + bj * HALF + n * 16) : (f32x4){0.f, 0.f, 0.f, 0.f};
#pragma unroll
                for (int ai = 0; ai < 2; ++ai)
#pragma unroll
                    for (int m = 0; m < 4; ++m) acc[ai][bj][m][n] += bv; }
        f32x4 pre[4][2][2];
#pragma unroll
        for (int m = 0; m < 4; ++m) { const size_t off = (size_t)(u.pm * BM + wr * 64 + m * 16 + fr) * ldc + col0;
#pragma unroll
            for (int bj = 0; bj < 2; ++bj)
#pragma unroll
                for (int n = 0; n < 2; ++n) pre[m][bj][n] = *(const f32x4*)(base + off + bj * HALF + n * 16); }
        const bool bad = st.run(acc, u, wr, wc, fr, fq, lds, wid, lane) || poison != 0u;
        const float qnan = __builtin_nanf("");
#pragma unroll
        for (int ai = 0; ai < 2; ++ai)
#pragma unroll
            for (int m = 0; m < 4; ++m) { const int r = ai * HALF + wr * 64 + m * 16 + fr; const f32x2v sr = S[r]; const size_t off = (size_t)(u.pm * BM + r) * ldc + col0;
#pragma unroll
                for (int bj = 0; bj < 2; ++bj)
#pragma unroll
                    for (int n = 0; n < 2; ++n) { const f32x4 bs = ai == 0 ? pre[m][bj][n] : *(const f32x4*)(base + off + bj * HALF + n * 16); f32x4 o = bs + (acc[ai][bj][m][n] - sr.x) * sr.y;
                        if (bad) o = (f32x4){qnan, qnan, qnan, qnan}; *(f32x4*)(out + off + bj * HALF + n * 16) = o; }
                if (m & 1) asm volatile("" ::: "memory"); }
    }
};
struct EpiLnResLn {
    static constexpr bool PERM = false, AFTER_DRAIN = true;
    const float* base; float* out; bf16_t* xn; int ldc; const float* bias; PanelStats st1, st2; unsigned poison;
    __device__ __forceinline__ void fused(f32x4 (&acc)[2][2][4][2], const Unit& u, int wr, int wc, int fr, int fq, PG8_LAS unsigned char* lds, int wid, int lane) const {
        typedef float f32x2v __attribute__((ext_vector_type(2))); typedef unsigned u32x2v __attribute__((ext_vector_type(2)));
        const PG8_LAS f32x2v* S = (const PG8_LAS f32x2v*)(lds + 8192);
        const int col0 = u.pn * BM + wc * 32 + 4 * fq;
#pragma unroll
        for (int bj = 0; bj < 2; ++bj)
#pragma unroll
            for (int n = 0; n < 2; ++n) { const f32x4 bv = bias ? *(const f32x4*)(bias + col0 + bj * HALF + n * 16) : (f32x4){0.f, 0.f, 0.f, 0.f};
#pragma unroll
                for (int ai = 0; ai < 2; ++ai)
#pragma unroll
                    for (int m = 0; m < 4; ++m) acc[ai][bj][m][n] += bv; }
        bool bad = st1.run(acc, u, wr, wc, fr, fq, lds, wid, lane) || poison != 0u;
        const float qnan = __builtin_nanf("");
#pragma unroll
        for (int ai = 0; ai < 2; ++ai)
#pragma unroll
            for (int m = 0; m < 4; ++m) { const int r = ai * HALF + wr * 64 + m * 16 + fr; const f32x2v sr = S[r]; const size_t off = (size_t)(u.pm * BM + r) * ldc + col0;
#pragma unroll
                for (int bj = 0; bj < 2; ++bj)
#pragma unroll
                    for (int n = 0; n < 2; ++n) { const f32x4 bs = *(const f32x4*)(base + off + bj * HALF + n * 16); acc[ai][bj][m][n] = bs + (acc[ai][bj][m][n] - sr.x) * sr.y; }
                asm volatile("" : "+v"(acc[ai][0][m][0]), "+v"(acc[ai][0][m][1]), "+v"(acc[ai][1][m][0]), "+v"(acc[ai][1][m][1]));
                if (m & 1) asm volatile("" ::: "memory"); }
        const bool bad1 = bad;
        bad = st2.run(acc, u, wr, wc, fr, fq, lds, wid, lane) || bad;
#pragma unroll
        for (int ai = 0; ai < 2; ++ai)
#pragma unroll
            for (int m = 0; m < 4; ++m) { const int r = ai * HALF + wr * 64 + m * 16 + fr; const f32x2v sr = S[r]; const size_t off = (size_t)(u.pm * BM + r) * ldc + col0;
#pragma unroll
                for (int bj = 0; bj < 2; ++bj)
#pragma unroll
                    for (int n = 0; n < 2; ++n) { const f32x4 x1 = acc[ai][bj][m][n]; *(f32x4*)(out + off + bj * HALF + n * 16) = bad1 ? (f32x4){qnan, qnan, qnan, qnan} : x1;
                        const f32x4 o = (x1 - sr.x) * sr.y; u32x2v w; w.x = cvt_pk_bf16(o[0], o[1]); w.y = cvt_pk_bf16(o[2], o[3]);
                        if (bad) { w.x = 0x7fc07fc0u; w.y = 0x7fc07fc0u; } *(u32x2v*)(xn + off + bj * HALF + n * 16) = w; }
                asm volatile("" ::: "memory"); }
    }
};

template <class Epi, class Sched, bool ALIGN_EPI = false, bool SP2 = false>
__device__ __forceinline__ void gemm_phase(PG8_LAS unsigned char* lds, const Gemm g, const Sched& S, const Epi& E) {
    const int tid = threadIdx.x, wid = __builtin_amdgcn_readfirstlane(tid >> 6), lane = tid & 63, wr = wid >> 2, wc = wid & 3, fr = lane & 15, fq = lane >> 4;
    const int K = g.K, nt = K / BK;
    unsigned voffA[2], voffB[2];
#pragma unroll
    for (int i = 0; i < 2; ++i) { int R, C; stage_rc(tid * 16 + i * 8192, R, C); const int Rb = Epi::PERM ? ((R & ~31) + perm32(R & 31)) : R;
        voffA[i] = (unsigned)(R * K + C) * 2u; voffB[i] = (unsigned)(Rb * K + C) * 2u; }
    const size_t kstep = (size_t)(BK * 2);
    const size_t hstep = (size_t)HALF * K * 2;
    const size_t tstep = 2 * hstep;
    const unsigned ldsw = (unsigned)wid * 1024u;
    const int aoff = lds_byte(wr * 64 + fr, fq * 8), boff = lds_byte(wc * 32 + fr, fq * 8);
#define PG8_SA(b, h) (((b) * 2 + (h)) * HTB)
#define PG8_SB(b, h) ((4 + (b) * 2 + (h)) * HTB)
#define PG8_STAGE(bufoff, gbase, voff) do { _Pragma("unroll") for (int _i = 0; _i < 2; ++_i) \
        __builtin_amdgcn_global_load_lds((const unsigned*)((const char*)(gbase) + (voff)[_i]), (PG8_LAS unsigned*)(lds + (bufoff) + ldsw + _i * 8192), 16, 0, 0); } while (0)
#define PG8_LDA(dst, b, h) do { _Pragma("unroll") for (int m = 0; m < 4; ++m) _Pragma("unroll") for (int k = 0; k < 2; ++k) dst[m][k] = *(const PG8_LAS bf16x8*)(lds + PG8_SA(b, h) + aoff + m * 2048 + k * 1024); } while (0)
#define PG8_LDB(dst, b, h) do { _Pragma("unroll") for (int n = 0; n < 2; ++n) _Pragma("unroll") for (int k = 0; k < 2; ++k) dst[n][k] = *(const PG8_LAS bf16x8*)(lds + PG8_SB(b, h) + boff + n * 2048 + k * 1024); } while (0)
#define PG8_MMA(ai, bj, At, Bt) do { __builtin_amdgcn_s_setprio(1); _Pragma("unroll") for (int m = 0; m < 4; ++m) _Pragma("unroll") for (int n = 0; n < 2; ++n) _Pragma("unroll") for (int k = 0; k < 2; ++k) \
        acc[ai][bj][m][n] = __builtin_amdgcn_mfma_f32_16x16x32_bf16(Bt[n][k], At[m][k], acc[ai][bj][m][n], 0, 0, 0); __builtin_amdgcn_s_setprio(0); } while (0)
#define PG8_WAIT_V(n) asm volatile("s_waitcnt vmcnt(" #n ")" ::: "memory")
#define PG8_WAIT_L(n) asm volatile("s_waitcnt lgkmcnt(" #n ")" ::: "memory")
#define PG8_BAR __builtin_amdgcn_s_barrier()
#define PG8_SCHED __builtin_amdgcn_sched_barrier(0)
    Unit cur, nxt; int ui = 0;
    if (!S.next(0, cur)) return;
    f32x4 acc[2][2][4][2];
#pragma unroll
    for (int a = 0; a < 2; ++a)
#pragma unroll
        for (int b = 0; b < 2; ++b)
#pragma unroll
            for (int m = 0; m < 4; ++m)
#pragma unroll
                for (int n = 0; n < 2; ++n) acc[a][b][m][n] = (f32x4){0.f, 0.f, 0.f, 0.f};
    bf16x8 At[4][2], B0[2][2], B1[2][2];
    const char* cA = (const char*)g.A + (size_t)cur.pm * tstep; const char* cB = (const char*)g.Bt + (size_t)cur.pn * tstep;
    S.a_ready(cur);
    if constexpr (SP2) {
        PG8_STAGE(PG8_SB(0, 0), cB, voffB); PG8_STAGE(PG8_SB(0, 1), cB + hstep, voffB); PG8_STAGE(PG8_SA(0, 0), cA, voffA); PG8_STAGE(PG8_SA(0, 1), cA + hstep, voffA);
        if (wr == 1) PG8_BAR;
        PG8_WAIT_V(2); PG8_BAR;
        PG8_STAGE(PG8_SB(1, 0), cB + kstep, voffB); PG8_STAGE(PG8_SA(1, 0), cA + kstep, voffA); PG8_STAGE(PG8_SB(1, 1), cB + hstep + kstep, voffB);
        PG8_WAIT_V(6); PG8_BAR;
    } else {
        PG8_STAGE(PG8_SB(0, 0), cB, voffB); PG8_STAGE(PG8_SA(0, 0), cA, voffA); PG8_STAGE(PG8_SB(0, 1), cB + hstep, voffB); PG8_STAGE(PG8_SA(0, 1), cA + hstep, voffA);
        if (wr == 1) PG8_BAR;
        PG8_WAIT_V(4); PG8_BAR;
        PG8_STAGE(PG8_SB(1, 0), cB + kstep, voffB); PG8_STAGE(PG8_SA(1, 0), cA + kstep, voffA); PG8_STAGE(PG8_SB(1, 1), cB + hstep + kstep, voffB);
        PG8_WAIT_V(6); PG8_BAR;
    }
    for (;;) {
        const bool has_next = S.next(ui + 1, nxt);
        const char* nA = has_next ? (const char*)g.A + (size_t)nxt.pm * tstep : cA; const char* nB = has_next ? (const char*)g.Bt + (size_t)nxt.pn * tstep : cB;
        for (int t = 0; t < nt; t += 2) {
            const bool last = (t == nt - 2);
            const char* a1 = cA + (size_t)(t + 1) * kstep;
            const char* a2 = last ? nA : cA + (size_t)(t + 2) * kstep; const char* b2 = last ? nB : cB + (size_t)(t + 2) * kstep;
            const char* a3 = a2 + kstep; const char* b3 = b2 + kstep;
            if (last && has_next) S.a_ready(nxt);
            if constexpr (SP2) {
            PG8_LDB(B0, 0, 0); PG8_LDB(B1, 0, 1); PG8_SCHED; PG8_LDA(At, 0, 0); PG8_STAGE(PG8_SA(1, 1), a1 + hstep, voffA);
            PG8_WAIT_V(8); PG8_WAIT_L(0); PG8_BAR; PG8_MMA(0, 0, At, B0); PG8_MMA(0, 1, At, B1); PG8_BAR; PG8_SCHED;
            PG8_LDA(At, 0, 1); PG8_STAGE(PG8_SB(0, 0), b2, voffB); PG8_STAGE(PG8_SB(0, 1), b2 + hstep, voffB); PG8_STAGE(PG8_SA(0, 0), a2, voffA);
            PG8_WAIT_V(8); PG8_WAIT_L(0); PG8_BAR; PG8_MMA(1, 0, At, B0); PG8_MMA(1, 1, At, B1); PG8_BAR; PG8_SCHED;
            PG8_LDB(B0, 1, 0); PG8_LDB(B1, 1, 1); PG8_SCHED; PG8_LDA(At, 1, 0); PG8_STAGE(PG8_SA(0, 1), a2 + hstep, voffA);
            PG8_WAIT_V(8); PG8_WAIT_L(0); PG8_BAR; PG8_MMA(0, 0, At, B0); PG8_MMA(0, 1, At, B1); PG8_BAR; PG8_SCHED;
            PG8_LDA(At, 1, 1); PG8_STAGE(PG8_SB(1, 0), b3, voffB); PG8_STAGE(PG8_SB(1, 1), b3 + hstep, voffB); PG8_STAGE(PG8_SA(1, 0), a3, voffA);
            PG8_WAIT_V(8); PG8_WAIT_L(0); PG8_BAR; PG8_MMA(1, 0, At, B0); PG8_MMA(1, 1, At, B1); PG8_BAR; PG8_SCHED;
            } else {
            PG8_LDB(B0, 0, 0); PG8_SCHED; PG8_LDA(At, 0, 0); PG8_STAGE(PG8_SA(1, 1), a1 + hstep, voffA);
            PG8_WAIT_L(8); PG8_BAR; PG8_WAIT_L(0); PG8_MMA(0, 0, At, B0); PG8_BAR; PG8_SCHED;
            PG8_LDB(B1, 0, 1); PG8_STAGE(PG8_SB(0, 0), b2, voffB);
            PG8_BAR; PG8_WAIT_L(0); PG8_MMA(0, 1, At, B1); PG8_BAR;
            PG8_LDA(At, 0, 1); PG8_STAGE(PG8_SA(0, 0), a2, voffA);
            PG8_BAR; PG8_WAIT_L(0); PG8_MMA(1, 0, At, B0); PG8_BAR; PG8_SCHED;
            PG8_STAGE(PG8_SB(0, 1), b2 + hstep, voffB);
            PG8_WAIT_V(6); PG8_BAR; PG8_MMA(1, 1, At, B1); PG8_BAR;
            PG8_LDB(B0, 1, 0); PG8_SCHED; PG8_LDA(At, 1, 0); PG8_STAGE(PG8_SA(0, 1), a2 + hstep, voffA);
            PG8_WAIT_L(8); PG8_BAR; PG8_WAIT_L(0); PG8_MMA(0, 0, At, B0); PG8_BAR; PG8_SCHED;
            PG8_LDB(B1, 1, 1); PG8_STAGE(PG8_SB(1, 0), b3, voffB);
            PG8_BAR; PG8_WAIT_L(0); PG8_MMA(0, 1, At, B1); PG8_BAR;
            PG8_LDA(At, 1, 1); PG8_STAGE(PG8_SA(1, 0), a3, voffA);
            PG8_BAR; PG8_WAIT_L(0); PG8_MMA(1, 0, At, B0); PG8_BAR; PG8_SCHED;
            PG8_STAGE(PG8_SB(1, 1), b3 + hstep, voffB);
            PG8_WAIT_V(6); PG8_BAR; PG8_MMA(1, 1, At, B1); PG8_BAR;
            }
        }
        if constexpr (ALIGN_EPI) { if (wr == 0) PG8_BAR; }
        if constexpr (!Epi::AFTER_DRAIN) { E(acc, cur, wr, wc, fr, fq); S.done(cur); }
        if (!has_next) break;
#pragma unroll
        for (int a = 0; a < 2; ++a)
#pragma unroll
            for (int b = 0; b < 2; ++b)
#pragma unroll
                for (int m = 0; m < 4; ++m)
#pragma unroll
                    for (int n = 0; n < 2; ++n) acc[a][b][m][n] = (f32x4){0.f, 0.f, 0.f, 0.f};
        cur = nxt; cA = nA; cB = nB; ++ui;
        if constexpr (ALIGN_EPI) { if (wr == 1) PG8_BAR; }
    }
    PG8_WAIT_V(0);
    if constexpr (!ALIGN_EPI) { if (wr == 0) PG8_BAR; }
    PG8_BAR;
    if constexpr (Epi::AFTER_DRAIN) { E.fused(acc, cur, wr, wc, fr, fq, lds, wid, lane); S.done(cur); }
#undef PG8_SA
#undef PG8_SB
#undef PG8_STAGE
#undef PG8_LDA
#undef PG8_LDB
#undef PG8_MMA
#undef PG8_WAIT_V
#undef PG8_WAIT_L
#undef PG8_BAR
#undef PG8_SCHED
}
}

namespace pg8 {
__device__ __forceinline__ float sigm(float x) { return 1.0f / (1.0f + __expf(-x)); }
__device__ __forceinline__ u32x4 pack8(const f32x4 a, const f32x4 b) { u32x4 w; w.x = cvt_pk_bf16(a[0], a[1]); w.y = cvt_pk_bf16(a[2], a[3]); w.z = cvt_pk_bf16(b[0], b[1]); w.w = cvt_pk_bf16(b[2], b[3]); return w; }

struct EpiF32 {
    static constexpr bool PERM = false, AFTER_DRAIN = false;
    float* C; int ldc;
    __device__ __forceinline__ void operator()(const f32x4 (&acc)[2][2][4][2], const Unit& u, int wr, int wc, int fr, int fq) const {
        const int row0 = u.pm * BM + wr * 64 + fr, col0 = u.pn * BM + wc * 32 + 4 * fq;
#pragma unroll
        for (int ai = 0; ai < 2; ++ai)
#pragma unroll
            for (int m = 0; m < 4; ++m) { float* rowp = C + (size_t)(row0 + ai * HALF + m * 16) * ldc + col0;
#pragma unroll
                for (int bj = 0; bj < 2; ++bj)
#pragma unroll
                    for (int n = 0; n < 2; ++n) *(f32x4*)(rowp + bj * HALF + n * 16) = acc[ai][bj][m][n]; }
    }
};

constexpr int MPROMPT = 16384;
struct EpiIn {
    static constexpr bool PERM = true, AFTER_DRAIN = false;
    bf16_t *Q, *K, *V, *HQ, *KK, *HI, *HG; float* LF; bf16_t *GA, *GB, *GAs, *GBs; float *okp, *ovp, *oks, *ovs; const float* lb; float qscale;
    template <int TYPE> __device__ __forceinline__ void tile(const f32x4 (&acc)[2][2][4][2], const Unit& u, int ct, int wr, int wc, int fr, int fq) const {
        const bool samp = (u.pm == MPROMPT / BM);
        const int colb = ct * BM + wc * 32 + 8 * fq;
        f32x4 lbv[2][2];
        if (TYPE == 4) {
#pragma unroll
            for (int bj = 0; bj < 2; ++bj) { lbv[bj][0] = *(const f32x4*)(lb + colb + bj * HALF); lbv[bj][1] = *(const f32x4*)(lb + colb + bj * HALF + 4); }
        }
#pragma unroll
        for (int ai = 0; ai < 2; ++ai)
#pragma unroll
            for (int m = 0; m < 4; ++m) {
                const int row = u.pm * BM + ai * HALF + wr * 64 + m * 16 + fr; const int lrow = row - MPROMPT;
#pragma unroll
                for (int bj = 0; bj < 2; ++bj) {
                    const int col = colb + bj * HALF; f32x4 v0 = acc[ai][bj][m][0], v1 = acc[ai][bj][m][1];
                    if (TYPE == 0) { *(u32x4*)(Q + (size_t)row * 512 + col) = pack8(v0 * qscale, v1 * qscale); }
                    else if (TYPE == 1 || TYPE == 2) {
                        bf16_t* B = TYPE == 1 ? K : V; *(u32x4*)(B + (size_t)row * 512 + col) = pack8(v0, v1);
                        float* o = nullptr;
                        if (!samp) o = (TYPE == 1 ? okp : ovp) + (size_t)row * 512 + col; else if (lrow < 128) o = (TYPE == 1 ? oks : ovs) + (size_t)lrow * 512 + col;
                        if (o) { *(f32x4*)o = v0; *(f32x4*)(o + 4) = v1; }
                    }
                    else if (TYPE == 3) { *(u32x4*)(HQ + (size_t)row * 512 + col) = pack8(v0, v1); }
                    else if (TYPE == 4) {
                        f32x4 f0, f1, l0, l1;
#pragma unroll
                        for (int j = 0; j < 4; ++j) { const float a = lbv[bj][0][j], b = lbv[bj][1][j];
                            f0[j] = a + (1.0f - a) * sigm(v0[j]); f1[j] = b + (1.0f - b) * sigm(v1[j]); l0[j] = __logf(f0[j]); l1[j] = __logf(f1[j]); }
                        float* lp = LF + (size_t)row * 512 + col; *(f32x4*)lp = l0; *(f32x4*)(lp + 4) = l1;
                        *(u32x4*)(KK + (size_t)row * 512 + col) = pack8(1.0f - f0, 1.0f - f1);
                    }
                    else if (TYPE == 5) { *(u32x4*)(HI + (size_t)row * 512 + col) = pack8(v0, v1); }
                    else {
                        f32x4 s0, s1;
#pragma unroll
                        for (int j = 0; j < 4; ++j) { s0[j] = sigm(v0[j]); s1[j] = sigm(v1[j]); }
                        if (TYPE == 6) *(u32x4*)(HG + (size_t)row * 512 + col) = pack8(s0, s1);
                        else { bf16_t* G = samp ? ((TYPE == 7 ? GAs : GBs) + (size_t)lrow * 1024) : ((TYPE == 7 ? GA : GB) + (size_t)row * 1024); *(u32x4*)(G + col) = pack8(s0, s1); }
                    }
                }
            }
    }
    __device__ __forceinline__ void operator()(const f32x4 (&acc)[2][2][4][2], const Unit& u, int wr, int wc, int fr, int fq) const {
        const int pn = u.pn;
        if (pn < 14) { const int ct = pn & 1;
            switch (pn >> 1) { case 0: tile<0>(acc, u, ct, wr, wc, fr, fq); break; case 1: tile<1>(acc, u, ct, wr, wc, fr, fq); break; case 2: tile<2>(acc, u, ct, wr, wc, fr, fq); break;
                               case 3: tile<3>(acc, u, ct, wr, wc, fr, fq); break; case 4: tile<4>(acc, u, ct, wr, wc, fr, fq); break; case 5: tile<5>(acc, u, ct, wr, wc, fr, fq); break;
                               default: tile<6>(acc, u, ct, wr, wc, fr, fq); break; } }
        else if (pn < 18) tile<7>(acc, u, pn - 14, wr, wc, fr, fq);
        else tile<8>(acc, u, pn - 18, wr, wc, fr, fq);
    }
};

constexpr int DFF = 2816;
struct EpiUpSplit {
    static constexpr bool PERM = true, AFTER_DRAIN = false;
    bf16_t *A, *G; float *cp, *cs;
    __device__ __forceinline__ void operator()(const f32x4 (&acc)[2][2][4][2], const Unit& u, int wr, int wc, int fr, int fq) const {
        const int cidx = 128 * u.pn + wc * 32 + 8 * fq;
#pragma unroll
        for (int ai = 0; ai < 2; ++ai)
#pragma unroll
            for (int m = 0; m < 4; ++m) {
                const int row = u.pm * BM + ai * HALF + wr * 64 + m * 16 + fr; const int lrow = row - MPROMPT;
                *(u32x4*)(A + (size_t)row * DFF + cidx) = pack8(acc[ai][0][m][0], acc[ai][0][m][1]);
                *(u32x4*)(G + (size_t)row * DFF + cidx) = pack8(acc[ai][1][m][0], acc[ai][1][m][1]);
                float* o = nullptr;
                if (row == MPROMPT - 2 || row == MPROMPT - 1) o = cp + (size_t)(row - (MPROMPT - 2)) * DFF + cidx;
                else if (lrow >= 0 && lrow < 128 && (lrow & 15) >= 14) o = cs + (size_t)((lrow >> 4) * 2 + ((lrow & 15) - 14)) * DFF + cidx;
                if (o) { *(f32x4*)o = acc[ai][0][m][0]; *(f32x4*)(o + 4) = acc[ai][0][m][1]; }
            }
    }
};
}

constexpr int NWAVES = 8, NTHR = 512;
constexpr int DMODEL = 1024, MP = 16384, MS = 128, MTOT = MP + MS, MPAD = 16640;
constexpr int FW = 512, NINP = 5632, NIN = 5640, DFF = 2816, PAST = 4096, SKS = 4112;
constexpr float RMS_EPS = 1e-6f, LOG2E = 1.4426950408889634f, C2 = 0.125f * 1.4426950408889634f;
constexpr size_t OFF_Y = 0, OFF_YS = 16777216, OFF_PK = 16908288, OFF_PV = 25296896, OFF_PLF = 33685504, OFF_PH = 33816576, OFF_PC = 33882112,
                 OFF_SK = 33887744, OFF_SV = 33953280, OFF_SLF = 34018816, OFF_SH = 34019840, OFF_SC = 34544128, OUT_TOTAL = 34589184;
constexpr size_t MiB = 1u << 20;
constexpr size_t SZ512 = (size_t)MPAD * 512 * 2, SZ1024 = (size_t)MPAD * 1024 * 2;
constexpr size_t WS_CTL = 0, CTL_ZERO_BYTES = 1 * MiB;
constexpr size_t WS_LB = 1 * MiB, WS_KB = WS_LB + 65536, WS_SKB = WS_KB + 524288;
constexpr size_t WS_GAS = 3 * MiB, WS_GBS = WS_GAS + 524288;
constexpr size_t WS_WIN = 4 * MiB, WS_WBF = 15 * MiB, WS_WBH = 16 * MiB, WS_WOUT = 17 * MiB, WS_WUP = 19 * MiB, WS_WDN = 30 * MiB;
constexpr size_t WS_H1 = 36 * MiB;
constexpr size_t WS_Q = WS_H1 + SZ1024, WS_OH = WS_Q + SZ512, WS_K = WS_OH + SZ512, WS_V = WS_K + SZ512, WS_HQ = WS_V + SZ512, WS_KK = WS_HQ + SZ512,
                 WS_HI = WS_KK + SZ512, WS_HG = WS_HI + SZ512, WS_LF = WS_HG + SZ512, WS_END1 = WS_LF + 2 * SZ512;
constexpr size_t WS_BRF = WS_K, WS_BRH = WS_K + 4 * SZ512, WS_MERGED = WS_H1, WS_MIX = WS_K, WS_H2 = WS_H1;
constexpr size_t WS_ABUF = WS_Q, WS_GBUF = WS_ABUF + (size_t)MPAD * DFF * 2, WS_FFN = WS_Q, WS_END = WS_GBUF + (size_t)MPAD * DFF * 2;
static_assert(WS_END <= 256 * MiB && WS_END1 <= 256 * MiB, "d_ws map");
constexpr int CW_TMO = 0, CW_CODE = 1, CW_BAR = 4096;
constexpr int RING_OFF = 0, RING_BYTES = 131072, LDSCTL_OFF = RING_BYTES, MISC_OFF = LDSCTL_OFF + 320, LDS_BYTES = 147456;

#define GAS __attribute__((address_space(1)))
#define LAS __attribute__((address_space(3)))
typedef unsigned short bf16;
typedef unsigned v4u __attribute__((ext_vector_type(4)));
typedef float f32x4 __attribute__((ext_vector_type(4)));
typedef short bf16x8 __attribute__((ext_vector_type(8)));
typedef GAS unsigned gu32;
typedef GAS unsigned long long gu64;
#define RLX_AGENT __ATOMIC_RELAXED, __HIP_MEMORY_SCOPE_AGENT
#define LDS_WAIT() asm volatile("s_waitcnt lgkmcnt(0)" ::: "memory")
#define VM_WAIT() asm volatile("s_waitcnt vmcnt(0)" ::: "memory")
__device__ __forceinline__ unsigned long long rt() { return __builtin_amdgcn_s_memrealtime(); }
__device__ __forceinline__ unsigned f2bf(float f) { unsigned u = __builtin_bit_cast(unsigned, f); return (u + 0x7fffu + ((u >> 16) & 1u)) >> 16; }
__device__ __forceinline__ unsigned pk2(float lo, float hi) { return f2bf(lo) | (f2bf(hi) << 16); }

#define XB_TMO      128
#define XB_XCNT(j)  (256  + 64 * (j))
#define XB_XSUB(j)  (1280 + 64 * (j))
#define XB_XGEN(j)  (2304 + 64 * (j))
#define XB_TOP      3328
#define XB_TOPGEN   3392
#define XCD_BAR_WORDS 3456
#define XB_SPIN_CAP (1u << 26)

__device__ __forceinline__ unsigned xb_ld(unsigned* p)              { return __hip_atomic_load(p, __ATOMIC_RELAXED, __HIP_MEMORY_SCOPE_AGENT); }
__device__ __forceinline__ unsigned xb_add(unsigned* p, unsigned v) { return __hip_atomic_fetch_add(p, v, __ATOMIC_RELAXED, __HIP_MEMORY_SCOPE_AGENT); }
__device__ __forceinline__ unsigned xb_xcc_id() { return (unsigned)__builtin_amdgcn_s_getreg((3 << 11) | 20) & 0xFu; }
#define XB_SPIN(cond, bar) do { unsigned _sp = 0; while (cond) { __builtin_amdgcn_s_sleep(1); \
    if ((++_sp & 255u) == 0u) { if (xb_ld(&(bar)[XB_TMO])) break; if (_sp > XB_SPIN_CAP) { atomicAdd(&(bar)[XB_TMO], 1u); break; } } } } while (0)

struct XcdBarrier {
    unsigned* bar; unsigned x;
    volatile LAS unsigned* st;
};

__device__ __forceinline__ XcdBarrier xcd_barrier_post(unsigned* bar, volatile LAS unsigned* st) {
    XcdBarrier b; b.bar = bar; b.x = xb_xcc_id(); b.st = st;
    if (threadIdx.x == 0) (void)xb_add(&bar[XB_XCNT(b.x)], 1u);
    return b;
}
__device__ __forceinline__ void xcd_barrier_complete(unsigned* bar, unsigned x, unsigned& nloc, unsigned& nx) {
    const unsigned G = gridDim.x * gridDim.y * gridDim.z;
    unsigned sum, cnt, mine, sp = 0u;
    for (;;) {
        sum = 0u; cnt = 0u; mine = 0u;
#pragma unroll
        for (unsigned j = 0; j < 16; ++j) { const unsigned c = xb_ld(&bar[XB_XCNT(j)]); sum += c; cnt += (c > 0u) ? 1u : 0u; mine = (j == x) ? c : mine; }
        if (sum == G) break;
        __builtin_amdgcn_s_sleep(1);
        if ((++sp & 255u) == 0u) { if (xb_ld(&bar[XB_TMO])) break; if (sp > XB_SPIN_CAP) { atomicAdd(&bar[XB_TMO], 1u); break; } }
    }
    nloc = mine > 0u ? mine : 1u; nx = cnt > 0u ? cnt : 1u;
}

__device__ __forceinline__ void xcd_barrier(const XcdBarrier& b) {
    asm volatile("s_waitcnt vmcnt(0)" ::: "memory");
    __syncthreads();
    if (threadIdx.x == 0) {
        unsigned* bar = b.bar;
        __builtin_amdgcn_s_waitcnt(0);
        unsigned nloc = b.st[0], nx = b.st[1];
        if (nloc == 0u) { xcd_barrier_complete(bar, b.x, nloc, nx); b.st[0] = nloc; b.st[1] = nx; }
        const unsigned old = xb_add(&bar[XB_XSUB(b.x)], 1u);
        const unsigned gen = old / nloc;
        if (old + 1u == (gen + 1u) * nloc) {
            __builtin_amdgcn_fence(__ATOMIC_RELEASE, "agent");
            asm volatile("s_waitcnt vmcnt(0)" ::: "memory");
            const unsigned og = xb_add(&bar[XB_TOP], 1u);
            const unsigned tg = og / nx;
            if (og + 1u == (tg + 1u) * nx) xb_add(&bar[XB_TOPGEN], 1u);
            else XB_SPIN(xb_ld(&bar[XB_TOPGEN]) == tg, bar);
            __builtin_amdgcn_fence(__ATOMIC_ACQUIRE, "agent");
            xb_add(&bar[XB_XGEN(b.x)], 1u);
            asm volatile("s_waitcnt vmcnt(0)" ::: "memory");
        } else {
            XB_SPIN(xb_ld(&bar[XB_XGEN(b.x)]) == gen, bar);
            __builtin_amdgcn_fence(__ATOMIC_ACQUIRE, "agent");
            asm volatile("s_waitcnt vmcnt(0)" ::: "memory");
        }
    }
    __syncthreads();
}


__device__ __forceinline__ float wave_sum(float v) {
#pragma unroll
    for (int o = 1; o < 64; o <<= 1) v += __shfl_xor(v, o);
    return v;
}
__device__ __forceinline__ float bf2f(unsigned short b) { return __builtin_bit_cast(float, (unsigned)b << 16); }
__device__ __forceinline__ float bflo(unsigned u) { return __builtin_bit_cast(float, u << 16); }
__device__ __forceinline__ float bfhi(unsigned u) { return __builtin_bit_cast(float, u & 0xffff0000u); }
__device__ __forceinline__ float sigm(float x) { return 1.0f / (1.0f + __expf(-x)); }

struct Frame {
    LAS unsigned char* lds; volatile LAS unsigned* MISC; gu32* ctl;
    int tid, lane, wave, vcu, G;
    const float *xp, *xs, *ck, *cv, *clf, *sh, *sc, *g_pre, *g_post, *w_in, *fbias, *lbl, *hgn, *w_bf, *w_bh, *w_out, *g_pre2, *g_post2, *w_up, *cw, *cb, *w_dn;
    float* out; unsigned char* ws;
};
#define WSP(T, off) ((T*)(F.ws + (off)))

__device__ __forceinline__ void tr_item(const float* W, int ldW, bf16* WT, int Kd, int k0, int nsrc0, int drow0, LAS float* scr, int lane) {
#pragma unroll 8
    for (int i = 0; i < 32; ++i) { const int kk = 2 * i + (lane >> 5); scr[kk * 33 + (lane & 31)] = W[(size_t)(k0 + kk) * ldW + nsrc0 + (lane & 31)]; }
    LDS_WAIT(); asm volatile("" ::: "memory");
    const int c = lane & 7;
#pragma unroll
    for (int j = 0; j < 4; ++j) { const int n = (lane >> 3) + 8 * j; const LAS float* s = scr + (8 * c) * 33 + n;
        v4u o; o.x = pk2(s[0 * 33], s[1 * 33]); o.y = pk2(s[2 * 33], s[3 * 33]); o.z = pk2(s[4 * 33], s[5 * 33]); o.w = pk2(s[6 * 33], s[7 * 33]);
        *(GAS v4u*)(WT + (size_t)(drow0 + n) * Kd + k0 + 8 * c) = o; }
    LDS_WAIT(); asm volatile("" ::: "memory");
}
__device__ __forceinline__ void p0_prologue(Frame& F) {
    LAS float* scr = (LAS float*)(F.lds + RING_OFF + F.wave * 16384);
    const int gw = F.vcu * NWAVES + F.wave, NGW = F.G * NWAVES;
    constexpr int I0 = 16 * 48, I1 = 16 * 128, I2 = 8 * 32, I3 = 8 * 32, I4 = 16 * 32, I5 = 16 * 176, I6 = 44 * 32, NITEMS = I0 + I1 + I2 + I3 + I4 + I5 + I6;
    for (int it = gw; it < NITEMS; it += NGW) {
        int r = it;
        if (r < I0) { const int kb = r / 48, nb = r % 48; tr_item(F.w_in, NIN, WSP(bf16, WS_WIN), 1024, 64 * kb, 32 * nb, 32 * nb, scr, F.lane); continue; } r -= I0;
        if (r < I1) { const int kb = r / 128, nb = r % 128; tr_item(F.w_in, NIN, WSP(bf16, WS_WIN), 1024, 64 * kb, 1544 + 32 * nb, 1536 + 32 * nb, scr, F.lane); continue; } r -= I1;
        if (r < I2) { const int kb = r / 32, nb = r % 32; tr_item(F.w_bf, 1024, WSP(bf16, WS_WBF), 512, 64 * kb, 32 * nb, 32 * nb, scr, F.lane); continue; } r -= I2;
        if (r < I3) { const int kb = r / 32, nb = r % 32; tr_item(F.w_bh, 1024, WSP(bf16, WS_WBH), 512, 64 * kb, 32 * nb, 32 * nb, scr, F.lane); continue; } r -= I3;
        if (r < I4) { const int kb = r / 32, nb = r % 32; tr_item(F.w_out, 1024, WSP(bf16, WS_WOUT), 1024, 64 * kb, 32 * nb, 32 * nb, scr, F.lane); continue; } r -= I4;
        if (r < I5) { const int kb = r / 176, nb = r % 176; const int drow = nb < 88 ? (nb >> 2) * 256 + (nb & 3) * 32 : ((nb - 88) >> 2) * 256 + 128 + ((nb - 88) & 3) * 32;
                      tr_item(F.w_up, 2 * DFF, WSP(bf16, WS_WUP), 1024, 64 * kb, 32 * nb, drow, scr, F.lane); continue; } r -= I5;
        { const int kb = r / 32, nb = r % 32; tr_item(F.w_dn, 1024, WSP(bf16, WS_WDN), DFF, 64 * kb, 32 * nb, 32 * nb, scr, F.lane); }
    }
    __syncthreads();
    LAS float* wf = (LAS float*)(F.lds + RING_OFF);
    for (int i = F.tid; i < 8192; i += NTHR) wf[i] = F.w_in[(size_t)(i >> 3) * NIN + 1536 + (i & 7)];
    __syncthreads();
    bf16* H1 = WSP(bf16, WS_H1);
    for (int m = gw; m < MTOT; m += NGW) {
        const float* xr = m < MP ? F.xp + (size_t)m * DMODEL : F.xs + (size_t)(m - MP) * DMODEL;
        f32x4 v[4]; float s = 0.f;
#pragma unroll
        for (int j = 0; j < 4; ++j) { v[j] = ((const GAS f32x4*)xr)[F.lane + 64 * j]; s += (v[j].x * v[j].x + v[j].y * v[j].y) + (v[j].z * v[j].z + v[j].w * v[j].w); }
        const float inv = 1.0f / sqrtf(wave_sum(s) * (1.f / DMODEL) + RMS_EPS);
        float ff[8];
#pragma unroll
        for (int i = 0; i < 8; ++i) ff[i] = 0.f;
#pragma unroll
        for (int j = 0; j < 4; ++j) { const f32x4 g = ((const GAS f32x4*)F.g_pre)[F.lane + 64 * j]; v[j] = (v[j] * inv) * g;
            GAS unsigned long long* o8 = (GAS unsigned long long*)(H1 + (size_t)m * DMODEL) + F.lane + 64 * j;
            *o8 = (unsigned long long)pk2(v[j].x, v[j].y) | ((unsigned long long)pk2(v[j].z, v[j].w) << 32);
#pragma unroll
            for (int e = 0; e < 4; ++e) { const LAS f32x4* wr = (const LAS f32x4*)(wf + (size_t)(4 * (F.lane + 64 * j) + e) * 8); const f32x4 a = wr[0], b = wr[1]; const float hv = v[j][e];
                ff[0] += hv * a.x; ff[1] += hv * a.y; ff[2] += hv * a.z; ff[3] += hv * a.w; ff[4] += hv * b.x; ff[5] += hv * b.y; ff[6] += hv * b.z; ff[7] += hv * b.w; } }
#pragma unroll
        for (int i = 0; i < 8; ++i) ff[i] = wave_sum(ff[i]);
        float mine = ff[0];
#pragma unroll
        for (int i = 1; i < 8; ++i) mine = (F.lane == i) ? ff[i] : mine;
        if (F.lane < 8) { const float xv = mine + F.fbias[F.lane]; const float ls = fminf(xv, 0.f) - log1pf(__expf(-fabsf(xv)));
            float* o = m < MP ? F.out + OFF_PLF + (size_t)m * 8 : F.out + OFF_SLF + (size_t)(m - MP) * 8; o[F.lane] = ls; }
    }
    { const int gt = F.vcu * NTHR + F.tid; const int n16 = (MPAD - MTOT) * DMODEL * 2 / 16; for (int i = gt; i < n16; i += F.G * NTHR) ((GAS v4u*)(H1 + (size_t)MTOT * DMODEL))[i] = (v4u){0u, 0u, 0u, 0u}; }
    if (blockIdx.x == 0) { float* LB = WSP(float, WS_LB); for (int c = F.tid; c < 512; c += NTHR) LB[c] = sigm(F.lbl[c] - F.lbl[512 + c]); }
}

__device__ __forceinline__ void ph_cum(Frame& F) {
    const int bid = blockIdx.x; LAS double* ld = (LAS double*)(F.lds + RING_OFF);
    if (bid == 0) {
        const float* plf = F.out + OFF_PLF; float* KB = WSP(float, WS_KB); const int h = F.tid & 7, c = F.tid >> 3;
        double s = 0.0; for (int t = 256 * c; t < 256 * c + 256; ++t) s += (double)plf[(size_t)t * 8 + h];
        ld[c * 8 + h] = s; __syncthreads();
        double run = 0.0; for (int cc = 0; cc < c; ++cc) run += ld[cc * 8 + h];
        for (int t = 256 * c; t < 256 * c + 256; ++t) { run += (double)plf[(size_t)t * 8 + h]; KB[(size_t)h * MP + t] = (float)(-run * 1.4426950408889634); }
    } else if (bid <= 8) {
        const int b = bid - 1, h = F.tid & 7, c = F.tid >> 3; const float* cl = F.clf + (size_t)b * PAST * 8; float* SKB = WSP(float, WS_SKB) + (size_t)(b * 8 + h) * SKS;
        double s = 0.0; for (int j = 64 * c; j < 64 * c + 64; ++j) s += (double)cl[(size_t)j * 8 + h];
        ld[c * 8 + h] = s; __syncthreads();
        double run = 0.0; for (int cc = c + 1; cc < 64; ++cc) run += ld[cc * 8 + h];
        for (int j = 64 * c + 63; j >= 64 * c; --j) { SKB[j] = (float)(run * 1.4426950408889634); run += (double)cl[(size_t)j * 8 + h]; }
        if (c == 0) { const float* slf = F.out + OFF_SLF + (size_t)b * 16 * 8; double r2 = 0.0; for (int i = 0; i < 16; ++i) { r2 += (double)slf[i * 8 + h]; SKB[PAST + i] = (float)(-r2 * 1.4426950408889634); } }
    }
}

__device__ __forceinline__ void ph_attn_naive(Frame& F) {
    const bf16* Q = WSP(bf16, WS_Q); const bf16* K = WSP(bf16, WS_K); const bf16* V = WSP(bf16, WS_V); bf16* O = WSP(bf16, WS_Q); const float* KB = WSP(float, WS_KB);
    for (int unit = blockIdx.x; unit < 256; unit += F.G) {
        const int h = unit >> 5, qb = unit & 31, qi = qb * 512 + F.tid;
        float q[64], o[64];
        { const v4u* qr = (const v4u*)(Q + (size_t)qi * 512 + h * 64);
#pragma unroll
          for (int c = 0; c < 8; ++c) { const v4u w = qr[c]; q[8 * c] = bflo(w.x); q[8 * c + 1] = bfhi(w.x); q[8 * c + 2] = bflo(w.y); q[8 * c + 3] = bfhi(w.y); q[8 * c + 4] = bflo(w.z); q[8 * c + 5] = bfhi(w.z); q[8 * c + 6] = bflo(w.w); q[8 * c + 7] = bfhi(w.w); } }
#pragma unroll
        for (int d = 0; d < 64; ++d) o[d] = 0.f;
        float m = -1e30f, l = 0.f; const int kend = qb * 512 + 511;
        for (int k = 0; k <= kend; ++k) {
            const v4u* kr = (const v4u*)(K + (size_t)k * 512 + h * 64); float s = 0.f;
#pragma unroll
            for (int c = 0; c < 8; ++c) { const v4u w = kr[c]; s += q[8 * c] * bflo(w.x) + q[8 * c + 1] * bfhi(w.x) + q[8 * c + 2] * bflo(w.y) + q[8 * c + 3] * bfhi(w.y) + q[8 * c + 4] * bflo(w.z) + q[8 * c + 5] * bfhi(w.z) + q[8 * c + 6] * bflo(w.w) + q[8 * c + 7] * bfhi(w.w); }
            s += KB[(size_t)h * MP + k];
            if (k <= qi) {
                const float mn = fmaxf(m, s), a = __builtin_amdgcn_exp2f(m - mn), p = __builtin_amdgcn_exp2f(s - mn); l = l * a + p; m = mn;
                const v4u* vr = (const v4u*)(V + (size_t)k * 512 + h * 64);
#pragma unroll
                for (int c = 0; c < 8; ++c) { const v4u w = vr[c];
                    o[8 * c] = o[8 * c] * a + p * bflo(w.x); o[8 * c + 1] = o[8 * c + 1] * a + p * bfhi(w.x); o[8 * c + 2] = o[8 * c + 2] * a + p * bflo(w.y); o[8 * c + 3] = o[8 * c + 3] * a + p * bfhi(w.y);
                    o[8 * c + 4] = o[8 * c + 4] * a + p * bflo(w.z); o[8 * c + 5] = o[8 * c + 5] * a + p * bfhi(w.z); o[8 * c + 6] = o[8 * c + 6] * a + p * bflo(w.w); o[8 * c + 7] = o[8 * c + 7] * a + p * bfhi(w.w); }
            }
        }
        const float rl = 1.0f / l; v4u* orow = (v4u*)(O + (size_t)qi * 512 + h * 64);
#pragma unroll
        for (int c = 0; c < 8; ++c) { v4u w; w.x = pk2(o[8 * c] * rl, o[8 * c + 1] * rl); w.y = pk2(o[8 * c + 2] * rl, o[8 * c + 3] * rl); w.z = pk2(o[8 * c + 4] * rl, o[8 * c + 5] * rl); w.w = pk2(o[8 * c + 6] * rl, o[8 * c + 7] * rl); orow[c] = w; }
    }
}
__device__ __forceinline__ void ph_attn_sample_naive(Frame& F) {
    const bf16* Q = WSP(bf16, WS_Q); const bf16* K = WSP(bf16, WS_K); const bf16* V = WSP(bf16, WS_V); bf16* O = WSP(bf16, WS_Q);
    const int task = blockIdx.x * NWAVES + F.wave; if (task >= 64) return;
    const int b = task >> 3, h = task & 7, qi = F.lane & 15; const size_t row = (size_t)MP + b * 16 + qi; const float* SKB = WSP(float, WS_SKB) + (size_t)(b * 8 + h) * SKS;
    float q[64], o[64];
    { const v4u* qr = (const v4u*)(Q + row * 512 + h * 64);
#pragma unroll
      for (int c = 0; c < 8; ++c) { const v4u w = qr[c]; q[8 * c] = bflo(w.x); q[8 * c + 1] = bfhi(w.x); q[8 * c + 2] = bflo(w.y); q[8 * c + 3] = bfhi(w.y); q[8 * c + 4] = bflo(w.z); q[8 * c + 5] = bfhi(w.z); q[8 * c + 6] = bflo(w.w); q[8 * c + 7] = bfhi(w.w); } }
#pragma unroll
    for (int d = 0; d < 64; ++d) o[d] = 0.f;
    float m = -1e30f, l = 0.f;
    for (int k = 0; k < PAST; ++k) {
        const f32x4* kr = (const f32x4*)(F.ck + ((size_t)(b * PAST + k) * 8 + h) * 64); float s = 0.f;
#pragma unroll
        for (int c = 0; c < 16; ++c) { const f32x4 w = kr[c]; s += q[4 * c] * w.x + q[4 * c + 1] * w.y + q[4 * c + 2] * w.z + q[4 * c + 3] * w.w; }
        s += SKB[k];
        const float mn = fmaxf(m, s), a = __builtin_amdgcn_exp2f(m - mn), p = __builtin_amdgcn_exp2f(s - mn); l = l * a + p; m = mn;
        const f32x4* vr = (const f32x4*)(F.cv + ((size_t)(b * PAST + k) * 8 + h) * 64);
#pragma unroll
        for (int c = 0; c < 16; ++c) { const f32x4 w = vr[c]; o[4 * c] = o[4 * c] * a + p * w.x; o[4 * c + 1] = o[4 * c + 1] * a + p * w.y; o[4 * c + 2] = o[4 * c + 2] * a + p * w.z; o[4 * c + 3] = o[4 * c + 3] * a + p * w.w; }
    }
    for (int i = 0; i < 16; ++i) {
        const size_t kr_ = (size_t)MP + b * 16 + i; const v4u* kr = (const v4u*)(K + kr_ * 512 + h * 64); float s = 0.f;
#pragma unroll
        for (int c = 0; c < 8; ++c) { const v4u w = kr[c]; s += q[8 * c] * bflo(w.x) + q[8 * c + 1] * bfhi(w.x) + q[8 * c + 2] * bflo(w.y) + q[8 * c + 3] * bfhi(w.y) + q[8 * c + 4] * bflo(w.z) + q[8 * c + 5] * bfhi(w.z) + q[8 * c + 6] * bflo(w.w) + q[8 * c + 7] * bfhi(w.w); }
        s += SKB[PAST + i];
        if (i <= qi) {
            const float mn = fmaxf(m, s), a = __builtin_amdgcn_exp2f(m - mn), p = __builtin_amdgcn_exp2f(s - mn); l = l * a + p; m = mn;
            const v4u* vr = (const v4u*)(V + kr_ * 512 + h * 64);
#pragma unroll
            for (int c = 0; c < 8; ++c) { const v4u w = vr[c];
                o[8 * c] = o[8 * c] * a + p * bflo(w.x); o[8 * c + 1] = o[8 * c + 1] * a + p * bfhi(w.x); o[8 * c + 2] = o[8 * c + 2] * a + p * bflo(w.y); o[8 * c + 3] = o[8 * c + 3] * a + p * bfhi(w.y);
                o[8 * c + 4] = o[8 * c + 4] * a + p * bflo(w.z); o[8 * c + 5] = o[8 * c + 5] * a + p * bfhi(w.z); o[8 * c + 6] = o[8 * c + 6] * a + p * bflo(w.w); o[8 * c + 7] = o[8 * c + 7] * a + p * bfhi(w.w); }
        }
    }
    if (F.lane < 16) { const float rl = 1.0f / l; v4u* orow = (v4u*)(O + row * 512 + h * 64);
#pragma unroll
        for (int c = 0; c < 8; ++c) { v4u w; w.x = pk2(o[8 * c] * rl, o[8 * c + 1] * rl); w.y = pk2(o[8 * c + 2] * rl, o[8 * c + 3] * rl); w.z = pk2(o[8 * c + 4] * rl, o[8 * c + 5] * rl); w.w = pk2(o[8 * c + 6] * rl, o[8 * c + 7] * rl); orow[c] = w; } }
}

__device__ __forceinline__ void hgrn_chain(Frame& F, size_t row0, int T, int h, int v, float& S0, float& S1) {
    const bf16* HQ = WSP(bf16, WS_HQ); const bf16* KK = WSP(bf16, WS_KK); const bf16* HI = WSP(bf16, WS_HI); const float* LF = WSP(float, WS_LF); bf16* OH = WSP(bf16, WS_OH);
    const int d0 = F.lane, d1 = F.lane + 64;
    for (int t = 0; t < T; ++t) {
        const size_t base = (row0 + t) * 512 + h * 128;
        const float q0 = bf2f(HQ[base + d0]), q1 = bf2f(HQ[base + d1]), k0 = bf2f(KK[base + d0]), k1 = bf2f(KK[base + d1]), l0 = LF[base + d0], l1 = LF[base + d1], iv = bf2f(HI[base + v]);
        S0 = __expf(l0) * S0 + k0 * iv; S1 = __expf(l1) * S1 + k1 * iv;
        const float p = wave_sum(q0 * S0 + q1 * S1);
        if (F.lane == 0) OH[base + v] = (bf16)f2bf(p);
    }
}
__device__ __forceinline__ void ph_hgrn_naive(Frame& F) {
    const int gw = blockIdx.x * NWAVES + F.wave, NGW = F.G * NWAVES;
    if (gw < 512) { const int h = gw >> 7, v = gw & 127; float S0 = 0.f, S1 = 0.f; hgrn_chain(F, 0, MP, h, v, S0, S1);
        float* ph = F.out + OFF_PH; ph[((size_t)h * 128 + F.lane) * 128 + v] = S0; ph[((size_t)h * 128 + F.lane + 64) * 128 + v] = S1; }
    for (int task = gw; task < 4096; task += NGW) { const int bh = task >> 7, v = task & 127, b = bh >> 2, h = bh & 3;
        const float* st = F.sh + (size_t)bh * 16384; float S0 = st[(size_t)F.lane * 128 + v], S1 = st[(size_t)(F.lane + 64) * 128 + v];
        hgrn_chain(F, (size_t)MP + b * 16, 16, h, v, S0, S1);
        float* so = F.out + OFF_SH + (size_t)bh * 16384; so[(size_t)F.lane * 128 + v] = S0; so[(size_t)(F.lane + 64) * 128 + v] = S1; }
}
__device__ __forceinline__ void ph_hgnorm(Frame& F) {
    const int gw = F.vcu * NWAVES + F.wave, NGW = F.G * NWAVES; unsigned* OH = WSP(unsigned, WS_OH); const unsigned* HG = WSP(unsigned, WS_HG);
    const float g0 = F.hgn[2 * F.lane], g1 = F.hgn[2 * F.lane + 1];
    for (int task = gw; task < MTOT * 4; task += NGW) { const size_t idx = (size_t)task * 64 + F.lane; const unsigned w = OH[idx], g = HG[idx];
        const float a = bflo(w), b = bfhi(w); const float inv = 1.0f / sqrtf(wave_sum(a * a + b * b) * (1.f / 128) + RMS_EPS);
        OH[idx] = pk2(a * inv * g0 * bflo(g), b * inv * g1 * bfhi(g)); }
}
__device__ __forceinline__ void ph_merge(Frame& F) {
    const float* BRF = WSP(float, WS_BRF); const float* BRH = WSP(float, WS_BRH); bf16* MG = WSP(bf16, WS_MERGED);
    const size_t n8 = (size_t)MTOT * DMODEL / 8;
    for (size_t i = (size_t)F.vcu * NTHR + F.tid; i < n8; i += (size_t)F.G * NTHR) { const size_t m = i >> 7, c = (i & 127) * 8;
        const bf16* ga = m < MP ? (const bf16*)F.out + m * DMODEL + c : WSP(bf16, WS_GAS) + (m - MP) * DMODEL + c;
        const bf16* gb = m < MP ? (const bf16*)F.out + (size_t)MP * DMODEL + m * DMODEL + c : WSP(bf16, WS_GBS) + (m - MP) * DMODEL + c;
        const v4u a = *(const v4u*)ga, b = *(const v4u*)gb; const f32x4 f0 = *(const f32x4*)(BRF + m * DMODEL + c), f1 = *(const f32x4*)(BRF + m * DMODEL + c + 4), h0 = *(const f32x4*)(BRH + m * DMODEL + c), h1 = *(const f32x4*)(BRH + m * DMODEL + c + 4);
        v4u o; o.x = pk2(bflo(a.x) * f0.x + bflo(b.x) * h0.x, bfhi(a.x) * f0.y + bfhi(b.x) * h0.y); o.y = pk2(bflo(a.y) * f0.z + bflo(b.y) * h0.z, bfhi(a.y) * f0.w + bfhi(b.y) * h0.w);
        o.z = pk2(bflo(a.z) * f1.x + bflo(b.z) * h1.x, bfhi(a.z) * f1.y + bfhi(b.z) * h1.y); o.w = pk2(bflo(a.w) * f1.z + bflo(b.w) * h1.z, bfhi(a.w) * f1.w + bfhi(b.w) * h1.w);
        *(v4u*)(MG + m * DMODEL + c) = o; }
}
__device__ __forceinline__ void ph_norm1(Frame& F) {
    const int gw = F.vcu * NWAVES + F.wave, NGW = F.G * NWAVES; const float* MIX = WSP(float, WS_MIX); bf16* H2 = WSP(bf16, WS_H2);
    for (int m = gw; m < MTOT; m += NGW) {
        const float* xr = m < MP ? F.xp + (size_t)m * DMODEL : F.xs + (size_t)(m - MP) * DMODEL; float* yr = m < MP ? F.out + OFF_Y + (size_t)m * DMODEL : F.out + OFF_YS + (size_t)(m - MP) * DMODEL;
        f32x4 v[4]; float s = 0.f;
#pragma unroll
        for (int j = 0; j < 4; ++j) { v[j] = ((const GAS f32x4*)(MIX + (size_t)m * DMODEL))[F.lane + 64 * j]; s += (v[j].x * v[j].x + v[j].y * v[j].y) + (v[j].z * v[j].z + v[j].w * v[j].w); }
        const float inv = 1.0f / sqrtf(wave_sum(s) * (1.f / DMODEL) + RMS_EPS); float s2 = 0.f;
#pragma unroll
        for (int j = 0; j < 4; ++j) { const f32x4 g = ((const GAS f32x4*)F.g_post)[F.lane + 64 * j], x = ((const GAS f32x4*)xr)[F.lane + 64 * j]; v[j] = x + (v[j] * inv) * g;
            ((GAS f32x4*)yr)[F.lane + 64 * j] = v[j]; s2 += (v[j].x * v[j].x + v[j].y * v[j].y) + (v[j].z * v[j].z + v[j].w * v[j].w); }
        const float inv2 = 1.0f / sqrtf(wave_sum(s2) * (1.f / DMODEL) + RMS_EPS);
#pragma unroll
        for (int j = 0; j < 4; ++j) { const f32x4 g = ((const GAS f32x4*)F.g_pre2)[F.lane + 64 * j]; const f32x4 hv = (v[j] * inv2) * g;
            GAS unsigned long long* o8 = (GAS unsigned long long*)(H2 + (size_t)m * DMODEL) + F.lane + 64 * j; *o8 = (unsigned long long)pk2(hv.x, hv.y) | ((unsigned long long)pk2(hv.z, hv.w) << 32); }
    }
}
__device__ __forceinline__ float gelu_tanh(float c) { const float u = 0.7978845608028654f * (c + 0.044715f * c * c * c); const float t = 1.0f - 2.0f / (__expf(2.0f * u) + 1.0f); return 0.5f * c * (1.0f + t); }
__device__ __forceinline__ void ph_conv(Frame& F) {
    const bf16* A = WSP(bf16, WS_ABUF); bf16* G = WSP(bf16, WS_GBUF); constexpr int NG = DFF / 8; const size_t n8 = (size_t)MTOT * NG;
    for (size_t i = (size_t)F.vcu * NTHR + F.tid; i < n8; i += (size_t)F.G * NTHR) { const size_t m = i / NG; const int c = (int)(i % NG) * 8;
        float a0[8], a1[8], a2[8];
        { const v4u w = *(const v4u*)(A + m * DFF + c); a0[0] = bflo(w.x); a0[1] = bfhi(w.x); a0[2] = bflo(w.y); a0[3] = bfhi(w.y); a0[4] = bflo(w.z); a0[5] = bfhi(w.z); a0[6] = bflo(w.w); a0[7] = bfhi(w.w); }
        int t, b = 0; const bool samp = m >= MP; if (samp) { t = (int)(m - MP) & 15; b = (int)(m - MP) >> 4; } else t = (int)(m < 2 ? m : 2);
        if (t >= 1) { const v4u w = *(const v4u*)(A + (m - 1) * DFF + c); a1[0] = bflo(w.x); a1[1] = bfhi(w.x); a1[2] = bflo(w.y); a1[3] = bfhi(w.y); a1[4] = bflo(w.z); a1[5] = bfhi(w.z); a1[6] = bflo(w.w); a1[7] = bfhi(w.w); }
        else {
#pragma unroll
            for (int e = 0; e < 8; ++e) a1[e] = samp ? F.sc[((size_t)b * 2 + 1) * DFF + c + e] : 0.f; }
        if (t >= 2) { const v4u w = *(const v4u*)(A + (m - 2) * DFF + c); a2[0] = bflo(w.x); a2[1] = bfhi(w.x); a2[2] = bflo(w.y); a2[3] = bfhi(w.y); a2[4] = bflo(w.z); a2[5] = bfhi(w.z); a2[6] = bflo(w.w); a2[7] = bfhi(w.w); }
        else {
#pragma unroll
            for (int e = 0; e < 8; ++e) a2[e] = samp ? F.sc[((size_t)b * 2 + t) * DFF + c + e] : 0.f; }
        const v4u gw_ = *(const v4u*)(G + m * DFF + c); float g[8] = {bflo(gw_.x), bfhi(gw_.x), bflo(gw_.y), bfhi(gw_.y), bflo(gw_.z), bfhi(gw_.z), bflo(gw_.w), bfhi(gw_.w)}; float u[8];
#pragma unroll
        for (int e = 0; e < 8; ++e) { const float cv_ = F.cb[c + e] + F.cw[c + e] * a2[e] + F.cw[DFF + c + e] * a1[e] + F.cw[2 * DFF + c + e] * a0[e]; u[e] = gelu_tanh(cv_) * g[e]; }
        v4u o; o.x = pk2(u[0], u[1]); o.y = pk2(u[2], u[3]); o.z = pk2(u[4], u[5]); o.w = pk2(u[6], u[7]); *(v4u*)(G + m * DFF + c) = o; }
}
__device__ __forceinline__ void ph_norm2(Frame& F) {
    const int gw = F.vcu * NWAVES + F.wave, NGW = F.G * NWAVES; const float* FFN = WSP(float, WS_FFN);
    for (int m = gw; m < MTOT; m += NGW) {
        float* yr = m < MP ? F.out + OFF_Y + (size_t)m * DMODEL : F.out + OFF_YS + (size_t)(m - MP) * DMODEL;
        f32x4 v[4]; float s = 0.f;
#pragma unroll
        for (int j = 0; j < 4; ++j) { v[j] = ((const GAS f32x4*)(FFN + (size_t)m * DMODEL))[F.lane + 64 * j]; s += (v[j].x * v[j].x + v[j].y * v[j].y) + (v[j].z * v[j].z + v[j].w * v[j].w); }
        const float inv = 1.0f / sqrtf(wave_sum(s) * (1.f / DMODEL) + RMS_EPS);
#pragma unroll
        for (int j = 0; j < 4; ++j) { const f32x4 g = ((const GAS f32x4*)F.g_post2)[F.lane + 64 * j]; GAS f32x4* y4 = (GAS f32x4*)yr + F.lane + 64 * j; *y4 = *y4 + (v[j] * inv) * g; }
    }
}

struct Args { const float* in[22]; float* out; unsigned char* ws; int ph_lo, ph_hi, li, pad; };
constexpr int NPHASE = 15;
__global__ void __launch_bounds__(NTHR, 2) skel_fwd(Args args) {
    extern __shared__ __attribute__((aligned(16))) unsigned char lds[];
    Frame F;
    F.lds = (LAS unsigned char*)lds; F.MISC = (volatile LAS unsigned*)(F.lds + MISC_OFF);
    F.tid = threadIdx.x; F.lane = F.tid & 63; F.wave = __builtin_amdgcn_readfirstlane(F.tid >> 6);
    F.G = gridDim.x; { const int bx = blockIdx.x; F.vcu = (F.G % 8 == 0) ? (bx % 8) * (F.G / 8) + bx / 8 : bx; }
    F.ws = args.ws; F.out = args.out; F.ctl = (gu32*)(args.ws + WS_CTL);
    F.xp = args.in[0]; F.xs = args.in[1]; F.ck = args.in[2]; F.cv = args.in[3]; F.clf = args.in[4]; F.sh = args.in[5]; F.sc = args.in[6]; F.g_pre = args.in[7]; F.g_post = args.in[8];
    F.w_in = args.in[9]; F.fbias = args.in[10]; F.lbl = args.in[11]; F.hgn = args.in[12]; F.w_bf = args.in[13]; F.w_bh = args.in[14]; F.w_out = args.in[15]; F.g_pre2 = args.in[16]; F.g_post2 = args.in[17];
    F.w_up = args.in[18]; F.cw = args.in[19]; F.cb = args.in[20]; F.w_dn = args.in[21];
    for (int u = F.tid; u < (LDS_BYTES - LDSCTL_OFF) / 4; u += NTHR) ((LAS unsigned*)(F.lds + LDSCTL_OFF))[u] = 0u;
    __syncthreads();
    XcdBarrier bar = xcd_barrier_post((unsigned*)(F.ctl + CW_BAR), F.MISC + 8);
    const int lo = args.ph_lo, hi = args.ph_hi;
#define IN(k) (lo <= (k) && (k) < hi)
#define SEAM(k) do { if (IN(k) && IN((k) + 1)) xcd_barrier(bar); } while (0)
    typedef pg8::bf16_t pbf;
    if (IN(0)) p0_prologue(F);
    SEAM(0);
    if (IN(1)) ph_cum(F);
    SEAM(1);
    if (IN(2)) {
        pg8::Gemm g{WSP(pbf, WS_H1), WSP(pbf, WS_WIN), MPAD, NINP, DMODEL}; pg8::StaticOrder S; S.init(MPAD, NINP, F.G, (int)blockIdx.x);
        pg8::EpiIn E{WSP(pbf, WS_Q), WSP(pbf, WS_K), WSP(pbf, WS_V), WSP(pbf, WS_HQ), WSP(pbf, WS_KK), WSP(pbf, WS_HI), WSP(pbf, WS_HG), WSP(float, WS_LF),
                     (pbf*)F.out, (pbf*)F.out + (size_t)MP * DMODEL, WSP(pbf, WS_GAS), WSP(pbf, WS_GBS), F.out + OFF_PK, F.out + OFF_PV, F.out + OFF_SK, F.out + OFF_SV, WSP(float, WS_LB), C2};
        pg8::gemm_phase<pg8::EpiIn, pg8::StaticOrder, true, true>(F.lds + RING_OFF, g, S, E);
    }
    SEAM(2);
    if (IN(3)) { ph_attn_sample_naive(F); ph_attn_naive(F); }
    SEAM(3);
    if (IN(4)) ph_hgrn_naive(F);
    SEAM(4);
    if (IN(5)) ph_hgnorm(F);
    SEAM(5);
    if (IN(6)) { pg8::Gemm g{WSP(pbf, WS_Q), WSP(pbf, WS_WBF), MPAD, DMODEL, 512}; pg8::StaticOrder S; S.init(MPAD, DMODEL, F.G, (int)blockIdx.x); pg8::EpiF32 E{WSP(float, WS_BRF), DMODEL};
                 pg8::gemm_phase<pg8::EpiF32, pg8::StaticOrder, true, true>(F.lds + RING_OFF, g, S, E); }
    SEAM(6);
    if (IN(7)) { pg8::Gemm g{WSP(pbf, WS_OH), WSP(pbf, WS_WBH), MPAD, DMODEL, 512}; pg8::StaticOrder S; S.init(MPAD, DMODEL, F.G, (int)blockIdx.x); pg8::EpiF32 E{WSP(float, WS_BRH), DMODEL};
                 pg8::gemm_phase<pg8::EpiF32, pg8::StaticOrder, true, true>(F.lds + RING_OFF, g, S, E); }
    SEAM(7);
    if (IN(8)) ph_merge(F);
    SEAM(8);
    if (IN(9)) { pg8::Gemm g{WSP(pbf, WS_MERGED), WSP(pbf, WS_WOUT), MPAD, DMODEL, DMODEL}; pg8::StaticOrder S; S.init(MPAD, DMODEL, F.G, (int)blockIdx.x); pg8::EpiF32 E{WSP(float, WS_MIX), DMODEL};
                 pg8::gemm_phase<pg8::EpiF32, pg8::StaticOrder, true, true>(F.lds + RING_OFF, g, S, E); }
    SEAM(9);
    if (IN(10)) ph_norm1(F);
    SEAM(10);
    if (IN(11)) { pg8::Gemm g{WSP(pbf, WS_H2), WSP(pbf, WS_WUP), MPAD, 2 * DFF, DMODEL}; pg8::StaticOrder S; S.init(MPAD, 2 * DFF, F.G, (int)blockIdx.x);
                  pg8::EpiUpSplit E{WSP(pbf, WS_ABUF), WSP(pbf, WS_GBUF), F.out + OFF_PC, F.out + OFF_SC};
                  pg8::gemm_phase<pg8::EpiUpSplit, pg8::StaticOrder, true, true>(F.lds + RING_OFF, g, S, E); }
    SEAM(11);
    if (IN(12)) ph_conv(F);
    SEAM(12);
    if (IN(13)) { pg8::Gemm g{WSP(pbf, WS_GBUF), WSP(pbf, WS_WDN), MPAD, DMODEL, DFF}; pg8::StaticOrder S; S.init(MPAD, DMODEL, F.G, (int)blockIdx.x); pg8::EpiF32 E{WSP(float, WS_FFN), DMODEL};
                  pg8::gemm_phase<pg8::EpiF32, pg8::StaticOrder, true, true>(F.lds + RING_OFF, g, S, E); }
    SEAM(13);
    if (IN(14)) ph_norm2(F);
#undef IN
}

extern "C" void kernel_launch(void* const* d_in, const int* in_sizes, int n_in, void* d_out, int out_size, void* d_ws, size_t ws_size, hipStream_t stream) {
    static int grid = 0;
    if (grid == 0) {
        if (n_in != 22 || out_size != (int)OUT_TOTAL || ws_size < WS_END) { fprintf(stderr, "kernel_launch: unexpected shapes (n_in %d out %d ws %zu)\n", n_in, out_size, ws_size); grid = -1; return; }
        if (hipFuncSetAttribute((const void*)skel_fwd, hipFuncAttributeMaxDynamicSharedMemorySize, LDS_BYTES) != hipSuccess) { fprintf(stderr, "kernel_launch: hipFuncSetAttribute failed\n"); grid = -1; return; }
        grid = 256;
    }
    if (grid < 0) return;
    (void)hipMemsetAsync((char*)d_ws + WS_CTL, 0, CTL_ZERO_BYTES, stream);
    Args a{};
    for (int i = 0; i < 22; ++i) a.in[i] = (const float*)d_in[i];
    a.out = (float*)d_out; a.ws = (unsigned char*)d_ws;
    a.ph_lo = 0; a.ph_hi = NPHASE; a.li = 0; hipLaunchKernelGGL(skel_fwd, dim3(grid), dim3(NTHR), LDS_BYTES, stream, a);
}
```

```cpp
#include <hip/hip_runtime.h>
#include <cstdio>
#include <cstdint>
namespace pg8 {
#define PG8_LAS __attribute__((address_space(3)))
typedef unsigned short bf16_t;
typedef short bf16x8 __attribute__((ext_vector_type(8)));
typedef float f32x4 __attribute__((ext_vector_type(4)));
typedef unsigned u32x4 __attribute__((ext_vector_type(4)));
constexpr int BM = 256, BK = 64, HALF = 128, HTB = HALF * BK * 2  , STAGE_BYTES = 8 * HTB, NXCD = 8, WGM = 8;

__host__ __device__ __forceinline__ int lds_byte(int r, int c) { const int st = (r >> 4) * 2 + (c >> 5), rr = r & 15, cc = c & 31, ob = rr * 64 + cc * 2; return st * 1024 + (ob ^ (((ob >> 9) & 1) << 5)); }
__host__ __device__ __forceinline__ void stage_rc(int b, int& R, int& C) { const int st = b / 1024, sb = b % 1024, swz = sb ^ (((sb >> 9) & 1) << 5); R = (st >> 1) * 16 + swz / 64; C = (st & 1) * 32 + (swz % 64) / 2; }
__host__ __device__ __forceinline__ int perm32(int rho) { const int n = rho >> 4, i = rho & 15; return 8 * (i >> 2) + 4 * n + (i & 3); }

struct Unit { int pm, pn; };
struct Gemm { const bf16_t* A; const bf16_t* Bt; int M, N, K; };

struct StaticOrder {
    int nM, nN, nwg, G, c;
    __host__ __device__ void init(int M, int N, int G_, int c_) { nM = M / BM; nN = N / BM; nwg = nM * nN; G = G_; c = c_; }
    __host__ __device__ bool next(int i, Unit& u) const {
        const long L = (long)i * G + c; if (L >= nwg) return false;
        int wgid = (int)L; { const int q = nwg / NXCD, r = nwg % NXCD, xcd = wgid % NXCD, off = wgid / NXCD; wgid = (xcd < r ? xcd * (q + 1) : r * (q + 1) + (xcd - r) * q) + off; }
        const int nig = WGM * nN, gid = wgid / nig, fm = gid * WGM, gsz = (nM - fm) < WGM ? (nM - fm) : WGM;
        u.pm = fm + ((wgid % nig) % gsz); u.pn = (wgid % nig) / gsz; return true;
    }
    __device__ __forceinline__ void a_ready(const Unit&) const {}
    __device__ __forceinline__ void done(const Unit&) const {}
};

__device__ __forceinline__ unsigned cvt_pk_bf16(float lo, float hi) { unsigned r; asm volatile("v_cvt_pk_bf16_f32 %0, %1, %2" : "=v"(r) : "v"(lo), "v"(hi)); return r; }
typedef float f32x2 __attribute__((ext_vector_type(2)));
__device__ __forceinline__ f32x2 gelu_pk(f32x2 v) {
    const f32x2 av = __builtin_elementwise_abs(v), d = av * 0.2316418882f + 1.0f;
    f32x2 t; t.x = __builtin_amdgcn_rcpf(d.x); t.y = __builtin_amdgcn_rcpf(d.y);
    f32x2 q = t * 0.5307027145f + (-0.7265760135f); q = q * t + 0.7107068705f; q = q * t + (-0.142248368f); q = q * t + 0.127414796f; q = q * t;
    const f32x2 s = (v * v) * (-0.72134752044f);
    f32x2 e; e.x = __builtin_amdgcn_exp2f(s.x); e.y = __builtin_amdgcn_exp2f(s.y);
    const f32x2 m = v * (q * e), r = v - m;
    f32x2 o; o.x = v.x < 0.f ? m.x : r.x; o.y = v.y < 0.f ? m.y : r.y; return o;
}

template <int ACT  > struct EpiBf16 {
    static constexpr bool PERM = true, AFTER_DRAIN = false; static_assert(ACT == 0 || ACT == 1, "EpiBf16: ACT is 0 (none) or 1 (gelu_pk)");
    bf16_t* O; int ldc; const float* bias; int split_cols; size_t split_stride; float scale0;
    __device__ __forceinline__ void operator()(const f32x4 (&acc)[2][2][4][2], const Unit& u, int wr, int wc, int fr, int fq) const {
        const int row0 = u.pm * BM + wr * 64 + fr; int colt = u.pn * BM; bf16_t* base = O;
        float sc = 1.f; if (split_cols) { const int t = colt / split_cols; base += (size_t)t * split_stride; colt -= t * split_cols; if (t == 0) sc = scale0; }
        const int col0 = colt + wc * 32 + 8 * fq, bcol0 = u.pn * BM + wc * 32 + 8 * fq;
        f32x4 bv[2][2];
#pragma unroll
        for (int bj = 0; bj < 2; ++bj)
#pragma unroll
            for (int n = 0; n < 2; ++n) bv[bj][n] = bias ? *(const f32x4*)(bias + bcol0 + bj * HALF + 4 * n) : (f32x4){0.f, 0.f, 0.f, 0.f};
#pragma unroll
        for (int ai = 0; ai < 2; ++ai)
#pragma unroll
            for (int m = 0; m < 4; ++m) { bf16_t* rowp = base + (size_t)(row0 + ai * HALF + m * 16) * ldc + col0;
#pragma unroll
                for (int bj = 0; bj < 2; ++bj) { f32x4 v0 = acc[ai][bj][m][0] + bv[bj][0], v1 = acc[ai][bj][m][1] + bv[bj][1];
                    if (ACT == 1) { f32x2 a = gelu_pk((f32x2){v0[0], v0[1]}), b = gelu_pk((f32x2){v0[2], v0[3]}), c = gelu_pk((f32x2){v1[0], v1[1]}), d = gelu_pk((f32x2){v1[2], v1[3]});
                        v0 = (f32x4){a.x, a.y, b.x, b.y}; v1 = (f32x4){c.x, c.y, d.x, d.y}; }
                    v0 = v0 * sc; v1 = v1 * sc; u32x4 w; w.x = cvt_pk_bf16(v0[0], v0[1]); w.y = cvt_pk_bf16(v0[2], v0[3]); w.z = cvt_pk_bf16(v1[0], v1[1]); w.w = cvt_pk_bf16(v1[2], v1[3]);
                    *(u32x4*)(rowp + bj * HALF) = w; } }
    }
};

struct PanelStats {
    unsigned* xbuf;
    unsigned* cnt;
    unsigned* tmo;
    int ntn; float eps;
    unsigned code;
    __device__ __forceinline__ bool run(const f32x4 (&v)[2][2][4][2], const Unit& u, int wr, int wc, int fr, int fq, PG8_LAS unsigned char* lds, int wid, int lane) const {
        typedef float f32x2v __attribute__((ext_vector_type(2)));
        PG8_LAS f32x2v* P = (PG8_LAS f32x2v*)lds;
        PG8_LAS f32x2v* S = (PG8_LAS f32x2v*)(lds + 8192);
        PG8_LAS unsigned* flag = (PG8_LAS unsigned*)(lds + 8192 + 2048);
#pragma unroll
        for (int ai = 0; ai < 2; ++ai)
#pragma unroll
            for (int m = 0; m < 4; ++m) {
                float s = 0.f;
#pragma unroll
                for (int bj = 0; bj < 2; ++bj)
#pragma unroll
                    for (int n = 0; n < 2; ++n) { const f32x4 x = v[ai][bj][m][n]; s += (x[0] + x[1]) + (x[2] + x[3]); }
                s += __shfl_xor(s, 16); s += __shfl_xor(s, 32);
                const float mw = s * (1.0f / 64.0f); float q = 0.f;
#pragma unroll
                for (int bj = 0; bj < 2; ++bj)
#pragma unroll
                    for (int n = 0; n < 2; ++n) { const f32x4 d = v[ai][bj][m][n] - mw; q += (d[0] * d[0] + d[1] * d[1]) + (d[2] * d[2] + d[3] * d[3]); }
                q += __shfl_xor(q, 16); q += __shfl_xor(q, 32);
                if (fq == 0) P[(ai * HALF + wr * 64 + m * 16 + fr) * 4 + wc] = (f32x2v){mw, q};
            }
        asm volatile("s_waitcnt lgkmcnt(0)" ::: "memory"); __builtin_amdgcn_s_barrier(); asm volatile("" ::: "memory");
#if defined(BROKEN_EXCHANGE_NO_WAIT)
#warning BROKEN CONTROL BUILD: the row-statistics exchange does not wait; results are wrong by design
        if (blockIdx.x >= 64) { const long long t0_ = clock64(); while (clock64() - t0_ < 60000) __builtin_amdgcn_s_sleep(8); }
#endif
        const int row = wid * 32 + (lane & 31);
        if (lane < 32) {
            const f32x2v a = P[row * 4 + 0], b = P[row * 4 + 1], c = P[row * 4 + 2], d = P[row * 4 + 3];
            const float mt = (a.x + b.x + c.x + d.x) * 0.25f;
            const float da = a.x - mt, db = b.x - mt, dc = c.x - mt, dd = d.x - mt;
            const float m2 = (a.y + b.y) + (c.y + d.y) + 64.0f * ((da * da + db * db) + (dc * dc + dd * dd));
            unsigned long long* slot = (unsigned long long*)xbuf + ((size_t)(u.pm * BM + row) * 4 + u.pn);
            __hip_atomic_store(slot, ((unsigned long long)__float_as_uint(m2) << 32) | __float_as_uint(mt), __ATOMIC_RELAXED, __HIP_MEMORY_SCOPE_AGENT);
        }
        asm volatile("s_waitcnt vmcnt(0)" ::: "memory");
        if (lane == 0) __hip_atomic_fetch_add(cnt + 64 * u.pm, 1u, __ATOMIC_RELAXED, __HIP_MEMORY_SCOPE_AGENT);
        if (wid == 0) {
            bool dead = false; const unsigned long long t0 = __builtin_amdgcn_s_memrealtime(); const unsigned want = 8u * (unsigned)ntn;
            for (;;) {
#if defined(BROKEN_EXCHANGE_NO_WAIT)
                break;
#endif
                if ((unsigned)__builtin_amdgcn_readfirstlane(__hip_atomic_load(cnt + 64 * u.pm, __ATOMIC_RELAXED, __HIP_MEMORY_SCOPE_AGENT)) >= want) break;
                if (__builtin_amdgcn_s_memrealtime() - t0 > 2000000ull) {
                    if (lane == 0) { unsigned expect = 0u; __hip_atomic_compare_exchange_strong(tmo + 1, &expect, code | (unsigned)(u.pm & 0xff), __ATOMIC_RELAXED, __ATOMIC_RELAXED, __HIP_MEMORY_SCOPE_AGENT);
                                     __hip_atomic_store(tmo, 1u, __ATOMIC_RELAXED, __HIP_MEMORY_SCOPE_AGENT); }
                    dead = true; break; }
                __builtin_amdgcn_s_sleep(2);
            }
            __builtin_amdgcn_fence(__ATOMIC_ACQUIRE, "agent");
            if (lane == 0) flag[0] = dead ? 1u : 0u;
        }
        asm volatile("s_waitcnt vmcnt(0) lgkmcnt(0)" ::: "memory"); __builtin_amdgcn_s_barrier(); asm volatile("" ::: "memory");
        const bool bad = flag[0] != 0u;
        if (lane < 32) {
            const unsigned long long* slot = (const unsigned long long*)xbuf + (size_t)(u.pm * BM + row) * 4; float mt[4], m2[4]; float ms = 0.f;
#pragma unroll
            for (int t = 0; t < 4; ++t) { if (t < ntn) { const unsigned long long w = __hip_atomic_load(slot + t, __ATOMIC_RELAXED, __HIP_MEMORY_SCOPE_AGENT); mt[t] = __uint_as_float((unsigned)w); m2[t] = __uint_as_float((unsigned)(w >> 32)); } else { mt[t] = 0.f; m2[t] = 0.f; } ms += mt[t]; }
            const float mean = ms / (float)ntn; float q = 0.f;
#pragma unroll
            for (int t = 0; t < 4; ++t) if (t < ntn) { const float dm = mt[t] - mean; q += m2[t] + 256.0f * dm * dm; }
            S[row] = (f32x2v){mean, 1.0f / sqrtf(q / (256.0f * (float)ntn) + eps)};
        }
        asm volatile("s_waitcnt lgkmcnt(0)" ::: "memory"); __builtin_amdgcn_s_barrier(); asm volatile("" ::: "memory");
        return bad;
    }
};
struct EpiLnRes {
    static constexpr bool PERM = false, AFTER_DRAIN = true;
    const float* base; float* out; int ldc; const float* bias; PanelStats st; unsigned poison;
    __device__ __forceinline__ void fused(f32x4 (&acc)[2][2][4][2], const Unit& u, int wr, int wc, int fr, int fq, PG8_LAS unsigned char* lds, int wid, int lane) const {
        typedef float f32x2v __attribute__((ext_vector_type(2)));
        const PG8_LAS f32x2v* S = (const PG8_LAS f32x2v*)(lds + 8192);
        const int col0 = u.pn * BM + wc * 32 + 4 * fq;
#pragma unroll
        for (int bj = 0; bj < 2; ++bj)
#pragma unroll
            for (int n = 0; n < 2; ++n) { const f32x4 bv = bias ? *(const f32x4*)(bias + col0 + bj * HALF + n * 16) : (f32x4){0.f, 0.f, 0.f, 0.f};
#pragma unroll
                for (int ai = 0; ai < 2; ++ai)
#pragma unroll
                    for (int m = 0; m < 4; ++m) acc[ai][bj][m][n] += bv; }
        f32x4 pre[4][2][2];
#pragma unroll
        for (int m = 0; m < 4; ++m) { const size_t off = (size_t)(u.pm * BM + wr * 64 + m * 16 + fr) * ldc + col0;
#pragma unroll
            for (int bj = 0; bj < 2; ++bj)
#pragma unroll
                for (int n = 0; n < 2; ++n) pre[m][bj][n] = *(const f32x4*)(base + off + bj * HALF + n * 16); }
        const bool bad = st.run(acc, u, wr, wc, fr, fq, lds, wid, lane) || poison != 0u;
        const float qnan = __builtin_nanf("");
#pragma unroll
        for (int ai = 0; ai < 2; ++ai)
#pragma unroll
            for (int m = 0; m < 4; ++m) { const int r = ai * HALF + wr * 64 + m * 16 + fr; const f32x2v sr = S[r]; const size_t off = (size_t)(u.pm * BM + r) * ldc + col0;
#pragma unroll
                for (int bj = 0; bj < 2; ++bj)
#pragma unroll
                    for (int n = 0; n < 2; ++n) { const f32x4 bs = ai == 0 ? pre[m][bj][n] : *(const f32x4*)(base + off + bj * HALF + n * 16); f32x4 o = bs + (acc[ai][bj][m][n] - sr.x) * sr.y;
                        if (bad) o = (f32x4){qnan, qnan, qnan, qnan}; *(f32x4*)(out + off + bj * HALF + n * 16) = o; }
                if (m & 1) asm volatile("" ::: "memory"); }
    }
};
struct EpiLnResLn {
    static constexpr bool PERM = false, AFTER_DRAIN = true;
    const float* base; float* out; bf16_t* xn; int ldc; const float* bias; PanelStats st1, st2; unsigned poison;
    __device__ __forceinline__ void fused(f32x4 (&acc)[2][2][4][2], const Unit& u, int wr, int wc, int fr, int fq, PG8_LAS unsigned char* lds, int wid, int lane) const {
        typedef float f32x2v __attribute__((ext_vector_type(2))); typedef unsigned u32x2v __attribute__((ext_vector_type(2)));
        const PG8_LAS f32x2v* S = (const PG8_LAS f32x2v*)(lds + 8192);
        const int col0 = u.pn * BM + wc * 32 + 4 * fq;
#pragma unroll
        for (int bj = 0; bj < 2; ++bj)
#pragma unroll
            for (int n = 0; n < 2; ++n) { const f32x4 bv = bias ? *(const f32x4*)(bias + col0 + bj * HALF + n * 16) : (f32x4){0.f, 0.f, 0.f, 0.f};
#pragma unroll
                for (int ai = 0; ai < 2; ++ai)
#pragma unroll
                    for (int m = 0; m < 4; ++m) acc[ai][bj][m][n] += bv; }
        bool bad = st1.run(acc, u, wr, wc, fr, fq, lds, wid, lane) || poison != 0u;
        const float qnan = __builtin_nanf("");
#pragma unroll
        for (int ai = 0; ai < 2; ++ai)
#pragma unroll
            for (int m = 0; m < 4; ++m) { const int r = ai * HALF + wr * 64 + m * 16 + fr; const f32x2v sr = S[r]; const size_t off = (size_t)(u.pm * BM + r) * ldc + col0;
#pragma unroll
                for (int bj = 0; bj < 2; ++bj)
#pragma unroll
                    for (int n = 0; n < 2; ++n) { const f32x4 bs = *(const f32x4*)(base + off + bj * HALF + n * 16); acc[ai][bj][m][n] = bs + (acc[ai][bj][m][n] - sr.x) * sr.y; }
                asm volatile("" : "+v"(acc[ai][0][m][0]), "+v"(acc[ai][0][m][1]), "+v"(acc[ai][1][m][0]), "+v"(acc[ai][1][m][1]));
                if (m & 1) asm volatile("" ::: "memory"); }
        const bool bad1 = bad;
        bad = st2.run(acc, u, wr, wc, fr, fq, lds, wid, lane) || bad;
#pragma unroll
        for (int ai = 0; ai < 2; ++ai)
#pragma unroll
            for (int m = 0; m < 4; ++m) { const int r = ai * HALF + wr * 64 + m * 16 + fr; const f32x2v sr = S[r]; const size_t off = (size_t)(u.pm * BM + r) * ldc + col0;
#pragma unroll
                for (int bj = 0; bj < 2; ++bj)
#pragma unroll
                    for (int n = 0; n < 2; ++n) { const f32x4 x1 = acc[ai][bj][m][n]; *(f32x4*)(out + off + bj * HALF + n * 16) = bad1 ? (f32x4){qnan, qnan, qnan, qnan} : x1;
                        const f32x4 o = (x1 - sr.x) * sr.y; u32x2v w; w.x = cvt_pk_bf16(o[0], o[1]); w.y = cvt_pk_bf16(o[2], o[3]);
                        if (bad) { w.x = 0x7fc07fc0u; w.y = 0x7fc07fc0u; } *(u32x2v*)(xn + off + bj * HALF + n * 16) = w; }
                asm volatile("" ::: "memory"); }
    }
};

template <class Epi, class Sched, bool ALIGN_EPI = false, bool SP2 = false>
__device__ __forceinline__ void gemm_phase(PG8_LAS unsigned char* lds, const Gemm g, const Sched& S, const Epi& E) {
    const int tid = threadIdx.x, wid = __builtin_amdgcn_readfirstlane(tid >> 6), lane = tid & 63, wr = wid >> 2, wc = wid & 3, fr = lane & 15, fq = lane >> 4;
    const int K = g.K, nt = K / BK;
    unsigned voffA[2], voffB[2];
#pragma unroll
    for (int i = 0; i < 2; ++i) { int R, C; stage_rc(tid * 16 + i * 8192, R, C); const int Rb = Epi::PERM ? ((R & ~31) + perm32(R & 31)) : R;
        voffA[i] = (unsigned)(R * K + C) * 2u; voffB[i] = (unsigned)(Rb * K + C) * 2u; }
    const size_t kstep = (size_t)(BK * 2);
    const size_t hstep = (size_t)HALF * K * 2;
    const size_t tstep = 2 * hstep;
    const unsigned ldsw = (unsigned)wid * 1024u;
    const int aoff = lds_byte(wr * 64 + fr, fq * 8), boff = lds_byte(wc * 32 + fr, fq * 8);
#define PG8_SA(b, h) (((b) * 2 + (h)) * HTB)
#define PG8_SB(b, h) ((4 + (b) * 2 + (h)) * HTB)
#define PG8_STAGE(bufoff, gbase, voff) do { _Pragma("unroll") for (int _i = 0; _i < 2; ++_i) \
        __builtin_amdgcn_global_load_lds((const unsigned*)((const char*)(gbase) + (voff)[_i]), (PG8_LAS unsigned*)(lds + (bufoff) + ldsw + _i * 8192), 16, 0, 0); } while (0)
#define PG8_LDA(dst, b, h) do { _Pragma("unroll") for (int m = 0; m < 4; ++m) _Pragma("unroll") for (int k = 0; k < 2; ++k) dst[m][k] = *(const PG8_LAS bf16x8*)(lds + PG8_SA(b, h) + aoff + m * 2048 + k * 1024); } while (0)
#define PG8_LDB(dst, b, h) do { _Pragma("unroll") for (int n = 0; n < 2; ++n) _Pragma("unroll") for (int k = 0; k < 2; ++k) dst[n][k] = *(const PG8_LAS bf16x8*)(lds + PG8_SB(b, h) + boff + n * 2048 + k * 1024); } while (0)
#define PG8_MMA(ai, bj, At, Bt) do { __builtin_amdgcn_s_setprio(1); _Pragma("unroll") for (int m = 0; m < 4; ++m) _Pragma("unroll") for (int n = 0; n < 2; ++n) _Pragma("unroll") for (int k = 0; k < 2; ++k) \
        acc[ai][bj][m][n] = __builtin_amdgcn_mfma_f32_16x16x32_bf16(Bt[n][k], At[m][k], acc[ai][bj][m][n], 0, 0, 0); __builtin_amdgcn_s_setprio(0); } while (0)
#define PG8_WAIT_V(n) asm volatile("s_waitcnt vmcnt(" #n ")" ::: "memory")
#define PG8_WAIT_L(n) asm volatile("s_waitcnt lgkmcnt(" #n ")" ::: "memory")
#define PG8_BAR __builtin_amdgcn_s_barrier()
#define PG8_SCHED __builtin_amdgcn_sched_barrier(0)
    Unit cur, nxt; int ui = 0;
    if (!S.next(0, cur)) return;
    f32x4 acc[2][2][4][2];
#pragma unroll
    for (int a = 0; a < 2; ++a)
#pragma unroll
        for (int b = 0; b < 2; ++b)
#pragma unroll
            for (int m = 0; m < 4; ++m)
#pragma unroll
                for (int n = 0; n < 2; ++n) acc[a][b][m][n] = (f32x4){0.f, 0.f, 0.f, 0.f};
    bf16x8 At[4][2], B0[2][2], B1[2][2];
    const char* cA = (const char*)g.A + (size_t)cur.pm * tstep; const char* cB = (const char*)g.Bt + (size_t)cur.pn * tstep;
    S.a_ready(cur);
    if constexpr (SP2) {
        PG8_STAGE(PG8_SB(0, 0), cB, voffB); PG8_STAGE(PG8_SB(0, 1), cB + hstep, voffB); PG8_STAGE(PG8_SA(0, 0), cA, voffA); PG8_STAGE(PG8_SA(0, 1), cA + hstep, voffA);
        if (wr == 1) PG8_BAR;
        PG8_WAIT_V(2); PG8_BAR;
        PG8_STAGE(PG8_SB(1, 0), cB + kstep, voffB); PG8_STAGE(PG8_SA(1, 0), cA + kstep, voffA); PG8_STAGE(PG8_SB(1, 1), cB + hstep + kstep, voffB);
        PG8_WAIT_V(6); PG8_BAR;
    } else {
        PG8_STAGE(PG8_SB(0, 0), cB, voffB); PG8_STAGE(PG8_SA(0, 0), cA, voffA); PG8_STAGE(PG8_SB(0, 1), cB + hstep, voffB); PG8_STAGE(PG8_SA(0, 1), cA + hstep, voffA);
        if (wr == 1) PG8_BAR;
        PG8_WAIT_V(4); PG8_BAR;
        PG8_STAGE(PG8_SB(1, 0), cB + kstep, voffB); PG8_STAGE(PG8_SA(1, 0), cA + kstep, voffA); PG8_STAGE(PG8_SB(1, 1), cB + hstep + kstep, voffB);
        PG8_WAIT_V(6); PG8_BAR;
    }
    for (;;) {
        const bool has_next = S.next(ui + 1, nxt);
        const char* nA = has_next ? (const char*)g.A + (size_t)nxt.pm * tstep : cA; const char* nB = has_next ? (const char*)g.Bt + (size_t)nxt.pn * tstep : cB;
        for (int t = 0; t < nt; t += 2) {
            const bool last = (t == nt - 2);
            const char* a1 = cA + (size_t)(t + 1) * kstep;
            const char* a2 = last ? nA : cA + (size_t)(t + 2) * kstep; const char* b2 = last ? nB : cB + (size_t)(t + 2) * kstep;
            const char* a3 = a2 + kstep; const char* b3 = b2 + kstep;
            if (last && has_next) S.a_ready(nxt);
            if constexpr (SP2) {
            PG8_LDB(B0, 0, 0); PG8_LDB(B1, 0, 1); PG8_SCHED; PG8_LDA(At, 0, 0); PG8_STAGE(PG8_SA(1, 1), a1 + hstep, voffA);
            PG8_WAIT_V(8); PG8_WAIT_L(0); PG8_BAR; PG8_MMA(0, 0, At, B0); PG8_MMA(0, 1, At, B1); PG8_BAR; PG8_SCHED;
            PG8_LDA(At, 0, 1); PG8_STAGE(PG8_SB(0, 0), b2, voffB); PG8_STAGE(PG8_SB(0, 1), b2 + hstep, voffB); PG8_STAGE(PG8_SA(0, 0), a2, voffA);
            PG8_WAIT_V(8); PG8_WAIT_L(0); PG8_BAR; PG8_MMA(1, 0, At, B0); PG8_MMA(1, 1, At, B1); PG8_BAR; PG8_SCHED;
            PG8_LDB(B0, 1, 0); PG8_LDB(B1, 1, 1); PG8_SCHED; PG8_LDA(At, 1, 0); PG8_STAGE(PG8_SA(0, 1), a2 + hstep, voffA);
            PG8_WAIT_V(8); PG8_WAIT_L(0); PG8_BAR; PG8_MMA(0, 0, At, B0); PG8_MMA(0, 1, At, B1); PG8_BAR; PG8_SCHED;
            PG8_LDA(At, 1, 1); PG8_STAGE(PG8_SB(1, 0), b3, voffB); PG8_STAGE(PG8_SB(1, 1), b3 + hstep, voffB); PG8_STAGE(PG8_SA(1, 0), a3, voffA);
            PG8_WAIT_V(8); PG8_WAIT_L(0); PG8_BAR; PG8_MMA(1, 0, At, B0); PG8_MMA(1, 1, At, B1); PG8_BAR; PG8_SCHED;
            } else {
            PG8_LDB(B0, 0, 0); PG8_SCHED; PG8_LDA(At, 0, 0); PG8_STAGE(PG8_SA(1, 1), a1 + hstep, voffA);
            PG8_WAIT_L(8); PG8_BAR; PG8_WAIT_L(0); PG8_MMA(0, 0, At, B0); PG8_BAR; PG8_SCHED;
            PG8_LDB(B1, 0, 1); PG8_STAGE(PG8_SB(0, 0), b2, voffB);
            PG8_BAR; PG8_WAIT_L(0); PG8_MMA(0, 1, At, B1); PG8_BAR;
            PG8_LDA(At, 0, 1); PG8_STAGE(PG8_SA(0, 0), a2, voffA);
            PG8_BAR; PG8_WAIT_L(0); PG8_MMA(1, 0, At, B0); PG8_BAR; PG8_SCHED;
            PG8_STAGE(PG8_SB(0, 1), b2 + hstep, voffB);
            PG8_WAIT_V(6); PG8_BAR; PG8_MMA(1, 1, At, B1); PG8_BAR;
            PG8_LDB(B0, 1, 0); PG8_SCHED; PG8_LDA(At, 1, 0); PG8_STAGE(PG8_SA(0, 1), a2 + hstep, voffA);
            PG8_WAIT_L(8); PG8_BAR; PG8_WAIT_L(0); PG8_MMA(0, 0, At, B0); PG8_BAR; PG8_SCHED;
            PG8_LDB(B1, 1, 1); PG8_STAGE(PG8_SB(1, 0), b3, voffB);
            PG8_BAR; PG8_WAIT_L(0); PG8_MMA(0, 1, At, B1); PG8_BAR;
            PG8_LDA(At, 1, 1); PG8_STAGE(PG8_SA(1, 0), a3, voffA);
            PG8_BAR; PG8_WAIT_L(0); PG8_MMA(1, 0, At, B0); PG8_BAR; PG8_SCHED;
            PG8_STAGE(PG8_SB(1, 1), b3 + hstep, voffB);
            PG8_WAIT_V(6); PG8_BAR; PG8_MMA(1, 1, At, B1); PG8_BAR;
            }
        }
        if constexpr (ALIGN_EPI) { if (wr == 0) PG8_BAR; }
        if constexpr (!Epi::AFTER_DRAIN) { E(acc, cur, wr, wc, fr, fq); S.done(cur); }
        if (!has_next) break;
#pragma unroll
        for (int a = 0; a < 2; ++a)
#pragma unroll
            for (int b = 0; b < 2; ++b)
#pragma unroll
                for (int m = 0; m < 4; ++m)
#pragma unroll
                    for (int n = 0; n < 2; ++n) acc[a][b][m][n] = (f32x4){0.f, 0.f, 0.f, 0.f};
        cur = nxt; cA = nA; cB = nB; ++ui;
        if constexpr (ALIGN_EPI) { if (wr == 1) PG8_BAR; }
    }
    PG8_WAIT_V(0);
    if constexpr (!ALIGN_EPI) { if (wr == 0) PG8_BAR; }
    PG8_BAR;
    if constexpr (Epi::AFTER_DRAIN) { E.fused(acc, cur, wr, wc, fr, fq, lds, wid, lane); S.done(cur); }
#undef PG8_SA
#undef PG8_SB
#undef PG8_STAGE
#undef PG8_LDA
#undef PG8_LDB
#undef PG8_MMA
#undef PG8_WAIT_V
#undef PG8_WAIT_L
#undef PG8_BAR
#undef PG8_SCHED
}
}

namespace pg8 {
__device__ __forceinline__ float sigm(float x) { return 1.0f / (1.0f + __expf(-x)); }
__device__ __forceinline__ u32x4 pack8(const f32x4 a, const f32x4 b) { u32x4 w; w.x = cvt_pk_bf16(a[0], a[1]); w.y = cvt_pk_bf16(a[2], a[3]); w.z = cvt_pk_bf16(b[0], b[1]); w.w = cvt_pk_bf16(b[2], b[3]); return w; }

struct EpiF32 {
    static constexpr bool PERM = false, AFTER_DRAIN = false;
    float* C; int ldc;
    __device__ __forceinline__ void operator()(const f32x4 (&acc)[2][2][4][2], const Unit& u, int wr, int wc, int fr, int fq) const {
        const int row0 = u.pm * BM + wr * 64 + fr, col0 = u.pn * BM + wc * 32 + 4 * fq;
#pragma unroll
        for (int ai = 0; ai < 2; ++ai)
#pragma unroll
            for (int m = 0; m < 4; ++m) { float* rowp = C + (size_t)(row0 + ai * HALF + m * 16) * ldc + col0;
#pragma unroll
                for (int bj = 0; bj < 2; ++bj)
#pragma unroll
                    for (int n = 0; n < 2; ++n) *(f32x4*)(rowp + bj * HALF + n * 16) = acc[ai][bj][m][n]; }
    }
};

constexpr int MPROMPT = 16384; constexpr float QSCALE = 0.125f * 1.4426950408889634f;
struct EpiIn {
    static constexpr bool PERM = true, AFTER_DRAIN = false;
    bf16_t *Q, *K, *V, *HQ, *KK, *HI, *HG; float* LF; bf16_t *GA, *GB, *GAs, *GBs; float *okp, *ovp, *oks, *ovs; const float* lb; unsigned* mx;
    template <int TYPE> __device__ __forceinline__ void tile(const f32x4 (&acc)[2][2][4][2], const Unit& u, int ct, int wr, int wc, int fr, int fq) const {
        const bool samp = (u.pm == MPROMPT / BM);
        const int colb = ct * BM + wc * 32 + 8 * fq;
        float mxs[2] = {0.f, 0.f};
        f32x4 lbv[2][2];
        if (TYPE == 4) {
#pragma unroll
            for (int bj = 0; bj < 2; ++bj) { lbv[bj][0] = *(const f32x4*)(lb + colb + bj * HALF); lbv[bj][1] = *(const f32x4*)(lb + colb + bj * HALF + 4); }
        }
#pragma unroll
        for (int ai = 0; ai < 2; ++ai)
#pragma unroll
            for (int m = 0; m < 4; ++m) {
                const int row = u.pm * BM + ai * HALF + wr * 64 + m * 16 + fr; const int lrow = row - MPROMPT;
#pragma unroll
                for (int bj = 0; bj < 2; ++bj) {
                    const int col = colb + bj * HALF; f32x4 v0 = acc[ai][bj][m][0], v1 = acc[ai][bj][m][1];
                    if (TYPE <= 1 && !samp) { const float sc = TYPE == 0 ? QSCALE : 1.0f; const f32x4 a = v0 * sc, b = v1 * sc;
                        float s = (a[0] * a[0] + a[1] * a[1]) + (a[2] * a[2] + a[3] * a[3]) + (b[0] * b[0] + b[1] * b[1]) + (b[2] * b[2] + b[3] * b[3]);
                        s += __shfl_xor(s, 16); s += __shfl_xor(s, 32); mxs[bj] = fmaxf(mxs[bj], s); }
                    if (TYPE == 0) { *(u32x4*)(Q + (size_t)row * 512 + col) = pack8(v0 * QSCALE, v1 * QSCALE); }
                    else if (TYPE == 1 || TYPE == 2) {
                        bf16_t* B = TYPE == 1 ? K : V; *(u32x4*)(B + (size_t)row * 512 + col) = pack8(v0, v1);
                        float* o = nullptr;
                        if (!samp) o = (TYPE == 1 ? okp : ovp) + (size_t)row * 512 + col; else if (lrow < 128) o = (TYPE == 1 ? oks : ovs) + (size_t)lrow * 512 + col;
                        if (o) { *(f32x4*)o = v0; *(f32x4*)(o + 4) = v1; }
                    }
                    else if (TYPE == 3) { *(u32x4*)(HQ + (size_t)row * 512 + col) = pack8(v0, v1); }
                    else if (TYPE == 4) {
                        f32x4 f0, f1, l0, l1;
#pragma unroll
                        for (int j = 0; j < 4; ++j) { const float a = lbv[bj][0][j], b = lbv[bj][1][j];
                            f0[j] = a + (1.0f - a) * sigm(v0[j]); f1[j] = b + (1.0f - b) * sigm(v1[j]); l0[j] = __logf(f0[j]); l1[j] = __logf(f1[j]); }
                        float* lp = LF + (size_t)row * 512 + col; *(f32x4*)lp = l0; *(f32x4*)(lp + 4) = l1;
                        *(u32x4*)(KK + (size_t)row * 512 + col) = pack8(1.0f - f0, 1.0f - f1);
                    }
                    else if (TYPE == 5) { *(u32x4*)(HI + (size_t)row * 512 + col) = pack8(v0, v1); }
                    else {
                        f32x4 s0, s1;
#pragma unroll
                        for (int j = 0; j < 4; ++j) { s0[j] = sigm(v0[j]); s1[j] = sigm(v1[j]); }
                        if (TYPE == 6) *(u32x4*)(HG + (size_t)row * 512 + col) = pack8(s0, s1);
                        else { bf16_t* G = samp ? ((TYPE == 7 ? GAs : GBs) + (size_t)lrow * 1024) : ((TYPE == 7 ? GA : GB) + (size_t)row * 1024); *(u32x4*)(G + col) = pack8(s0, s1); }
                    }
                }
            }
        if (TYPE <= 1 && !samp) {
#pragma unroll
            for (int bj = 0; bj < 2; ++bj) { float r = mxs[bj]; r = fmaxf(r, __shfl_xor(r, 1)); r = fmaxf(r, __shfl_xor(r, 2)); r = fmaxf(r, __shfl_xor(r, 4)); r = fmaxf(r, __shfl_xor(r, 8));
                const int hd = ct * 4 + 2 * bj + (wc >> 1), half = wc & 1;
                if (fr == 0 && fq == 0) atomicMax(TYPE == 1 ? mx + hd * 2 + half : mx + 128 + (u.pm * 8 + hd) * 2 + half, __float_as_uint(r)); }
        }
    }
    __device__ __forceinline__ void operator()(const f32x4 (&acc)[2][2][4][2], const Unit& u, int wr, int wc, int fr, int fq) const {
        const int pn = u.pn;
        if (pn < 14) { const int ct = pn & 1;
            switch (pn >> 1) { case 0: tile<0>(acc, u, ct, wr, wc, fr, fq); break; case 1: tile<1>(acc, u, ct, wr, wc, fr, fq); break; case 2: tile<2>(acc, u, ct, wr, wc, fr, fq); break;
                               case 3: tile<3>(acc, u, ct, wr, wc, fr, fq); break; case 4: tile<4>(acc, u, ct, wr, wc, fr, fq); break; case 5: tile<5>(acc, u, ct, wr, wc, fr, fq); break;
                               default: tile<6>(acc, u, ct, wr, wc, fr, fq); break; } }
        else if (pn < 18) tile<7>(acc, u, pn - 14, wr, wc, fr, fq);
        else tile<8>(acc, u, pn - 18, wr, wc, fr, fq);
    }
};

constexpr int DFF = 2816;
struct EpiUpSplit {
    static constexpr bool PERM = true, AFTER_DRAIN = false;
    bf16_t *A, *G; float *cp, *cs;
    __device__ __forceinline__ void operator()(const f32x4 (&acc)[2][2][4][2], const Unit& u, int wr, int wc, int fr, int fq) const {
        const int cidx = 128 * u.pn + wc * 32 + 8 * fq;
#pragma unroll
        for (int ai = 0; ai < 2; ++ai)
#pragma unroll
            for (int m = 0; m < 4; ++m) {
                const int row = u.pm * BM + ai * HALF + wr * 64 + m * 16 + fr; const int lrow = row - MPROMPT;
                *(u32x4*)(A + (size_t)row * DFF + cidx) = pack8(acc[ai][0][m][0], acc[ai][0][m][1]);
                *(u32x4*)(G + (size_t)row * DFF + cidx) = pack8(acc[ai][1][m][0], acc[ai][1][m][1]);
                float* o = nullptr;
                if (row == MPROMPT - 2 || row == MPROMPT - 1) o = cp + (size_t)(row - (MPROMPT - 2)) * DFF + cidx;
                else if (lrow >= 0 && lrow < 128 && (lrow & 15) >= 14) o = cs + (size_t)((lrow >> 4) * 2 + ((lrow & 15) - 14)) * DFF + cidx;
                if (o) { *(f32x4*)o = acc[ai][0][m][0]; *(f32x4*)(o + 4) = acc[ai][0][m][1]; }
            }
    }
};
}
#include <hip/hip_bf16.h>
#include <cmath>
namespace attn_body {
using bf16=__hip_bfloat16;
using bf16x8=__attribute__((ext_vector_type(8)))short;
using s16x4=__attribute__((ext_vector_type(4)))short;
using f32x16=__attribute__((ext_vector_type(16)))float;
using u32x4=__attribute__((ext_vector_type(4)))unsigned;
constexpr int BATCH=1,NHEAD=8,SEQ=16384,D=64,DM=NHEAD*D;
constexpr int NW=8,QBLK=32,QB=QBLK*NW,KVBLK=64,NQB=SEQ/QB;
constexpr int ATTN_PITCH=DM, ATTN_UNIT_ROWS=QB;
__device__ __forceinline__ int crow(int r,int hi){return (r&3)+8*(r>>2)+4*hi;}
#define SBAR() __builtin_amdgcn_sched_barrier(0)
__device__ __forceinline__ void cmask(f32x16&p0,f32x16&p1,int jb,int qrel,int hi){
  const float NEG=-INFINITY; int kb=64*jb+4*hi;
  #pragma unroll
  for(int r=0;r<16;++r){int kv=kb+(r&3)+8*(r>>2); if(kv>qrel)p0[r]=NEG; if(kv+32>qrel)p1[r]=NEG;}
}

constexpr int NSLOT=3, SLOTB=8192;
constexpr int LDS_K=0, LDS_V=NSLOT*SLOTB, LDS_WS=2*NSLOT*SLOTB, LDS_OST=LDS_WS+NW*64*4, LDS_KB=LDS_OST+NW*4096, LDS_BYTES=LDS_KB+SEQ*4;
constexpr float C2=0.125f*1.4426950408889634f;
__device__ __forceinline__ void glds16(const void*gsrc,unsigned lds_dst){unsigned keep;
  asm volatile("s_mov_b32 %0, m0\n\ts_mov_b32 m0, %2\n\ts_nop 0\n\tglobal_load_lds_dwordx4 %1, off\n\ts_mov_b32 m0, %0":"=&s"(keep):"v"(gsrc),"s"(lds_dst):"memory");}
__device__ __forceinline__ float max3f(float a,float b,float c){float r;asm("v_max3_f32 %0, %1, %2, %3":"=v"(r):"v"(a),"v"(b),"v"(c));return r;}
__device__ __forceinline__ float max2f(float a,float b){float r;asm("v_max_f32_e32 %0, %1, %2":"=v"(r):"v"(a),"v"(b));return r;}
__device__ __forceinline__ float fadd_s(float a,float b){float r;asm("v_add_f32_e32 %0, %1, %2":"=v"(r):"v"(a),"v"(b));return r;}
__device__ __forceinline__ float fsub_s(float a,float b){float r;asm("v_sub_f32_e32 %0, %1, %2":"=v"(r):"v"(a),"v"(b));return r;}
typedef float f32x2_t __attribute__((ext_vector_type(2))); typedef __bf16 bf16x2_t __attribute__((ext_vector_type(2)));
__device__ __forceinline__ unsigned cvtpk_s(float lo,float hi){f32x2_t v={lo,hi};bf16x2_t b=__builtin_convertvector(v,bf16x2_t);return __builtin_bit_cast(unsigned,b);}
#define WAIT_BAR(N) asm volatile("s_waitcnt vmcnt(" #N ") lgkmcnt(0)\n\ts_barrier":::"memory")

__device__ __forceinline__ void split3(float x,unsigned&h,unsigned&m,unsigned&l){
  h=__float_as_uint(x)&0xffff0000u; const float r1=x-__uint_as_float(h);
  m=__float_as_uint(r1)&0xffff0000u; const float r2=r1-__uint_as_float(m);
  l=__float_as_uint(r2)&0xffff0000u; }
__device__ __forceinline__ bf16x8 mk_kaug(float kb,int hi){ unsigned h,m,l; split3(kb,h,m,l); const unsigned msk=hi?0u:0xffffffffu;
  const u32x4 w={((h>>16)|m)&msk,((l>>16)&msk)|(hi?0u:0x3F800000u),hi?0u:0x3F803F80u,0u}; return __builtin_bit_cast(bf16x8,w); }
__device__ __forceinline__ bf16x8 mk_qaug(float mhat,int hi){ unsigned h,m,l; split3(-mhat,h,m,l); const unsigned msk=hi?0u:0xffffffffu;
  const u32x4 w={hi?0u:0x3F803F80u,(hi?0u:0x00003F80u)|(h&msk),((m>>16)|l)&msk,0u}; return __builtin_bit_cast(bf16x8,w); }
__device__ __forceinline__ void qkt(f32x16&p0,f32x16&p1,const char*Kslot,const bf16x8*qr,bf16x8 ka0,bf16x8 ka1,bf16x8 qa,int r32,int hi){
  p0=__builtin_amdgcn_mfma_f32_32x32x16_bf16(ka0,qa,f32x16{},0,0,0); p1=__builtin_amdgcn_mfma_f32_32x32x16_bf16(ka1,qa,f32x16{},0,0,0);
  const char*kb=Kslot+hi*1024+r32*16;
  #pragma unroll
  for(int d0=0;d0<4;++d0){
    const bf16x8 b0=*reinterpret_cast<const bf16x8*>(kb+d0*2048);
    const bf16x8 b1=*reinterpret_cast<const bf16x8*>(kb+d0*2048+512);
    p0=__builtin_amdgcn_mfma_f32_32x32x16_bf16(b0,qr[d0],p0,0,0,0);p1=__builtin_amdgcn_mfma_f32_32x32x16_bf16(b1,qr[d0],p1,0,0,0);}
}
typedef __attribute__((address_space(3))) const char* lds_cptr;
typedef short v4i16_t __attribute__((ext_vector_type(4))); typedef float f32x4_t __attribute__((ext_vector_type(4)));
__device__ __forceinline__ void kload8(bf16x8*kf,lds_cptr kp){
  kf[0]=*(const __attribute__((address_space(3))) bf16x8*)(kp);      kf[1]=*(const __attribute__((address_space(3))) bf16x8*)(kp+512);
  kf[2]=*(const __attribute__((address_space(3))) bf16x8*)(kp+2048); kf[3]=*(const __attribute__((address_space(3))) bf16x8*)(kp+2560);
  kf[4]=*(const __attribute__((address_space(3))) bf16x8*)(kp+4096); kf[5]=*(const __attribute__((address_space(3))) bf16x8*)(kp+4608);
  kf[6]=*(const __attribute__((address_space(3))) bf16x8*)(kp+6144); kf[7]=*(const __attribute__((address_space(3))) bf16x8*)(kp+6656);
}
__device__ __forceinline__ void kload2(bf16x8*kf,lds_cptr kp,int j){ kf[2*j]=*(const __attribute__((address_space(3))) bf16x8*)(kp+j*2048); kf[2*j+1]=*(const __attribute__((address_space(3))) bf16x8*)(kp+j*2048+512); }
__device__ __forceinline__ s16x4 vtr(lds_cptr p){ return __builtin_bit_cast(s16x4,__builtin_amdgcn_ds_read_tr16_b64_v4i16((__attribute__((address_space(3))) v4i16_t*)p)); }
__device__ __forceinline__ float rowmax(const f32x16&p0,const f32x16&p1){
  float a=max3f(p0[0],p0[1],p1[0]),b=max3f(p0[2],p0[3],p1[1]);a=max3f(a,p1[2],p1[3]);
  #pragma unroll
  for(int r=4;r<16;r+=4){a=max3f(a,p0[r],p0[r+1]);b=max3f(b,p0[r+2],p0[r+3]);a=max3f(a,p1[r],p1[r+1]);b=max3f(b,p1[r+2],p1[r+3]);}
  const float m=max2f(a,b);
  auto rr=__builtin_amdgcn_permlane32_swap(__float_as_uint(m),__float_as_uint(m),false,false);
  return max2f(__uint_as_float(rr[0]),__uint_as_float(rr[1]));
}
__device__ __forceinline__ void pv(f32x16*o,int vb,bf16x8 pa0,bf16x8 pa1,bf16x8 pa2,bf16x8 pa3){
  #pragma unroll
  for(int d0=0;d0<2;++d0){s16x4 lo[4],hi[4];
    #pragma unroll
    for(int ks=0;ks<4;++ks){
      asm volatile("ds_read_b64_tr_b16 %0,%1 offset:%c2":"=&v"(lo[ks]):"v"(vb),"i"(d0*4096+ks*1024):"memory");
      asm volatile("ds_read_b64_tr_b16 %0,%1 offset:%c2":"=&v"(hi[ks]):"v"(vb),"i"(d0*4096+ks*1024+512):"memory");}
    asm volatile("s_waitcnt lgkmcnt(0)":::"memory");SBAR();
    #define PK(k) (bf16x8){lo[k][0],lo[k][1],lo[k][2],lo[k][3],hi[k][0],hi[k][1],hi[k][2],hi[k][3]}
    o[d0]=__builtin_amdgcn_mfma_f32_32x32x16_bf16(pa0,PK(0),o[d0],0,0,0);
    o[d0]=__builtin_amdgcn_mfma_f32_32x32x16_bf16(pa1,PK(1),o[d0],0,0,0);
    o[d0]=__builtin_amdgcn_mfma_f32_32x32x16_bf16(pa2,PK(2),o[d0],0,0,0);
    o[d0]=__builtin_amdgcn_mfma_f32_32x32x16_bf16(pa3,PK(3),o[d0],0,0,0);
    #undef PK
  }
}

#ifndef ATTN_STORE16
#define ATTN_STORE16(p,v) (*(u32x4*)(p)=(v))
#endif
template<int THRL> __device__ __forceinline__ void attn_unit(int h,int qb,int tskip,const float*__restrict__ kbh,const bf16*Q,const bf16*__restrict__ K,const bf16*__restrict__ V,bf16*O,char*shm){
  int tid_=threadIdx.x; asm volatile("":"+v"(tid_));
  const int tid=tid_,lane=tid&63,r32=lane&31,hi=lane>>5; const int wid=__builtin_amdgcn_readfirstlane(tid>>6);
  const long rowbase=0; const int q0=qb*QB;
  const bf16*Qw=Q+(rowbase+q0+wid*QBLK)*DM+h*D;
  const bf16*Kh=K+(long)tskip*KVBLK*DM+h*D,*Vh=V+(long)tskip*KVBLK*DM+h*D;
  const unsigned lds0=(unsigned)(uintptr_t)shm;
  float*wsf=(float*)(shm+LDS_WS)+wid*64;
  const bf16*ksrc=Kh+(long)lane*DM+wid*8;
  const bf16*vsrc=Vh+(long)(16*(wid&3)+(lane>>2))*DM+(wid>>2)*32+(lane&3)*8;
  const unsigned kdst=lds0+LDS_K+wid*1024, vdst=lds0+LDS_V+wid*1024;
  #define DMA_K(t,slot) glds16(ksrc+(long)(t)*KVBLK*DM,(unsigned)__builtin_amdgcn_readfirstlane(kdst+(slot)))
  #define DMA_V(t,slot) glds16(vsrc+(long)(t)*KVBLK*DM,(unsigned)__builtin_amdgcn_readfirstlane(vdst+(slot)))
  const int vb0=(int)(lds0+LDS_V)+((lane>>4)&1)*32+(lane&3)*8+(4*hi+((lane&15)>>2))*64;
  const char*Kbase=shm+LDS_K; bf16x8 kf[8];
  const lds_cptr shm3=(lds_cptr)shm; const lds_cptr kp0=shm3+LDS_K+hi*1024+r32*16; const lds_cptr vp0=shm3+LDS_V+((lane>>4)&1)*32+(lane&3)*8+(4*hi+((lane&15)>>2))*64;
  const int NT=(q0+QB)/KVBLK-tskip;
  DMA_K(0,0);DMA_V(0,0);DMA_K(1,SLOTB);
  bf16x8 qr[4];
  #pragma unroll
  for(int d0=0;d0<4;++d0)qr[d0]=*reinterpret_cast<const bf16x8*>(&Qw[(long)r32*DM+d0*16+hi*8]);
  { const float*kg=kbh+(long)tskip*KVBLK; __attribute__((address_space(3))) float*kl=(__attribute__((address_space(3))) float*)(shm3+LDS_KB);
    for(int i=tid;i<NT*KVBLK;i+=NW*64)kl[i]=kg[i]; }
  const __attribute__((address_space(3))) float*kl3=(const __attribute__((address_space(3))) float*)(shm3+LDS_KB)+r32;
  bf16x8 qa=mk_qaug(0.f,hi); float kbv0,kbv1;
  float mhat=0.f,l_reg=0.f;f32x16 o[2];o[0]=f32x16{};o[1]=f32x16{};
  const int qrel=wid*QBLK+r32;
  #define CMASK(P0,P1,t) do{int jb_=(t)-(NT-4); if(jb_>=0)cmask(P0,P1,jb_,qrel,hi);}while(0)
  bool resc=false;
  #define START(P0,P1) do{ const float rm=rowmax(P0,P1); resc=false; \
    { const float dl=rm; mhat=fadd_s(mhat,dl); qa=mk_qaug(mhat,hi); \
      _Pragma("unroll") for(int r=0;r<16;++r){P0[r]=fsub_s(P0[r],dl);P1[r]=fsub_s(P1[r],dl);} \
      } \
    _Pragma("unroll") for(int r=0;r<16;++r)P0[r]=__builtin_amdgcn_exp2f(P0[r]); }while(0)
  #define RESC() do{ if(resc){ asm volatile("s_waitcnt lgkmcnt(0)":::"memory"); \
      _Pragma("unroll") for(int d_=0;d_<2;++d_) _Pragma("unroll") for(int r=0;r<16;++r)o[d_][r]*=wsf[crow(r,hi)]; } }while(0)
  f32x16 pA0,pA1,pB0,pB1;
  int sl_prev=0,sl_cur=0,sl_next=SLOTB;
  #define ROT() do{sl_prev=sl_cur;sl_cur=sl_next;sl_next=(sl_next==(NSLOT-1)*SLOTB)?0:sl_next+SLOTB;}while(0)
  DMA_K(2,2*SLOTB);
  WAIT_BAR(3);
  kbv0=kl3[0];kbv1=kl3[32];
  qkt(pA0,pA1,Kbase,qr,mk_kaug(kbv0,hi),mk_kaug(kbv1,hi),qa,r32,hi);asm volatile("s_nop 15\n\ts_nop 7":"+v"(pA0),"+v"(pA1));CMASK(pA0,pA1,0);
  kbv0=kl3[64];kbv1=kl3[96];
  START(pA0,pA1);
  _Pragma("unroll") for(int r=0;r<16;++r)pA1[r]=__builtin_amdgcn_exp2f(pA1[r]);
  WAIT_BAR(0);
  DMA_K(3,0);DMA_V(1,SLOTB);
  ROT();
  kload8(kf,kp0+sl_cur);
  WAIT_BAR(2);
  s16x4 vlo[8],vhi[8]; u32x4 pw0,pw1,pw2,pw3;
  #define PKW(P,B) cvtpk_s(P[B],P[B+1])
  #define PAF(k) __builtin_bit_cast(bf16x8,pw##k)
  #define VFR(i) (bf16x8){vlo[i][0],vlo[i][1],vlo[i][2],vlo[i][3],vhi[i][0],vhi[i][1],vhi[i][2],vhi[i][3]}
  #define PIN(x) asm volatile("":"+v"(x))
  #define MX3(a,b,c) __builtin_fmaxf(__builtin_fmaxf((a),(b)),(c))
  #define GAPA(MF,A0,A1,A2,A3,W0,W1,PW) do{ MF; sacc+=A0; sacc+=A1; sacc+=A2; sacc+=A3; PIN(sacc); W0; W1; PIN(PW); SBAR(); }while(0)
  #define EX(v) __builtin_amdgcn_exp2f(v)
  #define GAPB(MF,X,B) do{ MF; X[B]=EX(X[B]); X[B+1]=EX(X[B+1]); X[B+2]=EX(X[B+2]); X[B+3]=EX(X[B+3]); PIN(X); SBAR(); }while(0)
  #define VRD(i) do{ vlo[i]=vtr(vp_+(((i)>>2)*4096+((i)&3)*1024)); vhi[i]=vtr(vp_+(((i)>>2)*4096+((i)&3)*1024+512)); }while(0)
  #define KRD(G,j) do{ if(G){ kload2(kf,kp0+sl_next,j); SBAR(); } }while(0)
  #define STEP(C0,C1,P0,P1,t,GK,GV,GL) do{ SBAR(); \
    const lds_cptr vp_=vp0+sl_prev; \
    { const bf16x8 ka0_=mk_kaug(kbv0,hi),ka1_=mk_kaug(kbv1,hi); \
      C0=__builtin_amdgcn_mfma_f32_32x32x16_bf16(ka0_,qa,f32x16{},0,0,0); C1=__builtin_amdgcn_mfma_f32_32x32x16_bf16(ka1_,qa,f32x16{},0,0,0); \
      kbv0=kl3[((t)+1)*64]; kbv1=kl3[((t)+1)*64+32]; } SBAR(); \
    VRD(0); SBAR(); float sacc=(P0[0]+P0[1]); \
    GAPA(C0=__builtin_amdgcn_mfma_f32_32x32x16_bf16(kf[0],qr[0],C0,0,0,0), P0[2],P0[3],P0[4],P0[5],     pw0[0]=PKW(P0,0), pw0[1]=PKW(P0,2), pw0); \
    VRD(4); SBAR(); GAPA(C1=__builtin_amdgcn_mfma_f32_32x32x16_bf16(kf[1],qr[0],C1,0,0,0), P0[6],P0[7],P0[8],P0[9],     pw0[2]=PKW(P0,4), pw0[3]=PKW(P0,6), pw0); \
    VRD(1); SBAR(); GAPA(C0=__builtin_amdgcn_mfma_f32_32x32x16_bf16(kf[2],qr[1],C0,0,0,0),   P0[10],P0[11],P0[12],P0[13], pw1[0]=PKW(P0,8), pw1[1]=PKW(P0,10), pw1); \
    VRD(5); SBAR(); GAPA(C1=__builtin_amdgcn_mfma_f32_32x32x16_bf16(kf[3],qr[1],C1,0,0,0),   P0[14],P0[15],P1[0],P1[1],   pw1[2]=PKW(P0,12),pw1[3]=PKW(P0,14), pw1); \
    VRD(2); SBAR(); GAPA(C0=__builtin_amdgcn_mfma_f32_32x32x16_bf16(kf[4],qr[2],C0,0,0,0),   P1[2],P1[3],P1[4],P1[5],     pw2[0]=PKW(P1,0), pw2[1]=PKW(P1,2), pw2); \
    VRD(6); SBAR(); GAPA(C1=__builtin_amdgcn_mfma_f32_32x32x16_bf16(kf[5],qr[2],C1,0,0,0),   P1[6],P1[7],P1[8],P1[9],     pw2[2]=PKW(P1,4), pw2[3]=PKW(P1,6), pw2); \
    VRD(3); SBAR(); GAPA(C0=__builtin_amdgcn_mfma_f32_32x32x16_bf16(kf[6],qr[3],C0,0,0,0),   P1[10],P1[11],P1[12],P1[13], pw3[0]=PKW(P1,8), pw3[1]=PKW(P1,10), pw3); \
    VRD(7); SBAR(); GAPA(C1=__builtin_amdgcn_mfma_f32_32x32x16_bf16(kf[7],qr[3],C1,0,0,0),   P1[14],P1[15],0.f,0.f,       pw3[2]=PKW(P1,12),pw3[3]=PKW(P1,14), pw3); \
    l_reg+=sacc; \
    if(GK){DMA_K((t)+3,sl_cur);} if(GV){DMA_V((t)+1,sl_next);} \
    CMASK(C0,C1,t); \
    { float a=MX3(C0[0],C0[1],C1[0]),b=MX3(C0[2],C0[3],C1[1]); a=MX3(a,C1[2],C1[3]); \
      _Pragma("unroll") for(int r=4;r<16;r+=4){a=MX3(a,C0[r],C0[r+1]);b=MX3(b,C0[r+2],C0[r+3]);a=MX3(a,C1[r],C1[r+1]);b=MX3(b,C1[r+2],C1[r+3]);} \
      float rm=__builtin_fmaxf(a,b); { auto rr=__builtin_amdgcn_permlane32_swap(__float_as_uint(rm),__float_as_uint(rm),false,false); rm=__builtin_fmaxf(__uint_as_float(rr[0]),__uint_as_float(rr[1])); } \
      resc=false; \
      if(__builtin_expect(__any(rm>(float)THRL),0)){ const float dl=__builtin_fmaxf(rm,0.f); mhat+=dl; qa=mk_qaug(mhat,hi); \
        _Pragma("unroll") for(int r=0;r<16;++r){C0[r]-=dl;C1[r]-=dl;} \
        const float f=__builtin_amdgcn_exp2f(-dl); l_reg*=f; if(hi==0)wsf[r32]=f; resc=true; } } \
    SBAR(); \
    GAPB(o[0]=__builtin_amdgcn_mfma_f32_32x32x16_bf16(PAF(0),VFR(0),o[0],0,0,0), C0,0); \
    GAPB(o[1]=__builtin_amdgcn_mfma_f32_32x32x16_bf16(PAF(0),VFR(4),o[1],0,0,0), C0,4); \
    KRD(GL,0); GAPB(o[0]=__builtin_amdgcn_mfma_f32_32x32x16_bf16(PAF(1),VFR(1),o[0],0,0,0), C0,8); \
    KRD(GL,1); GAPB(o[1]=__builtin_amdgcn_mfma_f32_32x32x16_bf16(PAF(1),VFR(5),o[1],0,0,0), C0,12); \
    KRD(GL,2); GAPB(o[0]=__builtin_amdgcn_mfma_f32_32x32x16_bf16(PAF(2),VFR(2),o[0],0,0,0), C1,0); \
    KRD(GL,3); GAPB(o[1]=__builtin_amdgcn_mfma_f32_32x32x16_bf16(PAF(2),VFR(6),o[1],0,0,0), C1,4); \
    GAPB(o[0]=__builtin_amdgcn_mfma_f32_32x32x16_bf16(PAF(3),VFR(3),o[0],0,0,0), C1,8); \
    GAPB(o[1]=__builtin_amdgcn_mfma_f32_32x32x16_bf16(PAF(3),VFR(7),o[1],0,0,0), C1,12); \
    }while(0)
  int t=1;
  #undef CMASK
  #define CMASK(P0,P1,t) do{}while(0)
  for(;t+5<NT;t+=2){
    STEP(pB0,pB1,pA0,pA1,t,true,true,true);     WAIT_BAR(2); RESC(); ROT();
    STEP(pA0,pA1,pB0,pB1,t+1,true,true,true);   WAIT_BAR(2); RESC(); ROT();
  }
  #undef CMASK
  #define CMASK(P0,P1,t) do{int jb_=(t)-(NT-4); if(jb_>=0)cmask(P0,P1,jb_,qrel,hi);}while(0)
  #define ENDW(tt) do{ if((tt)+3<NT){WAIT_BAR(2);} else if((tt)+2<NT){WAIT_BAR(1);} else {WAIT_BAR(0);} }while(0)
  for(;t+1<NT;t+=2){
    STEP(pB0,pB1,pA0,pA1,t,(t+3<NT),(t+1<NT),(t+1<NT));       ENDW(t);   RESC(); ROT();
    STEP(pA0,pA1,pB0,pB1,t+1,(t+4<NT),(t+2<NT),(t+2<NT));     ENDW(t+1); RESC(); ROT();
  }
  STEP(pB0,pB1,pA0,pA1,NT-1,false,false,false); RESC();
  { float sacc=pB0[0]+pB0[1]; _Pragma("unroll") for(int r=2;r<16;++r)sacc+=pB0[r]; _Pragma("unroll") for(int r=0;r<16;++r)sacc+=pB1[r]; l_reg+=sacc;
    pw0=(u32x4){PKW(pB0,0),PKW(pB0,2),PKW(pB0,4),PKW(pB0,6)};pw1=(u32x4){PKW(pB0,8),PKW(pB0,10),PKW(pB0,12),PKW(pB0,14)};pw2=(u32x4){PKW(pB1,0),PKW(pB1,2),PKW(pB1,4),PKW(pB1,6)};pw3=(u32x4){PKW(pB1,8),PKW(pB1,10),PKW(pB1,12),PKW(pB1,14)};
    SBAR(); pv(o,vb0+sl_cur,PAF(0),PAF(1),PAF(2),PAF(3)); }
  #undef PKW
  #undef PAF
  #undef VFR
  #undef PIN
  #undef MX3
  #undef GAPA
  #undef GAPB
  #undef EX
  #undef VRD
  #undef KRD
  #undef STEP
  #undef ENDW
  {auto rr=__builtin_amdgcn_permlane32_swap(__float_as_uint(l_reg),__float_as_uint(l_reg),false,false);l_reg=__uint_as_float(rr[0])+__uint_as_float(rr[1]);}
  if(hi==0)wsf[32+r32]=l_reg;asm volatile("s_waitcnt lgkmcnt(0)":::"memory");
  float rli[16];
  #pragma unroll
  for(int r=0;r<16;++r)rli[r]=__builtin_amdgcn_rcpf(wsf[32+crow(r,hi)]);
  bf16*Ow=O+(rowbase+q0+wid*QBLK)*DM+h*D;
  { bf16*stg=(bf16*)(shm+LDS_OST)+wid*2048;
    #pragma unroll
    for(int r=0;r<16;++r){const int orow=crow(r,hi);
      #pragma unroll
      for(int d0=0;d0<2;++d0)stg[orow*64+d0*32+r32]=__float2bfloat16(o[d0][r]*rli[r]);}
    asm volatile("s_waitcnt lgkmcnt(0)":::"memory");
    #pragma unroll
    for(int i=0;i<4;++i){const int row=i*8+(lane>>3),ch=lane&7; const u32x4 v=*(const u32x4*)(stg+row*64+ch*8); ATTN_STORE16(Ow+(long)row*DM+ch*8,v);} }
  asm volatile("s_waitcnt lgkmcnt(0)\n\ts_barrier":::"memory");
  #undef DMA_K
  #undef DMA_V
  #undef CMASK
  #undef START
  #undef RESC
  #undef ROT
}
constexpr int ATTN_LDS_BYTES=LDS_BYTES;
#undef SBAR
#undef WAIT_BAR
}

constexpr int NWAVES = 8, NTHR = 512;
constexpr int DMODEL = 1024, MP = 16384, MS = 128, MTOT = MP + MS, MPAD = 16640;
constexpr int FW = 512, NINP = 5632, NIN = 5640, DFF = 2816, PAST = 4096, SKS = 4112;
constexpr float RMS_EPS = 1e-6f, LOG2E = 1.4426950408889634f, C2 = 0.125f * 1.4426950408889634f;

constexpr size_t OFF_Y = 0, OFF_YS = 16777216, OFF_PK = 16908288, OFF_PV = 25296896, OFF_PLF = 33685504, OFF_PH = 33816576, OFF_PC = 33882112,
                 OFF_SK = 33887744, OFF_SV = 33953280, OFF_SLF = 34018816, OFF_SH = 34019840, OFF_SC = 34544128, OUT_TOTAL = 34589184;
constexpr size_t MiB = 1u << 20;
constexpr size_t SZ512 = (size_t)MPAD * 512 * 2, SZ1024 = (size_t)MPAD * 1024 * 2;
constexpr size_t WS_CTL = 0, CTL_ZERO_BYTES = 1 * MiB;
constexpr size_t WS_LB = 1 * MiB, WS_KB = WS_LB + 65536, WS_SKB = WS_KB + 524288;
constexpr size_t WS_GAS = 3 * MiB, WS_GBS = WS_GAS + 524288;
constexpr size_t WS_WIN = 4 * MiB, WS_WBF = 15 * MiB, WS_WBH = 16 * MiB, WS_WOUT = 17 * MiB, WS_WUP = 19 * MiB, WS_WDN = 30 * MiB;
constexpr size_t WS_H1 = 36 * MiB;
constexpr size_t WS_Q = WS_H1 + SZ1024, WS_OH = WS_Q + SZ512, WS_K = WS_OH + SZ512, WS_V = WS_K + SZ512, WS_HQ = WS_V + SZ512, WS_KK = WS_HQ + SZ512,
                 WS_HI = WS_KK + SZ512, WS_HG = WS_HI + SZ512, WS_LF = WS_HG + SZ512, WS_END1 = WS_LF + 2 * SZ512;
constexpr size_t WS_BRF = WS_K, WS_BRH = WS_K + 4 * SZ512, WS_MERGED = WS_H1, WS_MIX = WS_K, WS_H2 = WS_H1;
constexpr size_t WS_ABUF = WS_Q, WS_GBUF = WS_ABUF + (size_t)MPAD * DFF * 2, WS_FFN = WS_Q, WS_END = WS_GBUF + (size_t)MPAD * DFF * 2;
static_assert(WS_END <= 256 * MiB && WS_END1 <= 256 * MiB, "d_ws map");
constexpr int CW_TMO = 0, CW_CODE = 1, CW_BAR = 4096;
constexpr int RING_OFF = 0, RING_BYTES = 131072, LDSCTL_OFF = 149504, MISC_OFF = LDSCTL_OFF + 320, LDS_BYTES = 150528;
constexpr int CW_KMX = 8192, CW_QMX = CW_KMX + 128;
static_assert(attn_body::ATTN_LDS_BYTES <= LDSCTL_OFF, "attention LDS");

#define GAS __attribute__((address_space(1)))
#define LAS __attribute__((address_space(3)))
typedef unsigned short bf16;
typedef unsigned v4u __attribute__((ext_vector_type(4)));
typedef float f32x4 __attribute__((ext_vector_type(4)));
typedef short bf16x8 __attribute__((ext_vector_type(8)));
typedef GAS unsigned gu32;
typedef GAS unsigned long long gu64;
#define RLX_AGENT __ATOMIC_RELAXED, __HIP_MEMORY_SCOPE_AGENT
#define LDS_WAIT() asm volatile("s_waitcnt lgkmcnt(0)" ::: "memory")
#define VM_WAIT() asm volatile("s_waitcnt vmcnt(0)" ::: "memory")
__device__ __forceinline__ unsigned long long rt() { return __builtin_amdgcn_s_memrealtime(); }
__device__ __forceinline__ unsigned f2bf(float f) { unsigned u = __builtin_bit_cast(unsigned, f); return (u + 0x7fffu + ((u >> 16) & 1u)) >> 16; }
__device__ __forceinline__ unsigned pk2(float lo, float hi) { return f2bf(lo) | (f2bf(hi) << 16); }

#define XB_TMO      128
#define XB_XCNT(j)  (256  + 64 * (j))
#define XB_XSUB(j)  (1280 + 64 * (j))
#define XB_XGEN(j)  (2304 + 64 * (j))
#define XB_TOP      3328
#define XB_TOPGEN   3392
#define XCD_BAR_WORDS 3456
#define XB_SPIN_CAP (1u << 26)

__device__ __forceinline__ unsigned xb_ld(unsigned* p)              { return __hip_atomic_load(p, __ATOMIC_RELAXED, __HIP_MEMORY_SCOPE_AGENT); }
__device__ __forceinline__ unsigned xb_add(unsigned* p, unsigned v) { return __hip_atomic_fetch_add(p, v, __ATOMIC_RELAXED, __HIP_MEMORY_SCOPE_AGENT); }
__device__ __forceinline__ unsigned xb_xcc_id() { return (unsigned)__builtin_amdgcn_s_getreg((3 << 11) | 20) & 0xFu; }
#define XB_SPIN(cond, bar) do { unsigned _sp = 0; while (cond) { __builtin_amdgcn_s_sleep(1); \
    if ((++_sp & 255u) == 0u) { if (xb_ld(&(bar)[XB_TMO])) break; if (_sp > XB_SPIN_CAP) { atomicAdd(&(bar)[XB_TMO], 1u); break; } } } } while (0)

struct XcdBarrier {
    unsigned* bar; unsigned x;
    volatile LAS unsigned* st;
};

__device__ __forceinline__ XcdBarrier xcd_barrier_post(unsigned* bar, volatile LAS unsigned* st) {
    XcdBarrier b; b.bar = bar; b.x = xb_xcc_id(); b.st = st;
    if (threadIdx.x == 0) (void)xb_add(&bar[XB_XCNT(b.x)], 1u);
    return b;
}
__device__ __forceinline__ void xcd_barrier_complete(unsigned* bar, unsigned x, unsigned& nloc, unsigned& nx) {
    const unsigned G = gridDim.x * gridDim.y * gridDim.z;
    unsigned sum, cnt, mine, sp = 0u;
    for (;;) {
        sum = 0u; cnt = 0u; mine = 0u;
#pragma unroll
        for (unsigned j = 0; j < 16; ++j) { const unsigned c = xb_ld(&bar[XB_XCNT(j)]); sum += c; cnt += (c > 0u) ? 1u : 0u; mine = (j == x) ? c : mine; }
        if (sum == G) break;
        __builtin_amdgcn_s_sleep(1);
        if ((++sp & 255u) == 0u) { if (xb_ld(&bar[XB_TMO])) break; if (sp > XB_SPIN_CAP) { atomicAdd(&bar[XB_TMO], 1u); break; } }
    }
    nloc = mine > 0u ? mine : 1u; nx = cnt > 0u ? cnt : 1u;
}

__device__ __forceinline__ void xcd_barrier(const XcdBarrier& b) {
    asm volatile("s_waitcnt vmcnt(0)" ::: "memory");
    __syncthreads();
    if (threadIdx.x == 0) {
        unsigned* bar = b.bar;
        __builtin_amdgcn_s_waitcnt(0);
        unsigned nloc = b.st[0], nx = b.st[1];
        if (nloc == 0u) { xcd_barrier_complete(bar, b.x, nloc, nx); b.st[0] = nloc; b.st[1] = nx; }
        const unsigned old = xb_add(&bar[XB_XSUB(b.x)], 1u);
        const unsigned gen = old / nloc;
        if (old + 1u == (gen + 1u) * nloc) {
            __builtin_amdgcn_fence(__ATOMIC_RELEASE, "agent");
            asm volatile("s_waitcnt vmcnt(0)" ::: "memory");
            const unsigned og = xb_add(&bar[XB_TOP], 1u);
            const unsigned tg = og / nx;
            if (og + 1u == (tg + 1u) * nx) xb_add(&bar[XB_TOPGEN], 1u);
            else XB_SPIN(xb_ld(&bar[XB_TOPGEN]) == tg, bar);
            __builtin_amdgcn_fence(__ATOMIC_ACQUIRE, "agent");
            xb_add(&bar[XB_XGEN(b.x)], 1u);
            asm volatile("s_waitcnt vmcnt(0)" ::: "memory");
        } else {
            XB_SPIN(xb_ld(&bar[XB_XGEN(b.x)]) == gen, bar);
            __builtin_amdgcn_fence(__ATOMIC_ACQUIRE, "agent");
            asm volatile("s_waitcnt vmcnt(0)" ::: "memory");
        }
    }
    __syncthreads();
}


__device__ __forceinline__ float wave_sum(float v) {
#pragma unroll
    for (int o = 1; o < 64; o <<= 1) v += __shfl_xor(v, o);
    return v;
}
__device__ __forceinline__ float bf2f(unsigned short b) { return __builtin_bit_cast(float, (unsigned)b << 16); }
__device__ __forceinline__ float bflo(unsigned u) { return __builtin_bit_cast(float, u << 16); }
__device__ __forceinline__ float bfhi(unsigned u) { return __builtin_bit_cast(float, u & 0xffff0000u); }
__device__ __forceinline__ float sigm(float x) { return 1.0f / (1.0f + __expf(-x)); }

struct Frame {
    LAS unsigned char* lds; volatile LAS unsigned* MISC; gu32* ctl;
    int tid, lane, wave, vcu, G;
    const float *xp, *xs, *ck, *cv, *clf, *sh, *sc, *g_pre, *g_post, *w_in, *fbias, *lbl, *hgn, *w_bf, *w_bh, *w_out, *g_pre2, *g_post2, *w_up, *cw, *cb, *w_dn;
    float* out; unsigned char* ws;
};
#define WSP(T, off) ((T*)(F.ws + (off)))

__device__ __forceinline__ void tr_item(const float* W, int ldW, bf16* WT, int Kd, int k0, int nsrc0, int drow0, LAS float* scr, int lane) {
#pragma unroll 8
    for (int i = 0; i < 32; ++i) { const int kk = 2 * i + (lane >> 5); scr[kk * 33 + (lane & 31)] = W[(size_t)(k0 + kk) * ldW + nsrc0 + (lane & 31)]; }
    LDS_WAIT(); asm volatile("" ::: "memory");
    const int c = lane & 7;
#pragma unroll
    for (int j = 0; j < 4; ++j) { const int n = (lane >> 3) + 8 * j; const LAS float* s = scr + (8 * c) * 33 + n;
        v4u o; o.x = pk2(s[0 * 33], s[1 * 33]); o.y = pk2(s[2 * 33], s[3 * 33]); o.z = pk2(s[4 * 33], s[5 * 33]); o.w = pk2(s[6 * 33], s[7 * 33]);
        *(GAS v4u*)(WT + (size_t)(drow0 + n) * Kd + k0 + 8 * c) = o; }
    LDS_WAIT(); asm volatile("" ::: "memory");
}
__device__ __forceinline__ void p0_prologue(Frame& F) {
    LAS float* scr = (LAS float*)(F.lds + RING_OFF + F.wave * 16384);
    const int gw = F.vcu * NWAVES + F.wave, NGW = F.G * NWAVES;
    constexpr int I0 = 16 * 48, I1 = 16 * 128, I2 = 8 * 32, I3 = 8 * 32, I4 = 16 * 32, I5 = 16 * 176, I6 = 44 * 32, NITEMS = I0 + I1 + I2 + I3 + I4 + I5 + I6;
    for (int it = gw; it < NITEMS; it += NGW) {
        int r = it;
        if (r < I0) { const int kb = r / 48, nb = r % 48; tr_item(F.w_in, NIN, WSP(bf16, WS_WIN), 1024, 64 * kb, 32 * nb, 32 * nb, scr, F.lane); continue; } r -= I0;
        if (r < I1) { const int kb = r / 128, nb = r % 128; tr_item(F.w_in, NIN, WSP(bf16, WS_WIN), 1024, 64 * kb, 1544 + 32 * nb, 1536 + 32 * nb, scr, F.lane); continue; } r -= I1;
        if (r < I2) { const int kb = r / 32, nb = r % 32; tr_item(F.w_bf, 1024, WSP(bf16, WS_WBF), 512, 64 * kb, 32 * nb, 32 * nb, scr, F.lane); continue; } r -= I2;
        if (r < I3) { const int kb = r / 32, nb = r % 32; tr_item(F.w_bh, 1024, WSP(bf16, WS_WBH), 512, 64 * kb, 32 * nb, 32 * nb, scr, F.lane); continue; } r -= I3;
        if (r < I4) { const int kb = r / 32, nb = r % 32; tr_item(F.w_out, 1024, WSP(bf16, WS_WOUT), 1024, 64 * kb, 32 * nb, 32 * nb, scr, F.lane); continue; } r -= I4;
        if (r < I5) { const int kb = r / 176, nb = r % 176; const int drow = nb < 88 ? (nb >> 2) * 256 + (nb & 3) * 32 : ((nb - 88) >> 2) * 256 + 128 + ((nb - 88) & 3) * 32;
                      tr_item(F.w_up, 2 * DFF, WSP(bf16, WS_WUP), 1024, 64 * kb, 32 * nb, drow, scr, F.lane); continue; } r -= I5;
        { const int kb = r / 32, nb = r % 32; tr_item(F.w_dn, 1024, WSP(bf16, WS_WDN), DFF, 64 * kb, 32 * nb, 32 * nb, scr, F.lane); }
    }
    __syncthreads();
    LAS float* wf = (LAS float*)(F.lds + RING_OFF);
    for (int i = F.tid; i < 8192; i += NTHR) wf[i] = F.w_in[(size_t)(i >> 3) * NIN + 1536 + (i & 7)];
    __syncthreads();
    bf16* H1 = WSP(bf16, WS_H1);
    for (int m = gw; m < MTOT; m += NGW) {
        const float* xr = m < MP ? F.xp + (size_t)m * DMODEL : F.xs + (size_t)(m - MP) * DMODEL;
        f32x4 v[4]; float s = 0.f;
#pragma unroll
        for (int j = 0; j < 4; ++j) { v[j] = ((const GAS f32x4*)xr)[F.lane + 64 * j]; s += (v[j].x * v[j].x + v[j].y * v[j].y) + (v[j].z * v[j].z + v[j].w * v[j].w); }
        const float inv = 1.0f / sqrtf(wave_sum(s) * (1.f / DMODEL) + RMS_EPS);
        float ff[8];
#pragma unroll
        for (int i = 0; i < 8; ++i) ff[i] = 0.f;
#pragma unroll
        for (int j = 0; j < 4; ++j) { const f32x4 g = ((const GAS f32x4*)F.g_pre)[F.lane + 64 * j]; v[j] = (v[j] * inv) * g;
            GAS unsigned long long* o8 = (GAS unsigned long long*)(H1 + (size_t)m * DMODEL) + F.lane + 64 * j;
            *o8 = (unsigned long long)pk2(v[j].x, v[j].y) | ((unsigned long long)pk2(v[j].z, v[j].w) << 32);
#pragma unroll
            for (int e = 0; e < 4; ++e) { const LAS f32x4* wr = (const LAS f32x4*)(wf + (size_t)(4 * (F.lane + 64 * j) + e) * 8); const f32x4 a = wr[0], b = wr[1]; const float hv = v[j][e];
                ff[0] += hv * a.x; ff[1] += hv * a.y; ff[2] += hv * a.z; ff[3] += hv * a.w; ff[4] += hv * b.x; ff[5] += hv * b.y; ff[6] += hv * b.z; ff[7] += hv * b.w; } }
#pragma unroll
        for (int i = 0; i < 8; ++i) ff[i] = wave_sum(ff[i]);
        float mine = ff[0];
#pragma unroll
        for (int i = 1; i < 8; ++i) mine = (F.lane == i) ? ff[i] : mine;
        if (F.lane < 8) { const float xv = mine + F.fbias[F.lane]; const float ls = fminf(xv, 0.f) - log1pf(__expf(-fabsf(xv)));
            float* o = m < MP ? F.out + OFF_PLF + (size_t)m * 8 : F.out + OFF_SLF + (size_t)(m - MP) * 8; o[F.lane] = ls; }
    }
    { const int gt = F.vcu * NTHR + F.tid; const int n16 = (MPAD - MTOT) * DMODEL * 2 / 16; for (int i = gt; i < n16; i += F.G * NTHR) ((GAS v4u*)(H1 + (size_t)MTOT * DMODEL))[i] = (v4u){0u, 0u, 0u, 0u}; }
    if (blockIdx.x == 0) { float* LB = WSP(float, WS_LB); for (int c = F.tid; c < 512; c += NTHR) LB[c] = sigm(F.lbl[c] - F.lbl[512 + c]); }
}

__device__ __forceinline__ void ph_cum(Frame& F) {
    const int bid = blockIdx.x; LAS double* ld = (LAS double*)(F.lds + RING_OFF);
    if (bid == 0) {
        const float* plf = F.out + OFF_PLF; float* KB = WSP(float, WS_KB); const int h = F.tid & 7, c = F.tid >> 3;
        double s = 0.0; for (int t = 256 * c; t < 256 * c + 256; ++t) s += (double)plf[(size_t)t * 8 + h];
        ld[c * 8 + h] = s; __syncthreads();
        double run = 0.0; for (int cc = 0; cc < c; ++cc) run += ld[cc * 8 + h];
        for (int t = 256 * c; t < 256 * c + 256; ++t) { run += (double)plf[(size_t)t * 8 + h]; KB[(size_t)h * MP + t] = (float)(-run * 1.4426950408889634); }
    } else if (bid <= 8) {
        const int b = bid - 1, h = F.tid & 7, c = F.tid >> 3; const float* cl = F.clf + (size_t)b * PAST * 8; float* SKB = WSP(float, WS_SKB) + (size_t)(b * 8 + h) * SKS;
        double s = 0.0; for (int j = 64 * c; j < 64 * c + 64; ++j) s += (double)cl[(size_t)j * 8 + h];
        ld[c * 8 + h] = s; __syncthreads();
        double run = 0.0; for (int cc = c + 1; cc < 64; ++cc) run += ld[cc * 8 + h];
        for (int j = 64 * c + 63; j >= 64 * c; --j) { SKB[j] = (float)(run * 1.4426950408889634); run += (double)cl[(size_t)j * 8 + h]; }
        if (c == 0) { const float* slf = F.out + OFF_SLF + (size_t)b * 16 * 8; double r2 = 0.0; for (int i = 0; i < 16; ++i) { r2 += (double)slf[i * 8 + h]; SKB[PAST + i] = (float)(-r2 * 1.4426950408889634); } }
    }
}

__device__ __forceinline__ void ph_attn(Frame& F) {
    typedef attn_body::bf16 abf;
    const abf* Q = WSP(abf, WS_Q); const abf* K = WSP(abf, WS_K); const abf* V = WSP(abf, WS_V); abf* O = WSP(abf, WS_Q); const float* KB = WSP(float, WS_KB);
    const int c = blockIdx.x; if (c >= 256) return;
    if (F.wave == 0) {
        const unsigned* qmx = (const unsigned*)(F.ctl + CW_QMX); const unsigned* kmx = (const unsigned*)(F.ctl + CW_KMX);
        for (int ui = 0; ui < 2; ++ui) { const int id = ui == 0 ? c : 511 - c, qb = id >> 3, h = id & 7; const float* kbh = KB + (size_t)h * MP;
            const float q2 = __uint_as_float(qmx[(qb * 8 + h) * 2]) + __uint_as_float(qmx[(qb * 8 + h) * 2 + 1]), k2 = __uint_as_float(kmx[h * 2]) + __uint_as_float(kmx[h * 2 + 1]);
            const float U2 = sqrtf(q2 * k2) * 1.02f, thr = kbh[256 * qb] - 30.0f - 2.0f * U2; const int nb = 4 * qb; int tfirst = nb;
            for (int r = 0; r < 4; ++r) { const int t = 64 * r + F.lane; const bool need = (t < nb) && (kbh[64 * t + 63] >= thr); const unsigned long long mk = __ballot(need);
                if (mk) { tfirst = 64 * r + (int)__ffsll((long long)mk) - 1; break; } }
            if (F.lane == 0) F.MISC[16 + ui] = (unsigned)(tfirst & ~1); }
    }
    __syncthreads();
    for (int ui = 0; ui < 2; ++ui) { const int id = ui == 0 ? c : 511 - c, qb = id >> 3, h = id & 7; const int tskip = (int)F.MISC[16 + ui];
        attn_body::attn_unit<40>(h, qb, tskip, KB + (size_t)h * MP, Q, K, V, O, (char*)F.lds); }
}
__device__ __forceinline__ void ph_attn_naive(Frame& F) {
    const bf16* Q = WSP(bf16, WS_Q); const bf16* K = WSP(bf16, WS_K); const bf16* V = WSP(bf16, WS_V); bf16* O = WSP(bf16, WS_Q); const float* KB = WSP(float, WS_KB);
    for (int unit = blockIdx.x; unit < 256; unit += F.G) {
        const int h = unit >> 5, qb = unit & 31, qi = qb * 512 + F.tid;
        float q[64], o[64];
        { const v4u* qr = (const v4u*)(Q + (size_t)qi * 512 + h * 64);
#pragma unroll
          for (int c = 0; c < 8; ++c) { const v4u w = qr[c]; q[8 * c] = bflo(w.x); q[8 * c + 1] = bfhi(w.x); q[8 * c + 2] = bflo(w.y); q[8 * c + 3] = bfhi(w.y); q[8 * c + 4] = bflo(w.z); q[8 * c + 5] = bfhi(w.z); q[8 * c + 6] = bflo(w.w); q[8 * c + 7] = bfhi(w.w); } }
#pragma unroll
        for (int d = 0; d < 64; ++d) o[d] = 0.f;
        float m = -1e30f, l = 0.f; const int kend = qb * 512 + 511;
        for (int k = 0; k <= kend; ++k) {
            const v4u* kr = (const v4u*)(K + (size_t)k * 512 + h * 64); float s = 0.f;
#pragma unroll
            for (int c = 0; c < 8; ++c) { const v4u w = kr[c]; s += q[8 * c] * bflo(w.x) + q[8 * c + 1] * bfhi(w.x) + q[8 * c + 2] * bflo(w.y) + q[8 * c + 3] * bfhi(w.y) + q[8 * c + 4] * bflo(w.z) + q[8 * c + 5] * bfhi(w.z) + q[8 * c + 6] * bflo(w.w) + q[8 * c + 7] * bfhi(w.w); }
            s += KB[(size_t)h * MP + k];
            if (k <= qi) {
                const float mn = fmaxf(m, s), a = __builtin_amdgcn_exp2f(m - mn), p = __builtin_amdgcn_exp2f(s - mn); l = l * a + p; m = mn;
                const v4u* vr = (const v4u*)(V + (size_t)k * 512 + h * 64);
#pragma unroll
                for (int c = 0; c < 8; ++c) { const v4u w = vr[c];
                    o[8 * c] = o[8 * c] * a + p * bflo(w.x); o[8 * c + 1] = o[8 * c + 1] * a + p * bfhi(w.x); o[8 * c + 2] = o[8 * c + 2] * a + p * bflo(w.y); o[8 * c + 3] = o[8 * c + 3] * a + p * bfhi(w.y);
                    o[8 * c + 4] = o[8 * c + 4] * a + p * bflo(w.z); o[8 * c + 5] = o[8 * c + 5] * a + p * bfhi(w.z); o[8 * c + 6] = o[8 * c + 6] * a + p * bflo(w.w); o[8 * c + 7] = o[8 * c + 7] * a + p * bfhi(w.w); }
            }
        }
        const float rl = 1.0f / l; v4u* orow = (v4u*)(O + (size_t)qi * 512 + h * 64);
#pragma unroll
        for (int c = 0; c < 8; ++c) { v4u w; w.x = pk2(o[8 * c] * rl, o[8 * c + 1] * rl); w.y = pk2(o[8 * c + 2] * rl, o[8 * c + 3] * rl); w.z = pk2(o[8 * c + 4] * rl, o[8 * c + 5] * rl); w.w = pk2(o[8 * c + 6] * rl, o[8 * c + 7] * rl); orow[c] = w; }
    }
}
__device__ __forceinline__ void ph_attn_sample_naive(Frame& F) {
    const bf16* Q = WSP(bf16, WS_Q); const bf16* K = WSP(bf16, WS_K); const bf16* V = WSP(bf16, WS_V); bf16* O = WSP(bf16, WS_Q);
    const int task = blockIdx.x * NWAVES + F.wave; if (task >= 64) return;
    const int b = task >> 3, h = task & 7, qi = F.lane & 15; const size_t row = (size_t)MP + b * 16 + qi; const float* SKB = WSP(float, WS_SKB) + (size_t)(b * 8 + h) * SKS;
    float q[64], o[64];
    { const v4u* qr = (const v4u*)(Q + row * 512 + h * 64);
#pragma unroll
      for (int c = 0; c < 8; ++c) { const v4u w = qr[c]; q[8 * c] = bflo(w.x); q[8 * c + 1] = bfhi(w.x); q[8 * c + 2] = bflo(w.y); q[8 * c + 3] = bfhi(w.y); q[8 * c + 4] = bflo(w.z); q[8 * c + 5] = bfhi(w.z); q[8 * c + 6] = bflo(w.w); q[8 * c + 7] = bfhi(w.w); } }
#pragma unroll
    for (int d = 0; d < 64; ++d) o[d] = 0.f;
    float m = -1e30f, l = 0.f;
    for (int k = 0; k < PAST; ++k) {
        const f32x4* kr = (const f32x4*)(F.ck + ((size_t)(b * PAST + k) * 8 + h) * 64); float s = 0.f;
#pragma unroll
        for (int c = 0; c < 16; ++c) { const f32x4 w = kr[c]; s += q[4 * c] * w.x + q[4 * c + 1] * w.y + q[4 * c + 2] * w.z + q[4 * c + 3] * w.w; }
        s += SKB[k];
        const float mn = fmaxf(m, s), a = __builtin_amdgcn_exp2f(m - mn), p = __builtin_amdgcn_exp2f(s - mn); l = l * a + p; m = mn;
        const f32x4* vr = (const f32x4*)(F.cv + ((size_t)(b * PAST + k) * 8 + h) * 64);
#pragma unroll
        for (int c = 0; c < 16; ++c) { const f32x4 w = vr[c]; o[4 * c] = o[4 * c] * a + p * w.x; o[4 * c + 1] = o[4 * c + 1] * a + p * w.y; o[4 * c + 2] = o[4 * c + 2] * a + p * w.z; o[4 * c + 3] = o[4 * c + 3] * a + p * w.w; }
    }
    for (int i = 0; i < 16; ++i) {
        const size_t kr_ = (size_t)MP + b * 16 + i; const v4u* kr = (const v4u*)(K + kr_ * 512 + h * 64); float s = 0.f;
#pragma unroll
        for (int c = 0; c < 8; ++c) { const v4u w = kr[c]; s += q[8 * c] * bflo(w.x) + q[8 * c + 1] * bfhi(w.x) + q[8 * c + 2] * bflo(w.y) + q[8 * c + 3] * bfhi(w.y) + q[8 * c + 4] * bflo(w.z) + q[8 * c + 5] * bfhi(w.z) + q[8 * c + 6] * bflo(w.w) + q[8 * c + 7] * bfhi(w.w); }
        s += SKB[PAST + i];
        if (i <= qi) {
            const float mn = fmaxf(m, s), a = __builtin_amdgcn_exp2f(m - mn), p = __builtin_amdgcn_exp2f(s - mn); l = l * a + p; m = mn;
            const v4u* vr = (const v4u*)(V + kr_ * 512 + h * 64);
#pragma unroll
            for (int c = 0; c < 8; ++c) { const v4u w = vr[c];
                o[8 * c] = o[8 * c] * a + p * bflo(w.x); o[8 * c + 1] = o[8 * c + 1] * a + p * bfhi(w.x); o[8 * c + 2] = o[8 * c + 2] * a + p * bflo(w.y); o[8 * c + 3] = o[8 * c + 3] * a + p * bfhi(w.y);
                o[8 * c + 4] = o[8 * c + 4] * a + p * bflo(w.z); o[8 * c + 5] = o[8 * c + 5] * a + p * bfhi(w.z); o[8 * c + 6] = o[8 * c + 6] * a + p * bflo(w.w); o[8 * c + 7] = o[8 * c + 7] * a + p * bfhi(w.w); }
        }
    }
    if (F.lane < 16) { const float rl = 1.0f / l; v4u* orow = (v4u*)(O + row * 512 + h * 64);
#pragma unroll
        for (int c = 0; c < 8; ++c) { v4u w; w.x = pk2(o[8 * c] * rl, o[8 * c + 1] * rl); w.y = pk2(o[8 * c + 2] * rl, o[8 * c + 3] * rl); w.z = pk2(o[8 * c + 4] * rl, o[8 * c + 5] * rl); w.w = pk2(o[8 * c + 6] * rl, o[8 * c + 7] * rl); orow[c] = w; } }
}

__device__ __forceinline__ void hgrn_chain(Frame& F, size_t row0, int T, int h, int v, float& S0, float& S1) {
    const bf16* HQ = WSP(bf16, WS_HQ); const bf16* KK = WSP(bf16, WS_KK); const bf16* HI = WSP(bf16, WS_HI); const float* LF = WSP(float, WS_LF); bf16* OH = WSP(bf16, WS_OH);
    const int d0 = F.lane, d1 = F.lane + 64;
    for (int t = 0; t < T; ++t) {
        const size_t base = (row0 + t) * 512 + h * 128;
        const float q0 = bf2f(HQ[base + d0]), q1 = bf2f(HQ[base + d1]), k0 = bf2f(KK[base + d0]), k1 = bf2f(KK[base + d1]), l0 = LF[base + d0], l1 = LF[base + d1], iv = bf2f(HI[base + v]);
        S0 = __expf(l0) * S0 + k0 * iv; S1 = __expf(l1) * S1 + k1 * iv;
        const float p = wave_sum(q0 * S0 + q1 * S1);
        if (F.lane == 0) OH[base + v] = (bf16)f2bf(p);
    }
}
__device__ __forceinline__ void ph_hgrn_naive(Frame& F) {
    const int gw = blockIdx.x * NWAVES + F.wave, NGW = F.G * NWAVES;
    if (gw < 512) { const int h = gw >> 7, v = gw & 127; float S0 = 0.f, S1 = 0.f; hgrn_chain(F, 0, MP, h, v, S0, S1);
        float* ph = F.out + OFF_PH; ph[((size_t)h * 128 + F.lane) * 128 + v] = S0; ph[((size_t)h * 128 + F.lane + 64) * 128 + v] = S1; }
    for (int task = gw; task < 4096; task += NGW) { const int bh = task >> 7, v = task & 127, b = bh >> 2, h = bh & 3;
        const float* st = F.sh + (size_t)bh * 16384; float S0 = st[(size_t)F.lane * 128 + v], S1 = st[(size_t)(F.lane + 64) * 128 + v];
        hgrn_chain(F, (size_t)MP + b * 16, 16, h, v, S0, S1);
        float* so = F.out + OFF_SH + (size_t)bh * 16384; so[(size_t)F.lane * 128 + v] = S0; so[(size_t)(F.lane + 64) * 128 + v] = S1; }
}
__device__ __forceinline__ void ph_hgnorm(Frame& F) {
    const int gw = F.vcu * NWAVES + F.wave, NGW = F.G * NWAVES; unsigned* OH = WSP(unsigned, WS_OH); const unsigned* HG = WSP(unsigned, WS_HG);
    const float g0 = F.hgn[2 * F.lane], g1 = F.hgn[2 * F.lane + 1];
    for (int task = gw; task < MTOT * 4; task += NGW) { const size_t idx = (size_t)task * 64 + F.lane; const unsigned w = OH[idx], g = HG[idx];
        const float a = bflo(w), b = bfhi(w); const float inv = 1.0f / sqrtf(wave_sum(a * a + b * b) * (1.f / 128) + RMS_EPS);
        OH[idx] = pk2(a * inv * g0 * bflo(g), b * inv * g1 * bfhi(g)); }
}
__device__ __forceinline__ void ph_merge(Frame& F) {
    const float* BRF = WSP(float, WS_BRF); const float* BRH = WSP(float, WS_BRH); bf16* MG = WSP(bf16, WS_MERGED);
    const size_t n8 = (size_t)MTOT * DMODEL / 8;
    for (size_t i = (size_t)F.vcu * NTHR + F.tid; i < n8; i += (size_t)F.G * NTHR) { const size_t m = i >> 7, c = (i & 127) * 8;
        const bf16* ga = m < MP ? (const bf16*)F.out + m * DMODEL + c : WSP(bf16, WS_GAS) + (m - MP) * DMODEL + c;
        const bf16* gb = m < MP ? (const bf16*)F.out + (size_t)MP * DMODEL + m * DMODEL + c : WSP(bf16, WS_GBS) + (m - MP) * DMODEL + c;
        const v4u a = *(const v4u*)ga, b = *(const v4u*)gb; const f32x4 f0 = *(const f32x4*)(BRF + m * DMODEL + c), f1 = *(const f32x4*)(BRF + m * DMODEL + c + 4), h0 = *(const f32x4*)(BRH + m * DMODEL + c), h1 = *(const f32x4*)(BRH + m * DMODEL + c + 4);
        v4u o; o.x = pk2(bflo(a.x) * f0.x + bflo(b.x) * h0.x, bfhi(a.x) * f0.y + bfhi(b.x) * h0.y); o.y = pk2(bflo(a.y) * f0.z + bflo(b.y) * h0.z, bfhi(a.y) * f0.w + bfhi(b.y) * h0.w);
        o.z = pk2(bflo(a.z) * f1.x + bflo(b.z) * h1.x, bfhi(a.z) * f1.y + bfhi(b.z) * h1.y); o.w = pk2(bflo(a.w) * f1.z + bflo(b.w) * h1.z, bfhi(a.w) * f1.w + bfhi(b.w) * h1.w);
        *(v4u*)(MG + m * DMODEL + c) = o; }
}
__device__ __forceinline__ void ph_norm1(Frame& F) {
    const int gw = F.vcu * NWAVES + F.wave, NGW = F.G * NWAVES; const float* MIX = WSP(float, WS_MIX); bf16* H2 = WSP(bf16, WS_H2);
    for (int m = gw; m < MTOT; m += NGW) {
        const float* xr = m < MP ? F.xp + (size_t)m * DMODEL : F.xs + (size_t)(m - MP) * DMODEL; float* yr = m < MP ? F.out + OFF_Y + (size_t)m * DMODEL : F.out + OFF_YS + (size_t)(m - MP) * DMODEL;
        f32x4 v[4]; float s = 0.f;
#pragma unroll
        for (int j = 0; j < 4; ++j) { v[j] = ((const GAS f32x4*)(MIX + (size_t)m * DMODEL))[F.lane + 64 * j]; s += (v[j].x * v[j].x + v[j].y * v[j].y) + (v[j].z * v[j].z + v[j].w * v[j].w); }
        const float inv = 1.0f / sqrtf(wave_sum(s) * (1.f / DMODEL) + RMS_EPS); float s2 = 0.f;
#pragma unroll
        for (int j = 0; j < 4; ++j) { const f32x4 g = ((const GAS f32x4*)F.g_post)[F.lane + 64 * j], x = ((const GAS f32x4*)xr)[F.lane + 64 * j]; v[j] = x + (v[j] * inv) * g;
            ((GAS f32x4*)yr)[F.lane + 64 * j] = v[j]; s2 += (v[j].x * v[j].x + v[j].y * v[j].y) + (v[j].z * v[j].z + v[j].w * v[j].w); }
        const float inv2 = 1.0f / sqrtf(wave_sum(s2) * (1.f / DMODEL) + RMS_EPS);
#pragma unroll
        for (int j = 0; j < 4; ++j) { const f32x4 g = ((const GAS f32x4*)F.g_pre2)[F.lane + 64 * j]; const f32x4 hv = (v[j] * inv2) * g;
            GAS unsigned long long* o8 = (GAS unsigned long long*)(H2 + (size_t)m * DMODEL) + F.lane + 64 * j; *o8 = (unsigned long long)pk2(hv.x, hv.y) | ((unsigned long long)pk2(hv.z, hv.w) << 32); }
    }
}
__device__ __forceinline__ float gelu_tanh(float c) { const float u = 0.7978845608028654f * (c + 0.044715f * c * c * c); const float t = 1.0f - 2.0f / (__expf(2.0f * u) + 1.0f); return 0.5f * c * (1.0f + t); }
__device__ __forceinline__ void ph_conv(Frame& F) {
    const bf16* A = WSP(bf16, WS_ABUF); bf16* G = WSP(bf16, WS_GBUF); constexpr int NG = DFF / 8; const size_t n8 = (size_t)MTOT * NG;
    for (size_t i = (size_t)F.vcu * NTHR + F.tid; i < n8; i += (size_t)F.G * NTHR) { const size_t m = i / NG; const int c = (int)(i % NG) * 8;
        float a0[8], a1[8], a2[8];
        { const v4u w = *(const v4u*)(A + m * DFF + c); a0[0] = bflo(w.x); a0[1] = bfhi(w.x); a0[2] = bflo(w.y); a0[3] = bfhi(w.y); a0[4] = bflo(w.z); a0[5] = bfhi(w.z); a0[6] = bflo(w.w); a0[7] = bfhi(w.w); }
        int t, b = 0; const bool samp = m >= MP; if (samp) { t = (int)(m - MP) & 15; b = (int)(m - MP) >> 4; } else t = (int)(m < 2 ? m : 2);
        if (t >= 1) { const v4u w = *(const v4u*)(A + (m - 1) * DFF + c); a1[0] = bflo(w.x); a1[1] = bfhi(w.x); a1[2] = bflo(w.y); a1[3] = bfhi(w.y); a1[4] = bflo(w.z); a1[5] = bfhi(w.z); a1[6] = bflo(w.w); a1[7] = bfhi(w.w); }
        else {
#pragma unroll
            for (int e = 0; e < 8; ++e) a1[e] = samp ? F.sc[((size_t)b * 2 + 1) * DFF + c + e] : 0.f; }
        if (t >= 2) { const v4u w = *(const v4u*)(A + (m - 2) * DFF + c); a2[0] = bflo(w.x); a2[1] = bfhi(w.x); a2[2] = bflo(w.y); a2[3] = bfhi(w.y); a2[4] = bflo(w.z); a2[5] = bfhi(w.z); a2[6] = bflo(w.w); a2[7] = bfhi(w.w); }
        else {
#pragma unroll
            for (int e = 0; e < 8; ++e) a2[e] = samp ? F.sc[((size_t)b * 2 + t) * DFF + c + e] : 0.f; }
        const v4u gw_ = *(const v4u*)(G + m * DFF + c); float g[8] = {bflo(gw_.x), bfhi(gw_.x), bflo(gw_.y), bfhi(gw_.y), bflo(gw_.z), bfhi(gw_.z), bflo(gw_.w), bfhi(gw_.w)}; float u[8];
#pragma unroll
        for (int e = 0; e < 8; ++e) { const float cv_ = F.cb[c + e] + F.cw[c + e] * a2[e] + F.cw[DFF + c + e] * a1[e] + F.cw[2 * DFF + c + e] * a0[e]; u[e] = gelu_tanh(cv_) * g[e]; }
        v4u o; o.x = pk2(u[0], u[1]); o.y = pk2(u[2], u[3]); o.z = pk2(u[4], u[5]); o.w = pk2(u[6], u[7]); *(v4u*)(G + m * DFF + c) = o; }
}
__device__ __forceinline__ void ph_norm2(Frame& F) {
    const int gw = F.vcu * NWAVES + F.wave, NGW = F.G * NWAVES; const float* FFN = WSP(float, WS_FFN);
    for (int m = gw; m < MTOT; m += NGW) {
        float* yr = m < MP ? F.out + OFF_Y + (size_t)m * DMODEL : F.out + OFF_YS + (size_t)(m - MP) * DMODEL;
        f32x4 v[4]; float s = 0.f;
#pragma unroll
        for (int j = 0; j < 4; ++j) { v[j] = ((const GAS f32x4*)(FFN + (size_t)m * DMODEL))[F.lane + 64 * j]; s += (v[j].x * v[j].x + v[j].y * v[j].y) + (v[j].z * v[j].z + v[j].w * v[j].w); }
        const float inv = 1.0f / sqrtf(wave_sum(s) * (1.f / DMODEL) + RMS_EPS);
#pragma unroll
        for (int j = 0; j < 4; ++j) { const f32x4 g = ((const GAS f32x4*)F.g_post2)[F.lane + 64 * j]; GAS f32x4* y4 = (GAS f32x4*)yr + F.lane + 64 * j; *y4 = *y4 + (v[j] * inv) * g; }
    }
}

struct Args { const float* in[22]; float* out; unsigned char* ws; int ph_lo, ph_hi, li, pad; };
constexpr int NPHASE = 15;
__global__ void __launch_bounds__(NTHR, 2) skel_fwd(Args args) {
    extern __shared__ __attribute__((aligned(16))) unsigned char lds[];
    Frame F;
    F.lds = (LAS unsigned char*)lds; F.MISC = (volatile LAS unsigned*)(F.lds + MISC_OFF);
    F.tid = threadIdx.x; F.lane = F.tid & 63; F.wave = __builtin_amdgcn_readfirstlane(F.tid >> 6);
    F.G = gridDim.x; { const int bx = blockIdx.x; F.vcu = (F.G % 8 == 0) ? (bx % 8) * (F.G / 8) + bx / 8 : bx; }
    F.ws = args.ws; F.out = args.out; F.ctl = (gu32*)(args.ws + WS_CTL);
    F.xp = args.in[0]; F.xs = args.in[1]; F.ck = args.in[2]; F.cv = args.in[3]; F.clf = args.in[4]; F.sh = args.in[5]; F.sc = args.in[6]; F.g_pre = args.in[7]; F.g_post = args.in[8];
    F.w_in = args.in[9]; F.fbias = args.in[10]; F.lbl = args.in[11]; F.hgn = args.in[12]; F.w_bf = args.in[13]; F.w_bh = args.in[14]; F.w_out = args.in[15]; F.g_pre2 = args.in[16]; F.g_post2 = args.in[17];
    F.w_up = args.in[18]; F.cw = args.in[19]; F.cb = args.in[20]; F.w_dn = args.in[21];
    for (int u = F.tid; u < (LDS_BYTES - LDSCTL_OFF) / 4; u += NTHR) ((LAS unsigned*)(F.lds + LDSCTL_OFF))[u] = 0u;
    __syncthreads();
    XcdBarrier bar = xcd_barrier_post((unsigned*)(F.ctl + CW_BAR), F.MISC + 8);
    const int lo = args.ph_lo, hi = args.ph_hi;
#define IN(k) (lo <= (k) && (k) < hi)
#define SEAM(k) do { if (IN(k) && IN((k) + 1)) xcd_barrier(bar); } while (0)
    typedef pg8::bf16_t pbf;
    if (IN(0)) p0_prologue(F);
    SEAM(0);
    if (IN(1)) ph_cum(F);
    SEAM(1);
    if (IN(2)) {
        pg8::Gemm g{WSP(pbf, WS_H1), WSP(pbf, WS_WIN), MPAD, NINP, DMODEL}; pg8::StaticOrder S; S.init(MPAD, NINP, F.G, (int)blockIdx.x);
        pg8::EpiIn E{WSP(pbf, WS_Q), WSP(pbf, WS_K), WSP(pbf, WS_V), WSP(pbf, WS_HQ), WSP(pbf, WS_KK), WSP(pbf, WS_HI), WSP(pbf, WS_HG), WSP(float, WS_LF),
                     (pbf*)F.out, (pbf*)F.out + (size_t)MP * DMODEL, WSP(pbf, WS_GAS), WSP(pbf, WS_GBS), F.out + OFF_PK, F.out + OFF_PV, F.out + OFF_SK, F.out + OFF_SV, WSP(float, WS_LB), (unsigned*)(F.ctl + CW_KMX)};
        pg8::gemm_phase<pg8::EpiIn, pg8::StaticOrder, true, true>(F.lds + RING_OFF, g, S, E);
    }
    SEAM(2);
    if (IN(3)) { ph_attn_sample_naive(F); __syncthreads(); ph_attn(F); }
    SEAM(3);
    if (IN(4)) ph_hgrn_naive(F);
    SEAM(4);
    if (IN(5)) ph_hgnorm(F);
    SEAM(5);
    if (IN(6)) { pg8::Gemm g{WSP(pbf, WS_Q), WSP(pbf, WS_WBF), MPAD, DMODEL, 512}; pg8::StaticOrder S; S.init(MPAD, DMODEL, F.G, (int)blockIdx.x); pg8::EpiF32 E{WSP(float, WS_BRF), DMODEL};
                 pg8::gemm_phase<pg8::EpiF32, pg8::StaticOrder, true, true>(F.lds + RING_OFF, g, S, E); }
    SEAM(6);
    if (IN(7)) { pg8::Gemm g{WSP(pbf, WS_OH), WSP(pbf, WS_WBH), MPAD, DMODEL, 512}; pg8::StaticOrder S; S.init(MPAD, DMODEL, F.G, (int)blockIdx.x); pg8::EpiF32 E{WSP(float, WS_BRH), DMODEL};
                 pg8::gemm_phase<pg8::EpiF32, pg8::StaticOrder, true, true>(F.lds + RING_OFF, g, S, E); }
    SEAM(7);
    if (IN(8)) ph_merge(F);
    SEAM(8);
    if (IN(9)) { pg8::Gemm g{WSP(pbf, WS_MERGED), WSP(pbf, WS_WOUT), MPAD, DMODEL, DMODEL}; pg8::StaticOrder S; S.init(MPAD, DMODEL, F.G, (int)blockIdx.x); pg8::EpiF32 E{WSP(float, WS_MIX), DMODEL};
                 pg8::gemm_phase<pg8::EpiF32, pg8::StaticOrder, true, true>(F.lds + RING_OFF, g, S, E); }
    SEAM(9);
    if (IN(10)) ph_norm1(F);
    SEAM(10);
    if (IN(11)) { pg8::Gemm g{WSP(pbf, WS_H2), WSP(pbf, WS_WUP), MPAD, 2 * DFF, DMODEL}; pg8::StaticOrder S; S.init(MPAD, 2 * DFF, F.G, (int)blockIdx.x);
                  pg8::EpiUpSplit E{WSP(pbf, WS_ABUF), WSP(pbf, WS_GBUF), F.out + OFF_PC, F.out + OFF_SC};
                  pg8::gemm_phase<pg8::EpiUpSplit, pg8::StaticOrder, true, true>(F.lds + RING_OFF, g, S, E); }
    SEAM(11);
    if (IN(12)) ph_conv(F);
    SEAM(12);
    if (IN(13)) { pg8::Gemm g{WSP(pbf, WS_GBUF), WSP(pbf, WS_WDN), MPAD, DMODEL, DFF}; pg8::StaticOrder S; S.init(MPAD, DMODEL, F.G, (int)blockIdx.x); pg8::EpiF32 E{WSP(float, WS_FFN), DMODEL};
                  pg8::gemm_phase<pg8::EpiF32, pg8::StaticOrder, true, true>(F.lds + RING_OFF, g, S, E); }
    SEAM(13);
    if (IN(14)) ph_norm2(F);
#undef IN
}

extern "C" void kernel_launch(void* const* d_in, const int* in_sizes, int n_in, void* d_out, int out_size, void* d_ws, size_t ws_size, hipStream_t stream) {
    static int grid = 0;
    if (grid == 0) {
        if (n_in != 22 || out_size != (int)OUT_TOTAL || ws_size < WS_END) { fprintf(stderr, "kernel_launch: unexpected shapes (n_in %d out %d ws %zu)\n", n_in, out_size, ws_size); grid = -1; return; }
        if (hipFuncSetAttribute((const void*)skel_fwd, hipFuncAttributeMaxDynamicSharedMemorySize, LDS_BYTES) != hipSuccess) { fprintf(stderr, "kernel_launch: hipFuncSetAttribute failed\n"); grid = -1; return; }
        grid = 256;
    }
    if (grid < 0) return;
    (void)hipMemsetAsync((char*)d_ws + WS_CTL, 0, CTL_ZERO_BYTES, stream);
    Args a{};
    for (int i = 0; i < 22; ++i) a.in[i] = (const float*)d_in[i];
    a.out = (float*)d_out; a.ws = (unsigned char*)d_ws;
    a.ph_lo = 0; a.ph_hi = NPHASE; a.li = 0; hipLaunchKernelGGL(skel_fwd, dim3(grid), dim3(NTHR), LDS_BYTES, stream, a);
}
```

```cpp
#include <hip/hip_runtime.h>
#include <cstdio>
#include <cstdint>
namespace pg8 {
#define PG8_LAS __attribute__((address_space(3)))
typedef unsigned short bf16_t;
typedef short bf16x8 __attribute__((ext_vector_type(8)));
typedef float f32x4 __attribute__((ext_vector_type(4)));
typedef unsigned u32x4 __attribute__((ext_vector_type(4)));
constexpr int BM = 256, BK = 64, HALF = 128, HTB = HALF * BK * 2  , STAGE_BYTES = 8 * HTB, NXCD = 8, WGM = 8;

__host__ __device__ __forceinline__ int lds_byte(int r, int c) { const int st = (r >> 4) * 2 + (c >> 5), rr = r & 15, cc = c & 31, ob = rr * 64 + cc * 2; return st * 1024 + (ob ^ (((ob >> 9) & 1) << 5)); }
__host__ __device__ __forceinline__ void stage_rc(int b, int& R, int& C) { const int st = b / 1024, sb = b % 1024, swz = sb ^ (((sb >> 9) & 1) << 5); R = (st >> 1) * 16 + swz / 64; C = (st & 1) * 32 + (swz % 64) / 2; }
__host__ __device__ __forceinline__ int perm32(int rho) { const int n = rho >> 4, i = rho & 15; return 8 * (i >> 2) + 4 * n + (i & 3); }

struct Unit { int pm, pn; };
struct Gemm { const bf16_t* A; const bf16_t* Bt; int M, N, K; };

struct StaticOrder {
    int nM, nN, nwg, G, c;
    __host__ __device__ void init(int M, int N, int G_, int c_) { nM = M / BM; nN = N / BM; nwg = nM * nN; G = G_; c = c_; }
    __host__ __device__ bool next(int i, Unit& u) const {
        const long L = (long)i * G + c; if (L >= nwg) return false;
        int wgid = (int)L; { const int q = nwg / NXCD, r = nwg % NXCD, xcd = wgid % NXCD, off = wgid / NXCD; wgid = (xcd < r ? xcd * (q + 1) : r * (q + 1) + (xcd - r) * q) + off; }
        const int nig = WGM * nN, gid = wgid / nig, fm = gid * WGM, gsz = (nM - fm) < WGM ? (nM - fm) : WGM;
        u.pm = fm + ((wgid % nig) % gsz); u.pn = (wgid % nig) / gsz; return true;
    }
    __device__ __forceinline__ void a_ready(const Unit&) const {}
    __device__ __forceinline__ void done(const Unit&) const {}
};

__device__ __forceinline__ unsigned cvt_pk_bf16(float lo, float hi) { unsigned r; asm volatile("v_cvt_pk_bf16_f32 %0, %1, %2" : "=v"(r) : "v"(lo), "v"(hi)); return r; }
typedef float f32x2 __attribute__((ext_vector_type(2)));
__device__ __forceinline__ f32x2 gelu_pk(f32x2 v) {
    const f32x2 av = __builtin_elementwise_abs(v), d = av * 0.2316418882f + 1.0f;
    f32x2 t; t.x = __builtin_amdgcn_rcpf(d.x); t.y = __builtin_amdgcn_rcpf(d.y);
    f32x2 q = t * 0.5307027145f + (-0.7265760135f); q = q * t + 0.7107068705f; q = q * t + (-0.142248368f); q = q * t + 0.127414796f; q = q * t;
    const f32x2 s = (v * v) * (-0.72134752044f);
    f32x2 e; e.x = __builtin_amdgcn_exp2f(s.x); e.y = __builtin_amdgcn_exp2f(s.y);
    const f32x2 m = v * (q * e), r = v - m;
    f32x2 o; o.x = v.x < 0.f ? m.x : r.x; o.y = v.y < 0.f ? m.y : r.y; return o;
}

template <int ACT  > struct EpiBf16 {
    static constexpr bool PERM = true, AFTER_DRAIN = false; static_assert(ACT == 0 || ACT == 1, "EpiBf16: ACT is 0 (none) or 1 (gelu_pk)");
    bf16_t* O; int ldc; const float* bias; int split_cols; size_t split_stride; float scale0;
    __device__ __forceinline__ void operator()(const f32x4 (&acc)[2][2][4][2], const Unit& u, int wr, int wc, int fr, int fq) const {
        const int row0 = u.pm * BM + wr * 64 + fr; int colt = u.pn * BM; bf16_t* base = O;
        float sc = 1.f; if (split_cols) { const int t = colt / split_cols; base += (size_t)t * split_stride; colt -= t * split_cols; if (t == 0) sc = scale0; }
        const int col0 = colt + wc * 32 + 8 * fq, bcol0 = u.pn * BM + wc * 32 + 8 * fq;
        f32x4 bv[2][2];
#pragma unroll
        for (int bj = 0; bj < 2; ++bj)
#pragma unroll
            for (int n = 0; n < 2; ++n) bv[bj][n] = bias ? *(const f32x4*)(bias + bcol0 + bj * HALF + 4 * n) : (f32x4){0.f, 0.f, 0.f, 0.f};
#pragma unroll
        for (int ai = 0; ai < 2; ++ai)
#pragma unroll
            for (int m = 0; m < 4; ++m) { bf16_t* rowp = base + (size_t)(row0 + ai * HALF + m * 16) * ldc + col0;
#pragma unroll
                for (int bj = 0; bj < 2; ++bj) { f32x4 v0 = acc[ai][bj][m][0] + bv[bj][0], v1 = acc[ai][bj][m][1] + bv[bj][1];
                    if (ACT == 1) { f32x2 a = gelu_pk((f32x2){v0[0], v0[1]}), b = gelu_pk((f32x2){v0[2], v0[3]}), c = gelu_pk((f32x2){v1[0], v1[1]}), d = gelu_pk((f32x2){v1[2], v1[3]});
                        v0 = (f32x4){a.x, a.y, b.x, b.y}; v1 = (f32x4){c.x, c.y, d.x, d.y}; }
                    v0 = v0 * sc; v1 = v1 * sc; u32x4 w; w.x = cvt_pk_bf16(v0[0], v0[1]); w.y = cvt_pk_bf16(v0[2], v0[3]); w.z = cvt_pk_bf16(v1[0], v1[1]); w.w = cvt_pk_bf16(v1[2], v1[3]);
                    *(u32x4*)(rowp + bj * HALF) = w; } }
    }
};

struct PanelStats {
    unsigned* xbuf;
    unsigned* cnt;
    unsigned* tmo;
    int ntn; float eps;
    unsigned code;
    __device__ __forceinline__ bool run(const f32x4 (&v)[2][2][4][2], const Unit& u, int wr, int wc, int fr, int fq, PG8_LAS unsigned char* lds, int wid, int lane) const {
        typedef float f32x2v __attribute__((ext_vector_type(2)));
        PG8_LAS f32x2v* P = (PG8_LAS f32x2v*)lds;
        PG8_LAS f32x2v* S = (PG8_LAS f32x2v*)(lds + 8192);
        PG8_LAS unsigned* flag = (PG8_LAS unsigned*)(lds + 8192 + 2048);
#pragma unroll
        for (int ai = 0; ai < 2; ++ai)
#pragma unroll
            for (int m = 0; m < 4; ++m) {
                float s = 0.f;
#pragma unroll
                for (int bj = 0; bj < 2; ++bj)
#pragma unroll
                    for (int n = 0; n < 2; ++n) { const f32x4 x = v[ai][bj][m][n]; s += (x[0] + x[1]) + (x[2] + x[3]); }
                s += __shfl_xor(s, 16); s += __shfl_xor(s, 32);
                const float mw = s * (1.0f / 64.0f); float q = 0.f;
#pragma unroll
                for (int bj = 0; bj < 2; ++bj)
#pragma unroll
                    for (int n = 0; n < 2; ++n) { const f32x4 d = v[ai][bj][m][n] - mw; q += (d[0] * d[0] + d[1] * d[1]) + (d[2] * d[2] + d[3] * d[3]); }
                q += __shfl_xor(q, 16); q += __shfl_xor(q, 32);
                if (fq == 0) P[(ai * HALF + wr * 64 + m * 16 + fr) * 4 + wc] = (f32x2v){mw, q};
            }
        asm volatile("s_waitcnt lgkmcnt(0)" ::: "memory"); __builtin_amdgcn_s_barrier(); asm volatile("" ::: "memory");
#if defined(BROKEN_EXCHANGE_NO_WAIT)
#warning BROKEN CONTROL BUILD: the row-statistics exchange does not wait; results are wrong by design
        if (blockIdx.x >= 64) { const long long t0_ = clock64(); while (clock64() - t0_ < 60000) __builtin_amdgcn_s_sleep(8); }
#endif
        const int row = wid * 32 + (lane & 31);
        if (lane < 32) {
            const f32x2v a = P[row * 4 + 0], b = P[row * 4 + 1], c = P[row * 4 + 2], d = P[row * 4 + 3];
            const float mt = (a.x + b.x + c.x + d.x) * 0.25f;
            const float da = a.x - mt, db = b.x - mt, dc = c.x - mt, dd = d.x - mt;
            const float m2 = (a.y + b.y) + (c.y + d.y) + 64.0f * ((da * da + db * db) + (dc * dc + dd * dd));
            unsigned long long* slot = (unsigned long long*)xbuf + ((size_t)(u.pm * BM + row) * 4 + u.pn);
            __hip_atomic_store(slot, ((unsigned long long)__float_as_uint(m2) << 32) | __float_as_uint(mt), __ATOMIC_RELAXED, __HIP_MEMORY_SCOPE_AGENT);
        }
        asm volatile("s_waitcnt vmcnt(0)" ::: "memory");
        if (lane == 0) __hip_atomic_fetch_add(cnt + 64 * u.pm, 1u, __ATOMIC_RELAXED, __HIP_MEMORY_SCOPE_AGENT);
        if (wid == 0) {
            bool dead = false; const unsigned long long t0 = __builtin_amdgcn_s_memrealtime(); const unsigned want = 8u * (unsigned)ntn;
            for (;;) {
#if defined(BROKEN_EXCHANGE_NO_WAIT)
                break;
#endif
                if ((unsigned)__builtin_amdgcn_readfirstlane(__hip_atomic_load(cnt + 64 * u.pm, __ATOMIC_RELAXED, __HIP_MEMORY_SCOPE_AGENT)) >= want) break;
                if (__builtin_amdgcn_s_memrealtime() - t0 > 2000000ull) {
                    if (lane == 0) { unsigned expect = 0u; __hip_atomic_compare_exchange_strong(tmo + 1, &expect, code | (unsigned)(u.pm & 0xff), __ATOMIC_RELAXED, __ATOMIC_RELAXED, __HIP_MEMORY_SCOPE_AGENT);
                                     __hip_atomic_store(tmo, 1u, __ATOMIC_RELAXED, __HIP_MEMORY_SCOPE_AGENT); }
                    dead = true; break; }
                __builtin_amdgcn_s_sleep(2);
            }
            __builtin_amdgcn_fence(__ATOMIC_ACQUIRE, "agent");
            if (lane == 0) flag[0] = dead ? 1u : 0u;
        }
        asm volatile("s_waitcnt vmcnt(0) lgkmcnt(0)" ::: "memory"); __builtin_amdgcn_s_barrier(); asm volatile("" ::: "memory");
        const bool bad = flag[0] != 0u;
        if (lane < 32) {
            const unsigned long long* slot = (const unsigned long long*)xbuf + (size_t)(u.pm * BM + row) * 4; float mt[4], m2[4]; float ms = 0.f;
#pragma unroll
            for (int t = 0; t < 4; ++t) { if (t < ntn) { const unsigned long long w = __hip_atomic_load(slot + t, __ATOMIC_RELAXED, __HIP_MEMORY_SCOPE_AGENT); mt[t] = __uint_as_float((unsigned)w); m2[t] = __uint_as_float((unsigned)(w >> 32)); } else { mt[t] = 0.f; m2[t] = 0.f; } ms += mt[t]; }
            const float mean = ms / (float)ntn; float q = 0.f;
#pragma unroll
            for (int t = 0; t < 4; ++t) if (t < ntn) { const float dm = mt[t] - mean; q += m2[t] + 256.0f * dm * dm; }
            S[row] = (f32x2v){mean, 1.0f / sqrtf(q / (256.0f * (float)ntn) + eps)};
        }
        asm volatile("s_waitcnt lgkmcnt(0)" ::: "memory"); __builtin_amdgcn_s_barrier(); asm volatile("" ::: "memory");
        return bad;
    }
};
struct EpiLnRes {
    static constexpr bool PERM = false, AFTER_DRAIN = true;
    const float* base; float* out; int ldc; const float* bias; PanelStats st; unsigned poison;
    __device__ __forceinline__ void fused(f32x4 (&acc)[2][2][4][2], const Unit& u, int wr, int wc, int fr, int fq, PG8_LAS unsigned char* lds, int wid, int lane) const {
        typedef float f32x2v __attribute__((ext_vector_type(2)));
        const PG8_LAS f32x2v* S = (const PG8_LAS f32x2v*)(lds + 8192);
        const int col0 = u.pn * BM + wc * 32 + 4 * fq;
#pragma unroll
        for (int bj = 0; bj < 2; ++bj)
#pragma unroll
            for (int n = 0; n < 2; ++n) { const f32x4 bv = bias ? *(const f32x4*)(bias + col0 + bj * HALF + n * 16) : (f32x4){0.f, 0.f, 0.f, 0.f};
#pragma unroll
                for (int ai = 0; ai < 2; ++ai)
#pragma unroll
                    for (int m = 0; m < 4; ++m) acc[ai][bj][m][n] += bv; }
        f32x4 pre[4][2][2];
#pragma unroll
        for (int m = 0; m < 4; ++m) { const size_t off = (size_t)(u.pm * BM + wr * 64 + m * 16 + fr) * ldc + col0;
#pragma unroll
            for (int bj = 0; bj < 2; ++bj)
#pragma unroll
                for (int n = 0; n < 2; ++n) pre[m][bj][n] = *(const f32x4*)(base + off + bj * HALF + n * 16); }
        const bool bad = st.run(acc, u, wr, wc, fr, fq, lds, wid, lane) || poison != 0u;
        const float qnan = __builtin_nanf("");
#pragma unroll
        for (int ai = 0; ai < 2; ++ai)
#pragma unroll
            for (int m = 0; m < 4; ++m) { const int r = ai * HALF + wr * 64 + m * 16 + fr; const f32x2v sr = S[r]; const size_t off = (size_t)(u.pm * BM + r) * ldc + col0;
#pragma unroll
                for (int bj = 0; bj < 2; ++bj)
#pragma unroll
                    for (int n = 0; n < 2; ++n) { const f32x4 bs = ai == 0 ? pre[m][bj][n] : *(const f32x4*)(base + off + bj * HALF + n * 16); f32x4 o = bs + (acc[ai][bj][m][n] - sr.x) * sr.y;
                        if (bad) o = (f32x4){qnan, qnan, qnan, qnan}; *(f32x4*)(out + off + bj * HALF + n * 16) = o; }
                if (m & 1) asm volatile("" ::: "memory"); }
    }
};
struct EpiLnResLn {
    static constexpr bool PERM = false, AFTER_DRAIN = true;
    const float* base; float* out; bf16_t* xn; int ldc; const float* bias; PanelStats st1, st2; unsigned poison;
    __device__ __forceinline__ void fused(f32x4 (&acc)[2][2][4][2], const Unit& u, int wr, int wc, int fr, int fq, PG8_LAS unsigned char* lds, int wid, int lane) const {
        typedef float f32x2v __attribute__((ext_vector_type(2))); typedef unsigned u32x2v __attribute__((ext_vector_type(2)));
        const PG8_LAS f32x2v* S = (const PG8_LAS f32x2v*)(lds + 8192);
        const int col0 = u.pn * BM + wc * 32 + 4 * fq;
#pragma unroll
        for (int bj = 0; bj < 2; ++bj)
#pragma unroll
            for (int n = 0; n < 2; ++n) { const f32x4 bv = bias ? *(const f32x4*)(bias + col0 + bj * HALF + n * 16) : (f32x4){0.f, 0.f, 0.f, 0.f};
#pragma unroll
                for (int ai = 0; ai < 2; ++ai)
#pragma unroll
                    for (int m = 0; m < 4; ++m) acc[ai][bj][m][n] += bv; }
        bool bad = st1.run(acc, u, wr, wc, fr, fq, lds, wid, lane) || poison != 0u;
        const float qnan = __builtin_nanf("");
#pragma unroll
        for (int ai = 0; ai < 2; ++ai)
#pragma unroll
            for (int m = 0; m < 4; ++m) { const int r = ai * HALF + wr * 64 + m * 16 + fr; const f32x2v sr = S[r]; const size_t off = (size_t)(u.pm * BM + r) * ldc + col0;
#pragma unroll
                for (int bj = 0; bj < 2; ++bj)
#pragma unroll
                    for (int n = 0; n < 2; ++n) { const f32x4 bs = *(const f32x4*)(base + off + bj * HALF + n * 16); acc[ai][bj][m][n] = bs + (acc[ai][bj][m][n] - sr.x) * sr.y; }
                asm volatile("" : "+v"(acc[ai][0][m][0]), "+v"(acc[ai][0][m][1]), "+v"(acc[ai][1][m][0]), "+v"(acc[ai][1][m][1]));
                if (m & 1) asm volatile("" ::: "memory"); }
        const bool bad1 = bad;
        bad = st2.run(acc, u, wr, wc, fr, fq, lds, wid, lane) || bad;
#pragma unroll
        for (int ai = 0; ai < 2; ++ai)
#pragma unroll
            for (int m = 0; m < 4; ++m) { const int r = ai * HALF + wr * 64 + m * 16 + fr; const f32x2v sr = S[r]; const size_t off = (size_t)(u.pm * BM + r) * ldc + col0;
#pragma unroll
                for (int bj = 0; bj < 2; ++bj)
#pragma unroll
                    for (int n = 0; n < 2; ++n) { const f32x4 x1 = acc[ai][bj][m][n]; *(f32x4*)(out + off + bj * HALF + n * 16) = bad1 ? (f32x4){qnan, qnan, qnan, qnan} : x1;
                        const f32x4 o = (x1 - sr.x) * sr.y; u32x2v w; w.x = cvt_pk_bf16(o[0], o[1]); w.y = cvt_pk_bf16(o[2], o[3]);
                        if (bad) { w.x = 0x7fc07fc0u; w.y = 0x7fc07fc0u; } *(u32x2v*)(xn + off + bj * HALF + n * 16) = w; }
                asm volatile("" ::: "memory"); }
    }
};

template <class Epi, class Sched, bool ALIGN_EPI = false, bool SP2 = false>
__device__ __forceinline__ void gemm_phase(PG8_LAS unsigned char* lds, const Gemm g, const Sched& S, const Epi& E) {
    const int tid = threadIdx.x, wid = __builtin_amdgcn_readfirstlane(tid >> 6), lane = tid & 63, wr = wid >> 2, wc = wid & 3, fr = lane & 15, fq = lane >> 4;
    const int K = g.K, nt = K / BK;
    unsigned voffA[2], voffB[2];
#pragma unroll
    for (int i = 0; i < 2; ++i) { int R, C; stage_rc(tid * 16 + i * 8192, R, C); const int Rb = Epi::PERM ? ((R & ~31) + perm32(R & 31)) : R;
        voffA[i] = (unsigned)(R * K + C) * 2u; voffB[i] = (unsigned)(Rb * K + C) * 2u; }
    const size_t kstep = (size_t)(BK * 2);
    const size_t hstep = (size_t)HALF * K * 2;
    const size_t tstep = 2 * hstep;
    const unsigned ldsw = (unsigned)wid * 1024u;
    const int aoff = lds_byte(wr * 64 + fr, fq * 8), boff = lds_byte(wc * 32 + fr, fq * 8);
#define PG8_SA(b, h) (((b) * 2 + (h)) * HTB)
#define PG8_SB(b, h) ((4 + (b) * 2 + (h)) * HTB)
#define PG8_STAGE(bufoff, gbase, voff) do { _Pragma("unroll") for (int _i = 0; _i < 2; ++_i) \
        __builtin_amdgcn_global_load_lds((const unsigned*)((const char*)(gbase) + (voff)[_i]), (PG8_LAS unsigned*)(lds + (bufoff) + ldsw + _i * 8192), 16, 0, 0); } while (0)
#define PG8_LDA(dst, b, h) do { _Pragma("unroll") for (int m = 0; m < 4; ++m) _Pragma("unroll") for (int k = 0; k < 2; ++k) dst[m][k] = *(const PG8_LAS bf16x8*)(lds + PG8_SA(b, h) + aoff + m * 2048 + k * 1024); } while (0)
#define PG8_LDB(dst, b, h) do { _Pragma("unroll") for (int n = 0; n < 2; ++n) _Pragma("unroll") for (int k = 0; k < 2; ++k) dst[n][k] = *(const PG8_LAS bf16x8*)(lds + PG8_SB(b, h) + boff + n * 2048 + k * 1024); } while (0)
#define PG8_MMA(ai, bj, At, Bt) do { __builtin_amdgcn_s_setprio(1); _Pragma("unroll") for (int m = 0; m < 4; ++m) _Pragma("unroll") for (int n = 0; n < 2; ++n) _Pragma("unroll") for (int k = 0; k < 2; ++k) \
        acc[ai][bj][m][n] = __builtin_amdgcn_mfma_f32_16x16x32_bf16(Bt[n][k], At[m][k], acc[ai][bj][m][n], 0, 0, 0); __builtin_amdgcn_s_setprio(0); } while (0)
#define PG8_WAIT_V(n) asm volatile("s_waitcnt vmcnt(" #n ")" ::: "memory")
#define PG8_WAIT_L(n) asm volatile("s_waitcnt lgkmcnt(" #n ")" ::: "memory")
#define PG8_BAR __builtin_amdgcn_s_barrier()
#define PG8_SCHED __builtin_amdgcn_sched_barrier(0)
    Unit cur, nxt; int ui = 0;
    if (!S.next(0, cur)) return;
    f32x4 acc[2][2][4][2];
#pragma unroll
    for (int a = 0; a < 2; ++a)
#pragma unroll
        for (int b = 0; b < 2; ++b)
#pragma unroll
            for (int m = 0; m < 4; ++m)
#pragma unroll
                for (int n = 0; n < 2; ++n) acc[a][b][m][n] = (f32x4){0.f, 0.f, 0.f, 0.f};
    bf16x8 At[4][2], B0[2][2], B1[2][2];
    const char* cA = (const char*)g.A + (size_t)cur.pm * tstep; const char* cB = (const char*)g.Bt + (size_t)cur.pn * tstep;
    S.a_ready(cur);
    if constexpr (SP2) {
        PG8_STAGE(PG8_SB(0, 0), cB, voffB); PG8_STAGE(PG8_SB(0, 1), cB + hstep, voffB); PG8_STAGE(PG8_SA(0, 0), cA, voffA); PG8_STAGE(PG8_SA(0, 1), cA + hstep, voffA);
        if (wr == 1) PG8_BAR;
        PG8_WAIT_V(2); PG8_BAR;
        PG8_STAGE(PG8_SB(1, 0), cB + kstep, voffB); PG8_STAGE(PG8_SA(1, 0), cA + kstep, voffA); PG8_STAGE(PG8_SB(1, 1), cB + hstep + kstep, voffB);
        PG8_WAIT_V(6); PG8_BAR;
    } else {
        PG8_STAGE(PG8_SB(0, 0), cB, voffB); PG8_STAGE(PG8_SA(0, 0), cA, voffA); PG8_STAGE(PG8_SB(0, 1), cB + hstep, voffB); PG8_STAGE(PG8_SA(0, 1), cA + hstep, voffA);
        if (wr == 1) PG8_BAR;
        PG8_WAIT_V(4); PG8_BAR;
        PG8_STAGE(PG8_SB(1, 0), cB + kstep, voffB); PG8_STAGE(PG8_SA(1, 0), cA + kstep, voffA); PG8_STAGE(PG8_SB(1, 1), cB + hstep + kstep, voffB);
        PG8_WAIT_V(6); PG8_BAR;
    }
    for (;;) {
        const bool has_next = S.next(ui + 1, nxt);
        const char* nA = has_next ? (const char*)g.A + (size_t)nxt.pm * tstep : cA; const char* nB = has_next ? (const char*)g.Bt + (size_t)nxt.pn * tstep : cB;
        for (int t = 0; t < nt; t += 2) {
            const bool last = (t == nt - 2);
            const char* a1 = cA + (size_t)(t + 1) * kstep;
            const char* a2 = last ? nA : cA + (size_t)(t + 2) * kstep; const char* b2 = last ? nB : cB + (size_t)(t + 2) * kstep;
            const char* a3 = a2 + kstep; const char* b3 = b2 + kstep;
            if (last && has_next) S.a_ready(nxt);
            if constexpr (SP2) {
            PG8_LDB(B0, 0, 0); PG8_LDB(B1, 0, 1); PG8_SCHED; PG8_LDA(At, 0, 0); PG8_STAGE(PG8_SA(1, 1), a1 + hstep, voffA);
            PG8_WAIT_V(8); PG8_WAIT_L(0); PG8_BAR; PG8_MMA(0, 0, At, B0); PG8_MMA(0, 1, At, B1); PG8_BAR; PG8_SCHED;
            PG8_LDA(At, 0, 1); PG8_STAGE(PG8_SB(0, 0), b2, voffB); PG8_STAGE(PG8_SB(0, 1), b2 + hstep, voffB); PG8_STAGE(PG8_SA(0, 0), a2, voffA);
            PG8_WAIT_V(8); PG8_WAIT_L(0); PG8_BAR; PG8_MMA(1, 0, At, B0); PG8_MMA(1, 1, At, B1); PG8_BAR; PG8_SCHED;
            PG8_LDB(B0, 1, 0); PG8_LDB(B1, 1, 1); PG8_SCHED; PG8_LDA(At, 1, 0); PG8_STAGE(PG8_SA(0, 1), a2 + hstep, voffA);
            PG8_WAIT_V(8); PG8_WAIT_L(0); PG8_BAR; PG8_MMA(0, 0, At, B0); PG8_MMA(0, 1, At, B1); PG8_BAR; PG8_SCHED;
            PG8_LDA(At, 1, 1); PG8_STAGE(PG8_SB(1, 0), b3, voffB); PG8_STAGE(PG8_SB(1, 1), b3 + hstep, voffB); PG8_STAGE(PG8_SA(1, 0), a3, voffA);
            PG8_WAIT_V(8); PG8_WAIT_L(0); PG8_BAR; PG8_MMA(1, 0, At, B0); PG8_MMA(1, 1, At, B1); PG8_BAR; PG8_SCHED;
            } else {
            PG8_LDB(B0, 0, 0); PG8_SCHED; PG8_LDA(At, 0, 0); PG8_STAGE(PG8_SA(1, 1), a1 + hstep, voffA);
            PG8_WAIT_L(8); PG8_BAR; PG8_WAIT_L(0); PG8_MMA(0, 0, At, B0); PG8_BAR; PG8_SCHED;
            PG8_LDB(B1, 0, 1); PG8_STAGE(PG8_SB(0, 0), b2, voffB);
            PG8_BAR; PG8_WAIT_L(0); PG8_MMA(0, 1, At, B1); PG8_BAR;
            PG8_LDA(At, 0, 1); PG8_STAGE(PG8_SA(0, 0), a2, voffA);
            PG8_BAR; PG8_WAIT_L(0); PG8_MMA(1, 0, At, B0); PG8_BAR; PG8_SCHED;
            PG8_STAGE(PG8_SB(0, 1), b2 + hstep, voffB);
            PG8_WAIT_V(6); PG8_BAR; PG8_MMA(1, 1, At, B1); PG8_BAR;
            PG8_LDB(B0, 1, 0); PG8_SCHED; PG8_LDA(At, 1, 0); PG8_STAGE(PG8_SA(0, 1), a2 + hstep, voffA);
            PG8_WAIT_L(8); PG8_BAR; PG8_WAIT_L(0); PG8_MMA(0, 0, At, B0); PG8_BAR; PG8_SCHED;
            PG8_LDB(B1, 1, 1); PG8_STAGE(PG8_SB(1, 0), b3, voffB);
            PG8_BAR; PG8_WAIT_L(0); PG8_MMA(0, 1, At, B1); PG8_BAR;
            PG8_LDA(At, 1, 1); PG8_STAGE(PG8_SA(1, 0), a3, voffA);
            PG8_BAR; PG8_WAIT_L(0); PG8_MMA(1, 0, At, B0); PG8_BAR; PG8_SCHED;
            PG8_STAGE(PG8_SB(1, 1), b3 + hstep, voffB);
            PG8_WAIT_V(6); PG8_BAR; PG8_MMA(1, 1, At, B1); PG8_BAR;
            }
        }
        if constexpr (ALIGN_EPI) { if (wr == 0) PG8_BAR; }
        if constexpr (!Epi::AFTER_DRAIN) { E(acc, cur, wr, wc, fr, fq); S.done(cur); }
        if (!has_next) break;
#pragma unroll
        for (int a = 0; a < 2; ++a)
#pragma unroll
            for (int b = 0; b < 2; ++b)
#pragma unroll
                for (int m = 0; m < 4; ++m)
#pragma unroll
                    for (int n = 0; n < 2; ++n) acc[a][b][m][n] = (f32x4){0.f, 0.f, 0.f, 0.f};
        cur = nxt; cA = nA; cB = nB; ++ui;
        if constexpr (ALIGN_EPI) { if (wr == 1) PG8_BAR; }
    }
    PG8_WAIT_V(0);
    if constexpr (!ALIGN_EPI) { if (wr == 0) PG8_BAR; }
    PG8_BAR;
    if constexpr (Epi::AFTER_DRAIN) { E.fused(acc, cur, wr, wc, fr, fq, lds, wid, lane); S.done(cur); }
#undef PG8_SA
#undef PG8_SB
#undef PG8_STAGE
#undef PG8_LDA
#undef PG8_LDB
#undef PG8_MMA
#undef PG8_WAIT_V
#undef PG8_WAIT_L
#undef PG8_BAR
#undef PG8_SCHED
}
}

namespace pg8 {
__device__ __forceinline__ float sigm(float x) { return 1.0f / (1.0f + __expf(-x)); }
typedef __bf16 bf16x2_v __attribute__((ext_vector_type(2)));
__device__ __forceinline__ unsigned cvtpk_v(float lo, float hi) { const f32x2 v = {lo, hi}; return __builtin_bit_cast(unsigned, __builtin_convertvector(v, bf16x2_v)); }
__device__ __forceinline__ u32x4 pack8(const f32x4 a, const f32x4 b) { u32x4 w; w.x = cvtpk_v(a[0], a[1]); w.y = cvtpk_v(a[2], a[3]); w.z = cvtpk_v(b[0], b[1]); w.w = cvtpk_v(b[2], b[3]); return w; }

struct EpiF32 {
    static constexpr bool PERM = false, AFTER_DRAIN = false;
    float* C; int ldc;
    __device__ __forceinline__ void operator()(const f32x4 (&acc)[2][2][4][2], const Unit& u, int wr, int wc, int fr, int fq) const {
        const int row0 = u.pm * BM + wr * 64 + fr, col0 = u.pn * BM + wc * 32 + 4 * fq;
#pragma unroll
        for (int ai = 0; ai < 2; ++ai)
#pragma unroll
            for (int m = 0; m < 4; ++m) { float* rowp = C + (size_t)(row0 + ai * HALF + m * 16) * ldc + col0;
#pragma unroll
                for (int bj = 0; bj < 2; ++bj)
#pragma unroll
                    for (int n = 0; n < 2; ++n) *(f32x4*)(rowp + bj * HALF + n * 16) = acc[ai][bj][m][n]; }
    }
};

constexpr int MPROMPT = 16384; constexpr float QSCALE = 0.125f * 1.4426950408889634f;
struct EpiIn {
    static constexpr bool PERM = true, AFTER_DRAIN = false;
    bf16_t *Q, *K, *V, *HQ, *KK, *HI, *HG; float* LF; bf16_t *GA, *GB, *GAs, *GBs; float *okp, *ovp, *oks, *ovs; const float* lb; unsigned* mx;
    template <int TYPE> __device__ __forceinline__ void tile(const f32x4 (&acc)[2][2][4][2], const Unit& u, int ct, int wr, int wc, int fr, int fq) const {
        const bool samp = (u.pm == MPROMPT / BM);
        const int colb = ct * BM + wc * 32 + 8 * fq;
        float mxs[2] = {0.f, 0.f};
        f32x4 lbv[2][2];
        if (TYPE == 4) {
#pragma unroll
            for (int bj = 0; bj < 2; ++bj) { lbv[bj][0] = *(const f32x4*)(lb + colb + bj * HALF); lbv[bj][1] = *(const f32x4*)(lb + colb + bj * HALF + 4); }
        }
#pragma unroll
        for (int ai = 0; ai < 2; ++ai)
#pragma unroll
            for (int m = 0; m < 4; ++m) {
                const int row = u.pm * BM + ai * HALF + wr * 64 + m * 16 + fr; const int lrow = row - MPROMPT;
#pragma unroll
                for (int bj = 0; bj < 2; ++bj) {
                    const int col = colb + bj * HALF; f32x4 v0 = acc[ai][bj][m][0], v1 = acc[ai][bj][m][1];
                    if (TYPE <= 1 && !samp) { const float sc = TYPE == 0 ? QSCALE : 1.0f; const f32x4 a = v0 * sc, b = v1 * sc;
                        float s = (a[0] * a[0] + a[1] * a[1]) + (a[2] * a[2] + a[3] * a[3]) + (b[0] * b[0] + b[1] * b[1]) + (b[2] * b[2] + b[3] * b[3]);
                        s += __shfl_xor(s, 16); s += __shfl_xor(s, 32); mxs[bj] = fmaxf(mxs[bj], s); }
                    if (TYPE == 0) { *(u32x4*)(Q + (size_t)row * 512 + col) = pack8(v0 * QSCALE, v1 * QSCALE); }
                    else if (TYPE == 1 || TYPE == 2) {
                        bf16_t* B = TYPE == 1 ? K : V; *(u32x4*)(B + (size_t)row * 512 + col) = pack8(v0, v1);
                        float* o = nullptr;
                        if (!samp) o = (TYPE == 1 ? okp : ovp) + (size_t)row * 512 + col; else if (lrow < 128) o = (TYPE == 1 ? oks : ovs) + (size_t)lrow * 512 + col;
                        if (o) { *(f32x4*)o = v0; *(f32x4*)(o + 4) = v1; }
                    }
                    else if (TYPE == 3) { *(u32x4*)(HQ + (size_t)row * 512 + col) = pack8(v0, v1); }
                    else if (TYPE == 4) {
                        f32x4 f0, f1, l0, l1;
#pragma unroll
                        for (int j = 0; j < 4; ++j) { const float a = lbv[bj][0][j], b = lbv[bj][1][j];
                            f0[j] = a + (1.0f - a) * sigm(v0[j]); f1[j] = b + (1.0f - b) * sigm(v1[j]); l0[j] = __logf(f0[j]); l1[j] = __logf(f1[j]); }
                        float* lp = LF + (size_t)row * 512 + col; *(f32x4*)lp = l0; *(f32x4*)(lp + 4) = l1;
                        *(u32x4*)(KK + (size_t)row * 512 + col) = pack8(1.0f - f0, 1.0f - f1);
                    }
                    else if (TYPE == 5) { *(u32x4*)(HI + (size_t)row * 512 + col) = pack8(v0, v1); }
                    else {
                        f32x4 s0, s1;
#pragma unroll
                        for (int j = 0; j < 4; ++j) { s0[j] = sigm(v0[j]); s1[j] = sigm(v1[j]); }
                        if (TYPE == 6) *(u32x4*)(HG + (size_t)row * 512 + col) = pack8(s0, s1);
                        else { bf16_t* G = samp ? ((TYPE == 7 ? GAs : GBs) + (size_t)lrow * 1024) : ((TYPE == 7 ? GA : GB) + (size_t)row * 1024); *(u32x4*)(G + col) = pack8(s0, s1); }
                    }
                }
            }
        if (TYPE <= 1 && !samp) {
#pragma unroll
            for (int bj = 0; bj < 2; ++bj) { float r = mxs[bj]; r = fmaxf(r, __shfl_xor(r, 1)); r = fmaxf(r, __shfl_xor(r, 2)); r = fmaxf(r, __shfl_xor(r, 4)); r = fmaxf(r, __shfl_xor(r, 8));
                const int hd = ct * 4 + 2 * bj + (wc >> 1), half = wc & 1;
                if (fr == 0 && fq == 0) atomicMax(TYPE == 1 ? mx + hd * 2 + half : mx + 128 + (u.pm * 8 + hd) * 2 + half, __float_as_uint(r)); }
        }
    }
    __device__ __forceinline__ void operator()(const f32x4 (&acc)[2][2][4][2], const Unit& u, int wr, int wc, int fr, int fq) const {
        const int pn = u.pn;
        if (pn < 14) { const int ct = pn & 1;
            switch (pn >> 1) { case 0: tile<0>(acc, u, ct, wr, wc, fr, fq); break; case 1: tile<1>(acc, u, ct, wr, wc, fr, fq); break; case 2: tile<2>(acc, u, ct, wr, wc, fr, fq); break;
                               case 3: tile<3>(acc, u, ct, wr, wc, fr, fq); break; case 4: tile<4>(acc, u, ct, wr, wc, fr, fq); break; case 5: tile<5>(acc, u, ct, wr, wc, fr, fq); break;
                               default: tile<6>(acc, u, ct, wr, wc, fr, fq); break; } }
        else if (pn < 18) tile<7>(acc, u, pn - 14, wr, wc, fr, fq);
        else tile<8>(acc, u, pn - 18, wr, wc, fr, fq);
    }
};

constexpr int DFF = 2816;
struct EpiUpSplit {
    static constexpr bool PERM = true, AFTER_DRAIN = false;
    bf16_t *A, *G; float *cp, *cs;
    __device__ __forceinline__ void operator()(const f32x4 (&acc)[2][2][4][2], const Unit& u, int wr, int wc, int fr, int fq) const {
        const int cidx = 128 * u.pn + wc * 32 + 8 * fq;
#pragma unroll
        for (int ai = 0; ai < 2; ++ai)
#pragma unroll
            for (int m = 0; m < 4; ++m) {
                const int row = u.pm * BM + ai * HALF + wr * 64 + m * 16 + fr; const int lrow = row - MPROMPT;
                *(u32x4*)(A + (size_t)row * DFF + cidx) = pack8(acc[ai][0][m][0], acc[ai][0][m][1]);
                *(u32x4*)(G + (size_t)row * DFF + cidx) = pack8(acc[ai][1][m][0], acc[ai][1][m][1]);
                float* o = nullptr;
                if (row == MPROMPT - 2 || row == MPROMPT - 1) o = cp + (size_t)(row - (MPROMPT - 2)) * DFF + cidx;
                else if (lrow >= 0 && lrow < 128 && (lrow & 15) >= 14) o = cs + (size_t)((lrow >> 4) * 2 + ((lrow & 15) - 14)) * DFF + cidx;
                if (o) { *(f32x4*)o = acc[ai][0][m][0]; *(f32x4*)(o + 4) = acc[ai][0][m][1]; }
            }
    }
};
}
#include <hip/hip_bf16.h>
#include <cmath>
namespace attn_body {
using bf16=__hip_bfloat16;
using bf16x8=__attribute__((ext_vector_type(8)))short;
using s16x4=__attribute__((ext_vector_type(4)))short;
using f32x16=__attribute__((ext_vector_type(16)))float;
using u32x4=__attribute__((ext_vector_type(4)))unsigned;
constexpr int BATCH=1,NHEAD=8,SEQ=16384,D=64,DM=NHEAD*D;
constexpr int NW=8,QBLK=32,QB=QBLK*NW,KVBLK=64,NQB=SEQ/QB;
constexpr int ATTN_PITCH=DM, ATTN_UNIT_ROWS=QB;
__device__ __forceinline__ int crow(int r,int hi){return (r&3)+8*(r>>2)+4*hi;}
#define SBAR() __builtin_amdgcn_sched_barrier(0)
__device__ __forceinline__ void cmask(f32x16&p0,f32x16&p1,int jb,int qrel,int hi){
  const float NEG=-INFINITY; int kb=64*jb+4*hi;
  #pragma unroll
  for(int r=0;r<16;++r){int kv=kb+(r&3)+8*(r>>2); if(kv>qrel)p0[r]=NEG; if(kv+32>qrel)p1[r]=NEG;}
}

constexpr int NSLOT=3, SLOTB=8192;
constexpr int LDS_K=0, LDS_V=NSLOT*SLOTB, LDS_WS=2*NSLOT*SLOTB, LDS_OST=LDS_WS+NW*64*4, LDS_KB=LDS_OST+NW*4096, LDS_BYTES=LDS_KB+SEQ*4;
constexpr float C2=0.125f*1.4426950408889634f;
__device__ __forceinline__ void glds16(const void*gsrc,unsigned lds_dst){unsigned keep;
  asm volatile("s_mov_b32 %0, m0\n\ts_mov_b32 m0, %2\n\ts_nop 0\n\tglobal_load_lds_dwordx4 %1, off\n\ts_mov_b32 m0, %0":"=&s"(keep):"v"(gsrc),"s"(lds_dst):"memory");}
__device__ __forceinline__ float max3f(float a,float b,float c){float r;asm("v_max3_f32 %0, %1, %2, %3":"=v"(r):"v"(a),"v"(b),"v"(c));return r;}
__device__ __forceinline__ float max2f(float a,float b){float r;asm("v_max_f32_e32 %0, %1, %2":"=v"(r):"v"(a),"v"(b));return r;}
__device__ __forceinline__ float fadd_s(float a,float b){float r;asm("v_add_f32_e32 %0, %1, %2":"=v"(r):"v"(a),"v"(b));return r;}
__device__ __forceinline__ float fsub_s(float a,float b){float r;asm("v_sub_f32_e32 %0, %1, %2":"=v"(r):"v"(a),"v"(b));return r;}
typedef float f32x2_t __attribute__((ext_vector_type(2))); typedef __bf16 bf16x2_t __attribute__((ext_vector_type(2)));
__device__ __forceinline__ unsigned cvtpk_s(float lo,float hi){f32x2_t v={lo,hi};bf16x2_t b=__builtin_convertvector(v,bf16x2_t);return __builtin_bit_cast(unsigned,b);}
#define WAIT_BAR(N) asm volatile("s_waitcnt vmcnt(" #N ") lgkmcnt(0)\n\ts_barrier":::"memory")

__device__ __forceinline__ void split3(float x,unsigned&h,unsigned&m,unsigned&l){
  h=__float_as_uint(x)&0xffff0000u; const float r1=x-__uint_as_float(h);
  m=__float_as_uint(r1)&0xffff0000u; const float r2=r1-__uint_as_float(m);
  l=__float_as_uint(r2)&0xffff0000u; }
__device__ __forceinline__ bf16x8 mk_kaug(float kb,int hi){ unsigned h,m,l; split3(kb,h,m,l); const unsigned msk=hi?0u:0xffffffffu;
  const u32x4 w={((h>>16)|m)&msk,((l>>16)&msk)|(hi?0u:0x3F800000u),hi?0u:0x3F803F80u,0u}; return __builtin_bit_cast(bf16x8,w); }
__device__ __forceinline__ bf16x8 mk_qaug(float mhat,int hi){ unsigned h,m,l; split3(-mhat,h,m,l); const unsigned msk=hi?0u:0xffffffffu;
  const u32x4 w={hi?0u:0x3F803F80u,(hi?0u:0x00003F80u)|(h&msk),((m>>16)|l)&msk,0u}; return __builtin_bit_cast(bf16x8,w); }
__device__ __forceinline__ void qkt(f32x16&p0,f32x16&p1,const char*Kslot,const bf16x8*qr,bf16x8 ka0,bf16x8 ka1,bf16x8 qa,int r32,int hi){
  p0=__builtin_amdgcn_mfma_f32_32x32x16_bf16(ka0,qa,f32x16{},0,0,0); p1=__builtin_amdgcn_mfma_f32_32x32x16_bf16(ka1,qa,f32x16{},0,0,0);
  const char*kb=Kslot+hi*1024+r32*16;
  #pragma unroll
  for(int d0=0;d0<4;++d0){
    const bf16x8 b0=*reinterpret_cast<const bf16x8*>(kb+d0*2048);
    const bf16x8 b1=*reinterpret_cast<const bf16x8*>(kb+d0*2048+512);
    p0=__builtin_amdgcn_mfma_f32_32x32x16_bf16(b0,qr[d0],p0,0,0,0);p1=__builtin_amdgcn_mfma_f32_32x32x16_bf16(b1,qr[d0],p1,0,0,0);}
}
typedef __attribute__((address_space(3))) const char* lds_cptr;
typedef short v4i16_t __attribute__((ext_vector_type(4))); typedef float f32x4_t __attribute__((ext_vector_type(4)));
__device__ __forceinline__ void kload8(bf16x8*kf,lds_cptr kp){
  kf[0]=*(const __attribute__((address_space(3))) bf16x8*)(kp);      kf[1]=*(const __attribute__((address_space(3))) bf16x8*)(kp+512);
  kf[2]=*(const __attribute__((address_space(3))) bf16x8*)(kp+2048); kf[3]=*(const __attribute__((address_space(3))) bf16x8*)(kp+2560);
  kf[4]=*(const __attribute__((address_space(3))) bf16x8*)(kp+4096); kf[5]=*(const __attribute__((address_space(3))) bf16x8*)(kp+4608);
  kf[6]=*(const __attribute__((address_space(3))) bf16x8*)(kp+6144); kf[7]=*(const __attribute__((address_space(3))) bf16x8*)(kp+6656);
}
__device__ __forceinline__ void kload2(bf16x8*kf,lds_cptr kp,int j){ kf[2*j]=*(const __attribute__((address_space(3))) bf16x8*)(kp+j*2048); kf[2*j+1]=*(const __attribute__((address_space(3))) bf16x8*)(kp+j*2048+512); }
__device__ __forceinline__ s16x4 vtr(lds_cptr p){ return __builtin_bit_cast(s16x4,__builtin_amdgcn_ds_read_tr16_b64_v4i16((__attribute__((address_space(3))) v4i16_t*)p)); }
__device__ __forceinline__ float rowmax(const f32x16&p0,const f32x16&p1){
  float a=max3f(p0[0],p0[1],p1[0]),b=max3f(p0[2],p0[3],p1[1]);a=max3f(a,p1[2],p1[3]);
  #pragma unroll
  for(int r=4;r<16;r+=4){a=max3f(a,p0[r],p0[r+1]);b=max3f(b,p0[r+2],p0[r+3]);a=max3f(a,p1[r],p1[r+1]);b=max3f(b,p1[r+2],p1[r+3]);}
  const float m=max2f(a,b);
  auto rr=__builtin_amdgcn_permlane32_swap(__float_as_uint(m),__float_as_uint(m),false,false);
  return max2f(__uint_as_float(rr[0]),__uint_as_float(rr[1]));
}
__device__ __forceinline__ void pv(f32x16*o,int vb,bf16x8 pa0,bf16x8 pa1,bf16x8 pa2,bf16x8 pa3){
  #pragma unroll
  for(int d0=0;d0<2;++d0){s16x4 lo[4],hi[4];
    #pragma unroll
    for(int ks=0;ks<4;++ks){
      asm volatile("ds_read_b64_tr_b16 %0,%1 offset:%c2":"=&v"(lo[ks]):"v"(vb),"i"(d0*4096+ks*1024):"memory");
      asm volatile("ds_read_b64_tr_b16 %0,%1 offset:%c2":"=&v"(hi[ks]):"v"(vb),"i"(d0*4096+ks*1024+512):"memory");}
    asm volatile("s_waitcnt lgkmcnt(0)":::"memory");SBAR();
    #define PK(k) (bf16x8){lo[k][0],lo[k][1],lo[k][2],lo[k][3],hi[k][0],hi[k][1],hi[k][2],hi[k][3]}
    o[d0]=__builtin_amdgcn_mfma_f32_32x32x16_bf16(pa0,PK(0),o[d0],0,0,0);
    o[d0]=__builtin_amdgcn_mfma_f32_32x32x16_bf16(pa1,PK(1),o[d0],0,0,0);
    o[d0]=__builtin_amdgcn_mfma_f32_32x32x16_bf16(pa2,PK(2),o[d0],0,0,0);
    o[d0]=__builtin_amdgcn_mfma_f32_32x32x16_bf16(pa3,PK(3),o[d0],0,0,0);
    #undef PK
  }
}

#ifndef ATTN_STORE16
#define ATTN_STORE16(p,v) (*(u32x4*)(p)=(v))
#endif
template<int THRL> __device__ __forceinline__ void attn_unit(int h,int qb,int tskip,const float*__restrict__ kbh,const bf16*Q,const bf16*__restrict__ K,const bf16*__restrict__ V,bf16*O,char*shm){
  int tid_=threadIdx.x; asm volatile("":"+v"(tid_));
  const int tid=tid_,lane=tid&63,r32=lane&31,hi=lane>>5; const int wid=__builtin_amdgcn_readfirstlane(tid>>6);
  const long rowbase=0; const int q0=qb*QB;
  const bf16*Qw=Q+(rowbase+q0+wid*QBLK)*DM+h*D;
  const bf16*Kh=K+(long)tskip*KVBLK*DM+h*D,*Vh=V+(long)tskip*KVBLK*DM+h*D;
  const unsigned lds0=(unsigned)(uintptr_t)shm;
  float*wsf=(float*)(shm+LDS_WS)+wid*64;
  const bf16*ksrc=Kh+(long)lane*DM+wid*8;
  const bf16*vsrc=Vh+(long)(16*(wid&3)+(lane>>2))*DM+(wid>>2)*32+(lane&3)*8;
  const unsigned kdst=lds0+LDS_K+wid*1024, vdst=lds0+LDS_V+wid*1024;
  #define DMA_K(t,slot) glds16(ksrc+(long)(t)*KVBLK*DM,(unsigned)__builtin_amdgcn_readfirstlane(kdst+(slot)))
  #define DMA_V(t,slot) glds16(vsrc+(long)(t)*KVBLK*DM,(unsigned)__builtin_amdgcn_readfirstlane(vdst+(slot)))
  const int vb0=(int)(lds0+LDS_V)+((lane>>4)&1)*32+(lane&3)*8+(4*hi+((lane&15)>>2))*64;
  const char*Kbase=shm+LDS_K; bf16x8 kf[8];
  const lds_cptr shm3=(lds_cptr)shm; const lds_cptr kp0=shm3+LDS_K+hi*1024+r32*16; const lds_cptr vp0=shm3+LDS_V+((lane>>4)&1)*32+(lane&3)*8+(4*hi+((lane&15)>>2))*64;
  const int NT=(q0+QB)/KVBLK-tskip;
  DMA_K(0,0);DMA_V(0,0);DMA_K(1,SLOTB);
  bf16x8 qr[4];
  #pragma unroll
  for(int d0=0;d0<4;++d0)qr[d0]=*reinterpret_cast<const bf16x8*>(&Qw[(long)r32*DM+d0*16+hi*8]);
  { const float*kg=kbh+(long)tskip*KVBLK; __attribute__((address_space(3))) float*kl=(__attribute__((address_space(3))) float*)(shm3+LDS_KB);
    for(int i=tid;i<NT*KVBLK;i+=NW*64)kl[i]=kg[i]; }
  const __attribute__((address_space(3))) float*kl3=(const __attribute__((address_space(3))) float*)(shm3+LDS_KB)+r32;
  bf16x8 qa=mk_qaug(0.f,hi); float kbv0,kbv1;
  float mhat=0.f,l_reg=0.f;f32x16 o[2];o[0]=f32x16{};o[1]=f32x16{};
  const int qrel=wid*QBLK+r32;
  #define CMASK(P0,P1,t) do{int jb_=(t)-(NT-4); if(jb_>=0)cmask(P0,P1,jb_,qrel,hi);}while(0)
  bool resc=false;
  #define START(P0,P1) do{ const float rm=rowmax(P0,P1); resc=false; \
    { const float dl=rm; mhat=fadd_s(mhat,dl); qa=mk_qaug(mhat,hi); \
      _Pragma("unroll") for(int r=0;r<16;++r){P0[r]=fsub_s(P0[r],dl);P1[r]=fsub_s(P1[r],dl);} \
      } \
    _Pragma("unroll") for(int r=0;r<16;++r)P0[r]=__builtin_amdgcn_exp2f(P0[r]); }while(0)
  #define RESC() do{ if(resc){ asm volatile("s_waitcnt lgkmcnt(0)":::"memory"); \
      _Pragma("unroll") for(int d_=0;d_<2;++d_) _Pragma("unroll") for(int r=0;r<16;++r)o[d_][r]*=wsf[crow(r,hi)]; } }while(0)
  f32x16 pA0,pA1,pB0,pB1;
  int sl_prev=0,sl_cur=0,sl_next=SLOTB;
  #define ROT() do{sl_prev=sl_cur;sl_cur=sl_next;sl_next=(sl_next==(NSLOT-1)*SLOTB)?0:sl_next+SLOTB;}while(0)
  DMA_K(2,2*SLOTB);
  WAIT_BAR(3);
  kbv0=kl3[0];kbv1=kl3[32];
  qkt(pA0,pA1,Kbase,qr,mk_kaug(kbv0,hi),mk_kaug(kbv1,hi),qa,r32,hi);asm volatile("s_nop 15\n\ts_nop 7":"+v"(pA0),"+v"(pA1));CMASK(pA0,pA1,0);
  kbv0=kl3[64];kbv1=kl3[96];
  START(pA0,pA1);
  _Pragma("unroll") for(int r=0;r<16;++r)pA1[r]=__builtin_amdgcn_exp2f(pA1[r]);
  WAIT_BAR(0);
  DMA_K(3,0);DMA_V(1,SLOTB);
  ROT();
  kload8(kf,kp0+sl_cur);
  WAIT_BAR(2);
  s16x4 vlo[8],vhi[8]; u32x4 pw0,pw1,pw2,pw3;
  #define PKW(P,B) cvtpk_s(P[B],P[B+1])
  #define PAF(k) __builtin_bit_cast(bf16x8,pw##k)
  #define VFR(i) (bf16x8){vlo[i][0],vlo[i][1],vlo[i][2],vlo[i][3],vhi[i][0],vhi[i][1],vhi[i][2],vhi[i][3]}
  #define PIN(x) asm volatile("":"+v"(x))
  #define MX3(a,b,c) __builtin_fmaxf(__builtin_fmaxf((a),(b)),(c))
  #define GAPA(MF,A0,A1,A2,A3,W0,W1,PW) do{ MF; sacc+=A0; sacc+=A1; sacc+=A2; sacc+=A3; PIN(sacc); W0; W1; PIN(PW); SBAR(); }while(0)
  #define EX(v) __builtin_amdgcn_exp2f(v)
  #define GAPB(MF,X,B) do{ MF; X[B]=EX(X[B]); X[B+1]=EX(X[B+1]); X[B+2]=EX(X[B+2]); X[B+3]=EX(X[B+3]); PIN(X); SBAR(); }while(0)
  #define VRD(i) do{ vlo[i]=vtr(vp_+(((i)>>2)*4096+((i)&3)*1024)); vhi[i]=vtr(vp_+(((i)>>2)*4096+((i)&3)*1024+512)); }while(0)
  #define KRD(G,j) do{ if(G){ kload2(kf,kp0+sl_next,j); SBAR(); } }while(0)
  #define STEP(C0,C1,P0,P1,t,GK,GV,GL) do{ SBAR(); \
    const lds_cptr vp_=vp0+sl_prev; \
    { const bf16x8 ka0_=mk_kaug(kbv0,hi),ka1_=mk_kaug(kbv1,hi); \
      C0=__builtin_amdgcn_mfma_f32_32x32x16_bf16(ka0_,qa,f32x16{},0,0,0); C1=__builtin_amdgcn_mfma_f32_32x32x16_bf16(ka1_,qa,f32x16{},0,0,0); \
      kbv0=kl3[((t)+1)*64]; kbv1=kl3[((t)+1)*64+32]; } SBAR(); \
    VRD(0); SBAR(); float sacc=(P0[0]+P0[1]); \
    GAPA(C0=__builtin_amdgcn_mfma_f32_32x32x16_bf16(kf[0],qr[0],C0,0,0,0), P0[2],P0[3],P0[4],P0[5],     pw0[0]=PKW(P0,0), pw0[1]=PKW(P0,2), pw0); \
    VRD(4); SBAR(); GAPA(C1=__builtin_amdgcn_mfma_f32_32x32x16_bf16(kf[1],qr[0],C1,0,0,0), P0[6],P0[7],P0[8],P0[9],     pw0[2]=PKW(P0,4), pw0[3]=PKW(P0,6), pw0); \
    VRD(1); SBAR(); GAPA(C0=__builtin_amdgcn_mfma_f32_32x32x16_bf16(kf[2],qr[1],C0,0,0,0),   P0[10],P0[11],P0[12],P0[13], pw1[0]=PKW(P0,8), pw1[1]=PKW(P0,10), pw1); \
    VRD(5); SBAR(); GAPA(C1=__builtin_amdgcn_mfma_f32_32x32x16_bf16(kf[3],qr[1],C1,0,0,0),   P0[14],P0[15],P1[0],P1[1],   pw1[2]=PKW(P0,12),pw1[3]=PKW(P0,14), pw1); \
    VRD(2); SBAR(); GAPA(C0=__builtin_amdgcn_mfma_f32_32x32x16_bf16(kf[4],qr[2],C0,0,0,0),   P1[2],P1[3],P1[4],P1[5],     pw2[0]=PKW(P1,0), pw2[1]=PKW(P1,2), pw2); \
    VRD(6); SBAR(); GAPA(C1=__builtin_amdgcn_mfma_f32_32x32x16_bf16(kf[5],qr[2],C1,0,0,0),   P1[6],P1[7],P1[8],P1[9],     pw2[2]=PKW(P1,4), pw2[3]=PKW(P1,6), pw2); \
    VRD(3); SBAR(); GAPA(C0=__builtin_amdgcn_mfma_f32_32x32x16_bf16(kf[6],qr[3],C0,0,0,0),   P1[10],P1[11],P1[12],P1[13], pw3[0]=PKW(P1,8), pw3[1]=PKW(P1,10), pw3); \
    VRD(7); SBAR(); GAPA(C1=__builtin_amdgcn_mfma_f32_32x32x16_bf16(kf[7],qr[3],C1,0,0,0),   P1[14],P1[15],0.f,0.f,       pw3[2]=PKW(P1,12),pw3[3]=PKW(P1,14), pw3); \
    l_reg+=sacc; \
    if(GK){DMA_K((t)+3,sl_cur);} if(GV){DMA_V((t)+1,sl_next);} \
    CMASK(C0,C1,t); \
    { float a=MX3(C0[0],C0[1],C1[0]),b=MX3(C0[2],C0[3],C1[1]); a=MX3(a,C1[2],C1[3]); \
      _Pragma("unroll") for(int r=4;r<16;r+=4){a=MX3(a,C0[r],C0[r+1]);b=MX3(b,C0[r+2],C0[r+3]);a=MX3(a,C1[r],C1[r+1]);b=MX3(b,C1[r+2],C1[r+3]);} \
      float rm=__builtin_fmaxf(a,b); { auto rr=__builtin_amdgcn_permlane32_swap(__float_as_uint(rm),__float_as_uint(rm),false,false); rm=__builtin_fmaxf(__uint_as_float(rr[0]),__uint_as_float(rr[1])); } \
      resc=false; \
      if(__builtin_expect(__any(rm>(float)THRL),0)){ const float dl=__builtin_fmaxf(rm,0.f); mhat+=dl; qa=mk_qaug(mhat,hi); \
        _Pragma("unroll") for(int r=0;r<16;++r){C0[r]-=dl;C1[r]-=dl;} \
        const float f=__builtin_amdgcn_exp2f(-dl); l_reg*=f; if(hi==0)wsf[r32]=f; resc=true; } } \
    SBAR(); \
    GAPB(o[0]=__builtin_amdgcn_mfma_f32_32x32x16_bf16(PAF(0),VFR(0),o[0],0,0,0), C0,0); \
    GAPB(o[1]=__builtin_amdgcn_mfma_f32_32x32x16_bf16(PAF(0),VFR(4),o[1],0,0,0), C0,4); \
    KRD(GL,0); GAPB(o[0]=__builtin_amdgcn_mfma_f32_32x32x16_bf16(PAF(1),VFR(1),o[0],0,0,0), C0,8); \
    KRD(GL,1); GAPB(o[1]=__builtin_amdgcn_mfma_f32_32x32x16_bf16(PAF(1),VFR(5),o[1],0,0,0), C0,12); \
    KRD(GL,2); GAPB(o[0]=__builtin_amdgcn_mfma_f32_32x32x16_bf16(PAF(2),VFR(2),o[0],0,0,0), C1,0); \
    KRD(GL,3); GAPB(o[1]=__builtin_amdgcn_mfma_f32_32x32x16_bf16(PAF(2),VFR(6),o[1],0,0,0), C1,4); \
    GAPB(o[0]=__builtin_amdgcn_mfma_f32_32x32x16_bf16(PAF(3),VFR(3),o[0],0,0,0), C1,8); \
    GAPB(o[1]=__builtin_amdgcn_mfma_f32_32x32x16_bf16(PAF(3),VFR(7),o[1],0,0,0), C1,12); \
    }while(0)
  int t=1;
  #undef CMASK
  #define CMASK(P0,P1,t) do{}while(0)
  for(;t+5<NT;t+=2){
    STEP(pB0,pB1,pA0,pA1,t,true,true,true);     WAIT_BAR(2); RESC(); ROT();
    STEP(pA0,pA1,pB0,pB1,t+1,true,true,true);   WAIT_BAR(2); RESC(); ROT();
  }
  #undef CMASK
  #define CMASK(P0,P1,t) do{int jb_=(t)-(NT-4); if(jb_>=0)cmask(P0,P1,jb_,qrel,hi);}while(0)
  #define ENDW(tt) do{ if((tt)+3<NT){WAIT_BAR(2);} else if((tt)+2<NT){WAIT_BAR(1);} else {WAIT_BAR(0);} }while(0)
  for(;t+1<NT;t+=2){
    STEP(pB0,pB1,pA0,pA1,t,(t+3<NT),(t+1<NT),(t+1<NT));       ENDW(t);   RESC(); ROT();
    STEP(pA0,pA1,pB0,pB1,t+1,(t+4<NT),(t+2<NT),(t+2<NT));     ENDW(t+1); RESC(); ROT();
  }
  STEP(pB0,pB1,pA0,pA1,NT-1,false,false,false); RESC();
  { float sacc=pB0[0]+pB0[1]; _Pragma("unroll") for(int r=2;r<16;++r)sacc+=pB0[r]; _Pragma("unroll") for(int r=0;r<16;++r)sacc+=pB1[r]; l_reg+=sacc;
    pw0=(u32x4){PKW(pB0,0),PKW(pB0,2),PKW(pB0,4),PKW(pB0,6)};pw1=(u32x4){PKW(pB0,8),PKW(pB0,10),PKW(pB0,12),PKW(pB0,14)};pw2=(u32x4){PKW(pB1,0),PKW(pB1,2),PKW(pB1,4),PKW(pB1,6)};pw3=(u32x4){PKW(pB1,8),PKW(pB1,10),PKW(pB1,12),PKW(pB1,14)};
    SBAR(); pv(o,vb0+sl_cur,PAF(0),PAF(1),PAF(2),PAF(3)); }
  #undef PKW
  #undef PAF
  #undef VFR
  #undef PIN
  #undef MX3
  #undef GAPA
  #undef GAPB
  #undef EX
  #undef VRD
  #undef KRD
  #undef STEP
  #undef ENDW
  {auto rr=__builtin_amdgcn_permlane32_swap(__float_as_uint(l_reg),__float_as_uint(l_reg),false,false);l_reg=__uint_as_float(rr[0])+__uint_as_float(rr[1]);}
  if(hi==0)wsf[32+r32]=l_reg;asm volatile("s_waitcnt lgkmcnt(0)":::"memory");
  float rli[16];
  #pragma unroll
  for(int r=0;r<16;++r)rli[r]=__builtin_amdgcn_rcpf(wsf[32+crow(r,hi)]);
  bf16*Ow=O+(rowbase+q0+wid*QBLK)*DM+h*D;
  { bf16*stg=(bf16*)(shm+LDS_OST)+wid*2048;
    #pragma unroll
    for(int r=0;r<16;++r){const int orow=crow(r,hi);
      #pragma unroll
      for(int d0=0;d0<2;++d0)stg[orow*64+d0*32+r32]=__float2bfloat16(o[d0][r]*rli[r]);}
    asm volatile("s_waitcnt lgkmcnt(0)":::"memory");
    #pragma unroll
    for(int i=0;i<4;++i){const int row=i*8+(lane>>3),ch=lane&7; const u32x4 v=*(const u32x4*)(stg+row*64+ch*8); ATTN_STORE16(Ow+(long)row*DM+ch*8,v);} }
  asm volatile("s_waitcnt lgkmcnt(0)\n\ts_barrier":::"memory");
  #undef DMA_K
  #undef DMA_V
  #undef CMASK
  #undef START
  #undef RESC
  #undef ROT
}
constexpr int ATTN_LDS_BYTES=LDS_BYTES;
#undef SBAR
#undef WAIT_BAR
}

constexpr int NWAVES = 8, NTHR = 512;
constexpr int DMODEL = 1024, MP = 16384, MS = 128, MTOT = MP + MS, MPAD = 16640;
constexpr int FW = 512, NINP = 5632, NIN = 5640, DFF = 2816, PAST = 4096, SKS = 4112;
constexpr float RMS_EPS = 1e-6f, LOG2E = 1.4426950408889634f, C2 = 0.125f * 1.4426950408889634f;

constexpr size_t OFF_Y = 0, OFF_YS = 16777216, OFF_PK = 16908288, OFF_PV = 25296896, OFF_PLF = 33685504, OFF_PH = 33816576, OFF_PC = 33882112,
                 OFF_SK = 33887744, OFF_SV = 33953280, OFF_SLF = 34018816, OFF_SH = 34019840, OFF_SC = 34544128, OUT_TOTAL = 34589184;
constexpr size_t MiB = 1u << 20;
constexpr size_t SZ512 = (size_t)MPAD * 512 * 2, SZ1024 = (size_t)MPAD * 1024 * 2;
constexpr size_t WS_CTL = 0, CTL_ZERO_BYTES = 1 * MiB;
constexpr size_t WS_LB = 1 * MiB, WS_KB = WS_LB + 65536, WS_SKB = WS_KB + 524288;
constexpr size_t WS_GAS = 3 * MiB, WS_GBS = WS_GAS + 524288;
constexpr size_t WS_WIN = 4 * MiB, WS_WBF = 15 * MiB, WS_WBH = 16 * MiB, WS_WOUT = 17 * MiB, WS_WUP = 19 * MiB, WS_WDN = 30 * MiB;
constexpr size_t WS_H1 = 36 * MiB;
constexpr size_t WS_Q = WS_H1 + SZ1024, WS_OH = WS_Q + SZ512, WS_K = WS_OH + SZ512, WS_V = WS_K + SZ512, WS_HQ = WS_V + SZ512, WS_KK = WS_HQ + SZ512,
                 WS_HI = WS_KK + SZ512, WS_HG = WS_HI + SZ512, WS_LF = WS_HG + SZ512, WS_END1 = WS_LF + 2 * SZ512;
constexpr size_t WS_BRF = WS_K, WS_BRH = WS_K + 4 * SZ512, WS_MERGED = WS_H1, WS_MIX = WS_K, WS_H2 = WS_H1;
constexpr size_t WS_ABUF = WS_Q, WS_GBUF = WS_ABUF + (size_t)MPAD * DFF * 2, WS_FFN = WS_Q, WS_END = WS_GBUF + (size_t)MPAD * DFF * 2;
constexpr size_t WS_SL = 232 * MiB, WS_DSEG = 248 * MiB, WS_SS = WS_H1;
static_assert(WS_END <= 256 * MiB && WS_END1 <= WS_SL && WS_DSEG + 131072 <= 256 * MiB, "d_ws map");
constexpr int CW_TMO = 0, CW_CODE = 1, CW_BAR = 4096;
constexpr int RING_OFF = 0, RING_BYTES = 131072, LDSCTL_OFF = 149504, MISC_OFF = LDSCTL_OFF + 320, LDS_BYTES = 150528;
constexpr int CW_KMX = 8192, CW_QMX = CW_KMX + 128;
static_assert(attn_body::ATTN_LDS_BYTES <= LDSCTL_OFF, "attention LDS");

#define GAS __attribute__((address_space(1)))
#define LAS __attribute__((address_space(3)))
typedef unsigned short bf16;
typedef unsigned v4u __attribute__((ext_vector_type(4)));
typedef float f32x4 __attribute__((ext_vector_type(4)));
typedef short bf16x8 __attribute__((ext_vector_type(8)));
typedef GAS unsigned gu32;
typedef GAS unsigned long long gu64;
#define RLX_AGENT __ATOMIC_RELAXED, __HIP_MEMORY_SCOPE_AGENT
#define LDS_WAIT() asm volatile("s_waitcnt lgkmcnt(0)" ::: "memory")
#define VM_WAIT() asm volatile("s_waitcnt vmcnt(0)" ::: "memory")
__device__ __forceinline__ unsigned long long rt() { return __builtin_amdgcn_s_memrealtime(); }
__device__ __forceinline__ unsigned f2bf(float f) { unsigned u = __builtin_bit_cast(unsigned, f); return (u + 0x7fffu + ((u >> 16) & 1u)) >> 16; }
__device__ __forceinline__ unsigned pk2(float lo, float hi) { return f2bf(lo) | (f2bf(hi) << 16); }

#define XB_TMO      128
#define XB_XCNT(j)  (256  + 64 * (j))
#define XB_XSUB(j)  (1280 + 64 * (j))
#define XB_XGEN(j)  (2304 + 64 * (j))
#define XB_TOP      3328
#define XB_TOPGEN   3392
#define XCD_BAR_WORDS 3456
#define XB_SPIN_CAP (1u << 26)

__device__ __forceinline__ unsigned xb_ld(unsigned* p)              { return __hip_atomic_load(p, __ATOMIC_RELAXED, __HIP_MEMORY_SCOPE_AGENT); }
__device__ __forceinline__ unsigned xb_add(unsigned* p, unsigned v) { return __hip_atomic_fetch_add(p, v, __ATOMIC_RELAXED, __HIP_MEMORY_SCOPE_AGENT); }
__device__ __forceinline__ unsigned xb_xcc_id() { return (unsigned)__builtin_amdgcn_s_getreg((3 << 11) | 20) & 0xFu; }
#define XB_SPIN(cond, bar) do { unsigned _sp = 0; while (cond) { __builtin_amdgcn_s_sleep(1); \
    if ((++_sp & 255u) == 0u) { if (xb_ld(&(bar)[XB_TMO])) break; if (_sp > XB_SPIN_CAP) { atomicAdd(&(bar)[XB_TMO], 1u); break; } } } } while (0)

struct XcdBarrier {
    unsigned* bar; unsigned x;
    volatile LAS unsigned* st;
};

__device__ __forceinline__ XcdBarrier xcd_barrier_post(unsigned* bar, volatile LAS unsigned* st) {
    XcdBarrier b; b.bar = bar; b.x = xb_xcc_id(); b.st = st;
    if (threadIdx.x == 0) (void)xb_add(&bar[XB_XCNT(b.x)], 1u);
    return b;
}
__device__ __forceinline__ void xcd_barrier_complete(unsigned* bar, unsigned x, unsigned& nloc, unsigned& nx) {
    const unsigned G = gridDim.x * gridDim.y * gridDim.z;
    unsigned sum, cnt, mine, sp = 0u;
    for (;;) {
        sum = 0u; cnt = 0u; mine = 0u;
#pragma unroll
        for (unsigned j = 0; j < 16; ++j) { const unsigned c = xb_ld(&bar[XB_XCNT(j)]); sum += c; cnt += (c > 0u) ? 1u : 0u; mine = (j == x) ? c : mine; }
        if (sum == G) break;
        __builtin_amdgcn_s_sleep(1);
        if ((++sp & 255u) == 0u) { if (xb_ld(&bar[XB_TMO])) break; if (sp > XB_SPIN_CAP) { atomicAdd(&bar[XB_TMO], 1u); break; } }
    }
    nloc = mine > 0u ? mine : 1u; nx = cnt > 0u ? cnt : 1u;
}

__device__ __forceinline__ void xcd_barrier(const XcdBarrier& b) {
    asm volatile("s_waitcnt vmcnt(0)" ::: "memory");
    __syncthreads();
    if (threadIdx.x == 0) {
        unsigned* bar = b.bar;
        __builtin_amdgcn_s_waitcnt(0);
        unsigned nloc = b.st[0], nx = b.st[1];
        if (nloc == 0u) { xcd_barrier_complete(bar, b.x, nloc, nx); b.st[0] = nloc; b.st[1] = nx; }
        const unsigned old = xb_add(&bar[XB_XSUB(b.x)], 1u);
        const unsigned gen = old / nloc;
        if (old + 1u == (gen + 1u) * nloc) {
            __builtin_amdgcn_fence(__ATOMIC_RELEASE, "agent");
            asm volatile("s_waitcnt vmcnt(0)" ::: "memory");
            const unsigned og = xb_add(&bar[XB_TOP], 1u);
            const unsigned tg = og / nx;
            if (og + 1u == (tg + 1u) * nx) xb_add(&bar[XB_TOPGEN], 1u);
            else XB_SPIN(xb_ld(&bar[XB_TOPGEN]) == tg, bar);
            __builtin_amdgcn_fence(__ATOMIC_ACQUIRE, "agent");
            xb_add(&bar[XB_XGEN(b.x)], 1u);
            asm volatile("s_waitcnt vmcnt(0)" ::: "memory");
        } else {
            XB_SPIN(xb_ld(&bar[XB_XGEN(b.x)]) == gen, bar);
            __builtin_amdgcn_fence(__ATOMIC_ACQUIRE, "agent");
            asm volatile("s_waitcnt vmcnt(0)" ::: "memory");
        }
    }
    __syncthreads();
}


__device__ __forceinline__ float wave_sum(float v) {
#pragma unroll
    for (int o = 1; o < 64; o <<= 1) v += __shfl_xor(v, o);
    return v;
}
__device__ __forceinline__ float bf2f(unsigned short b) { return __builtin_bit_cast(float, (unsigned)b << 16); }
__device__ __forceinline__ float bflo(unsigned u) { return __builtin_bit_cast(float, u << 16); }
__device__ __forceinline__ float bfhi(unsigned u) { return __builtin_bit_cast(float, u & 0xffff0000u); }
__device__ __forceinline__ float sigm(float x) { return 1.0f / (1.0f + __expf(-x)); }

struct Frame {
    LAS unsigned char* lds; volatile LAS unsigned* MISC; gu32* ctl;
    int tid, lane, wave, vcu, G;
    const float *xp, *xs, *ck, *cv, *clf, *sh, *sc, *g_pre, *g_post, *w_in, *fbias, *lbl, *hgn, *w_bf, *w_bh, *w_out, *g_pre2, *g_post2, *w_up, *cw, *cb, *w_dn;
    float* out; unsigned char* ws;
};
#define WSP(T, off) ((T*)(F.ws + (off)))

__device__ __forceinline__ void tr_item(const float* W, int ldW, bf16* WT, int Kd, int k0, int nsrc0, int drow0, LAS float* scr, int lane) {
#pragma unroll 8
    for (int i = 0; i < 32; ++i) { const int kk = 2 * i + (lane >> 5); scr[kk * 33 + (lane & 31)] = W[(size_t)(k0 + kk) * ldW + nsrc0 + (lane & 31)]; }
    LDS_WAIT(); asm volatile("" ::: "memory");
    const int c = lane & 7;
#pragma unroll
    for (int j = 0; j < 4; ++j) { const int n = (lane >> 3) + 8 * j; const LAS float* s = scr + (8 * c) * 33 + n;
        v4u o; o.x = pk2(s[0 * 33], s[1 * 33]); o.y = pk2(s[2 * 33], s[3 * 33]); o.z = pk2(s[4 * 33], s[5 * 33]); o.w = pk2(s[6 * 33], s[7 * 33]);
        *(GAS v4u*)(WT + (size_t)(drow0 + n) * Kd + k0 + 8 * c) = o; }
    LDS_WAIT(); asm volatile("" ::: "memory");
}
__device__ __forceinline__ void p0_prologue(Frame& F) {
    LAS float* scr = (LAS float*)(F.lds + RING_OFF + F.wave * 16384);
    const int gw = F.vcu * NWAVES + F.wave, NGW = F.G * NWAVES;
    constexpr int I0 = 16 * 48, I1 = 16 * 128, I2 = 8 * 32, I3 = 8 * 32, I4 = 16 * 32, I5 = 16 * 176, I6 = 44 * 32, NITEMS = I0 + I1 + I2 + I3 + I4 + I5 + I6;
    for (int it = gw; it < NITEMS; it += NGW) {
        int r = it;
        if (r < I0) { const int kb = r / 48, nb = r % 48; tr_item(F.w_in, NIN, WSP(bf16, WS_WIN), 1024, 64 * kb, 32 * nb, 32 * nb, scr, F.lane); continue; } r -= I0;
        if (r < I1) { const int kb = r / 128, nb = r % 128; tr_item(F.w_in, NIN, WSP(bf16, WS_WIN), 1024, 64 * kb, 1544 + 32 * nb, 1536 + 32 * nb, scr, F.lane); continue; } r -= I1;
        if (r < I2) { const int kb = r / 32, nb = r % 32; tr_item(F.w_bf, 1024, WSP(bf16, WS_WBF), 512, 64 * kb, 32 * nb, 32 * nb, scr, F.lane); continue; } r -= I2;
        if (r < I3) { const int kb = r / 32, nb = r % 32; tr_item(F.w_bh, 1024, WSP(bf16, WS_WBH), 512, 64 * kb, 32 * nb, 32 * nb, scr, F.lane); continue; } r -= I3;
        if (r < I4) { const int kb = r / 32, nb = r % 32; tr_item(F.w_out, 1024, WSP(bf16, WS_WOUT), 1024, 64 * kb, 32 * nb, 32 * nb, scr, F.lane); continue; } r -= I4;
        if (r < I5) { const int kb = r / 176, nb = r % 176; const int drow = nb < 88 ? (nb >> 2) * 256 + (nb & 3) * 32 : ((nb - 88) >> 2) * 256 + 128 + ((nb - 88) & 3) * 32;
                      tr_item(F.w_up, 2 * DFF, WSP(bf16, WS_WUP), 1024, 64 * kb, 32 * nb, drow, scr, F.lane); continue; } r -= I5;
        { const int kb = r / 32, nb = r % 32; tr_item(F.w_dn, 1024, WSP(bf16, WS_WDN), DFF, 64 * kb, 32 * nb, 32 * nb, scr, F.lane); }
    }
    __syncthreads();
    LAS float* wf = (LAS float*)(F.lds + RING_OFF);
    for (int i = F.tid; i < 8192; i += NTHR) wf[i] = F.w_in[(size_t)(i >> 3) * NIN + 1536 + (i & 7)];
    __syncthreads();
    bf16* H1 = WSP(bf16, WS_H1);
    for (int m = gw; m < MTOT; m += NGW) {
        const float* xr = m < MP ? F.xp + (size_t)m * DMODEL : F.xs + (size_t)(m - MP) * DMODEL;
        f32x4 v[4]; float s = 0.f;
#pragma unroll
        for (int j = 0; j < 4; ++j) { v[j] = ((const GAS f32x4*)xr)[F.lane + 64 * j]; s += (v[j].x * v[j].x + v[j].y * v[j].y) + (v[j].z * v[j].z + v[j].w * v[j].w); }
        const float inv = 1.0f / sqrtf(wave_sum(s) * (1.f / DMODEL) + RMS_EPS);
        float ff[8];
#pragma unroll
        for (int i = 0; i < 8; ++i) ff[i] = 0.f;
#pragma unroll
        for (int j = 0; j < 4; ++j) { const f32x4 g = ((const GAS f32x4*)F.g_pre)[F.lane + 64 * j]; v[j] = (v[j] * inv) * g;
            GAS unsigned long long* o8 = (GAS unsigned long long*)(H1 + (size_t)m * DMODEL) + F.lane + 64 * j;
            *o8 = (unsigned long long)pk2(v[j].x, v[j].y) | ((unsigned long long)pk2(v[j].z, v[j].w) << 32);
#pragma unroll
            for (int e = 0; e < 4; ++e) { const LAS f32x4* wr = (const LAS f32x4*)(wf + (size_t)(4 * (F.lane + 64 * j) + e) * 8); const f32x4 a = wr[0], b = wr[1]; const float hv = v[j][e];
                ff[0] += hv * a.x; ff[1] += hv * a.y; ff[2] += hv * a.z; ff[3] += hv * a.w; ff[4] += hv * b.x; ff[5] += hv * b.y; ff[6] += hv * b.z; ff[7] += hv * b.w; } }
#pragma unroll
        for (int i = 0; i < 8; ++i) ff[i] = wave_sum(ff[i]);
        float mine = ff[0];
#pragma unroll
        for (int i = 1; i < 8; ++i) mine = (F.lane == i) ? ff[i] : mine;
        if (F.lane < 8) { const float xv = mine + F.fbias[F.lane]; const float ls = fminf(xv, 0.f) - log1pf(__expf(-fabsf(xv)));
            float* o = m < MP ? F.out + OFF_PLF + (size_t)m * 8 : F.out + OFF_SLF + (size_t)(m - MP) * 8; o[F.lane] = ls; }
    }
    { const int gt = F.vcu * NTHR + F.tid; const int n16 = (MPAD - MTOT) * DMODEL * 2 / 16; for (int i = gt; i < n16; i += F.G * NTHR) ((GAS v4u*)(H1 + (size_t)MTOT * DMODEL))[i] = (v4u){0u, 0u, 0u, 0u}; }
    if (blockIdx.x == 0) { float* LB = WSP(float, WS_LB); for (int c = F.tid; c < 512; c += NTHR) LB[c] = sigm(F.lbl[c] - F.lbl[512 + c]); }
}

__device__ __forceinline__ void ph_cum(Frame& F) {
    const int bid = blockIdx.x; LAS double* ld = (LAS double*)(F.lds + RING_OFF);
    if (bid == 0) {
        const float* plf = F.out + OFF_PLF; float* KB = WSP(float, WS_KB); const int h = F.tid & 7, c = F.tid >> 3;
        double s = 0.0; for (int t = 256 * c; t < 256 * c + 256; ++t) s += (double)plf[(size_t)t * 8 + h];
        ld[c * 8 + h] = s; __syncthreads();
        double run = 0.0; for (int cc = 0; cc < c; ++cc) run += ld[cc * 8 + h];
        for (int t = 256 * c; t < 256 * c + 256; ++t) { run += (double)plf[(size_t)t * 8 + h]; KB[(size_t)h * MP + t] = (float)(-run * 1.4426950408889634); }
    } else if (bid <= 8) {
        const int b = bid - 1, h = F.tid & 7, c = F.tid >> 3; const float* cl = F.clf + (size_t)b * PAST * 8; float* SKB = WSP(float, WS_SKB) + (size_t)(b * 8 + h) * SKS;
        double s = 0.0; for (int j = 64 * c; j < 64 * c + 64; ++j) s += (double)cl[(size_t)j * 8 + h];
        ld[c * 8 + h] = s; __syncthreads();
        double run = 0.0; for (int cc = c + 1; cc < 64; ++cc) run += ld[cc * 8 + h];
        for (int j = 64 * c + 63; j >= 64 * c; --j) { SKB[j] = (float)(run * 1.4426950408889634); run += (double)cl[(size_t)j * 8 + h]; }
        if (c == 0) { const float* slf = F.out + OFF_SLF + (size_t)b * 16 * 8; double r2 = 0.0; for (int i = 0; i < 16; ++i) { r2 += (double)slf[i * 8 + h]; SKB[PAST + i] = (float)(-r2 * 1.4426950408889634); } }
    }
}

__device__ __forceinline__ void ph_attn(Frame& F) {
    typedef attn_body::bf16 abf;
    const abf* Q = WSP(abf, WS_Q); const abf* K = WSP(abf, WS_K); const abf* V = WSP(abf, WS_V); abf* O = WSP(abf, WS_Q); const float* KB = WSP(float, WS_KB);
    const int c = blockIdx.x; if (c >= 256) return;
    if (F.wave == 0) {
        const unsigned* qmx = (const unsigned*)(F.ctl + CW_QMX); const unsigned* kmx = (const unsigned*)(F.ctl + CW_KMX);
        for (int ui = 0; ui < 2; ++ui) { const int id = ui == 0 ? c : 511 - c, qb = id >> 3, h = id & 7; const float* kbh = KB + (size_t)h * MP;
            const float q2 = __uint_as_float(qmx[(qb * 8 + h) * 2]) + __uint_as_float(qmx[(qb * 8 + h) * 2 + 1]), k2 = __uint_as_float(kmx[h * 2]) + __uint_as_float(kmx[h * 2 + 1]);
            const float U2 = sqrtf(q2 * k2) * 1.02f, thr = kbh[256 * qb] - 30.0f - 2.0f * U2; const int nb = 4 * qb; int tfirst = nb;
            for (int r = 0; r < 4; ++r) { const int t = 64 * r + F.lane; const bool need = (t < nb) && (kbh[64 * t + 63] >= thr); const unsigned long long mk = __ballot(need);
                if (mk) { tfirst = 64 * r + (int)__ffsll((long long)mk) - 1; break; } }
            if (F.lane == 0) F.MISC[16 + ui] = (unsigned)(tfirst & ~1); }
    }
    __syncthreads();
    for (int ui = 0; ui < 2; ++ui) { const int id = ui == 0 ? c : 511 - c, qb = id >> 3, h = id & 7; const int tskip = (int)F.MISC[16 + ui];
        attn_body::attn_unit<40>(h, qb, tskip, KB + (size_t)h * MP, Q, K, V, O, (char*)F.lds); }
}
__device__ __forceinline__ void ph_attn_naive(Frame& F) {
    const bf16* Q = WSP(bf16, WS_Q); const bf16* K = WSP(bf16, WS_K); const bf16* V = WSP(bf16, WS_V); bf16* O = WSP(bf16, WS_Q); const float* KB = WSP(float, WS_KB);
    for (int unit = blockIdx.x; unit < 256; unit += F.G) {
        const int h = unit >> 5, qb = unit & 31, qi = qb * 512 + F.tid;
        float q[64], o[64];
        { const v4u* qr = (const v4u*)(Q + (size_t)qi * 512 + h * 64);
#pragma unroll
          for (int c = 0; c < 8; ++c) { const v4u w = qr[c]; q[8 * c] = bflo(w.x); q[8 * c + 1] = bfhi(w.x); q[8 * c + 2] = bflo(w.y); q[8 * c + 3] = bfhi(w.y); q[8 * c + 4] = bflo(w.z); q[8 * c + 5] = bfhi(w.z); q[8 * c + 6] = bflo(w.w); q[8 * c + 7] = bfhi(w.w); } }
#pragma unroll
        for (int d = 0; d < 64; ++d) o[d] = 0.f;
        float m = -1e30f, l = 0.f; const int kend = qb * 512 + 511;
        for (int k = 0; k <= kend; ++k) {
            const v4u* kr = (const v4u*)(K + (size_t)k * 512 + h * 64); float s = 0.f;
#pragma unroll
            for (int c = 0; c < 8; ++c) { const v4u w = kr[c]; s += q[8 * c] * bflo(w.x) + q[8 * c + 1] * bfhi(w.x) + q[8 * c + 2] * bflo(w.y) + q[8 * c + 3] * bfhi(w.y) + q[8 * c + 4] * bflo(w.z) + q[8 * c + 5] * bfhi(w.z) + q[8 * c + 6] * bflo(w.w) + q[8 * c + 7] * bfhi(w.w); }
            s += KB[(size_t)h * MP + k];
            if (k <= qi) {
                const float mn = fmaxf(m, s), a = __builtin_amdgcn_exp2f(m - mn), p = __builtin_amdgcn_exp2f(s - mn); l = l * a + p; m = mn;
                const v4u* vr = (const v4u*)(V + (size_t)k * 512 + h * 64);
#pragma unroll
                for (int c = 0; c < 8; ++c) { const v4u w = vr[c];
                    o[8 * c] = o[8 * c] * a + p * bflo(w.x); o[8 * c + 1] = o[8 * c + 1] * a + p * bfhi(w.x); o[8 * c + 2] = o[8 * c + 2] * a + p * bflo(w.y); o[8 * c + 3] = o[8 * c + 3] * a + p * bfhi(w.y);
                    o[8 * c + 4] = o[8 * c + 4] * a + p * bflo(w.z); o[8 * c + 5] = o[8 * c + 5] * a + p * bfhi(w.z); o[8 * c + 6] = o[8 * c + 6] * a + p * bflo(w.w); o[8 * c + 7] = o[8 * c + 7] * a + p * bfhi(w.w); }
            }
        }
        const float rl = 1.0f / l; v4u* orow = (v4u*)(O + (size_t)qi * 512 + h * 64);
#pragma unroll
        for (int c = 0; c < 8; ++c) { v4u w; w.x = pk2(o[8 * c] * rl, o[8 * c + 1] * rl); w.y = pk2(o[8 * c + 2] * rl, o[8 * c + 3] * rl); w.z = pk2(o[8 * c + 4] * rl, o[8 * c + 5] * rl); w.w = pk2(o[8 * c + 6] * rl, o[8 * c + 7] * rl); orow[c] = w; }
    }
}
__device__ __forceinline__ void ph_attn_sample_naive(Frame& F) {
    const bf16* Q = WSP(bf16, WS_Q); const bf16* K = WSP(bf16, WS_K); const bf16* V = WSP(bf16, WS_V); bf16* O = WSP(bf16, WS_Q);
    const int task = blockIdx.x * NWAVES + F.wave; if (task >= 64) return;
    const int b = task >> 3, h = task & 7, qi = F.lane & 15; const size_t row = (size_t)MP + b * 16 + qi; const float* SKB = WSP(float, WS_SKB) + (size_t)(b * 8 + h) * SKS;
    float q[64], o[64];
    { const v4u* qr = (const v4u*)(Q + row * 512 + h * 64);
#pragma unroll
      for (int c = 0; c < 8; ++c) { const v4u w = qr[c]; q[8 * c] = bflo(w.x); q[8 * c + 1] = bfhi(w.x); q[8 * c + 2] = bflo(w.y); q[8 * c + 3] = bfhi(w.y); q[8 * c + 4] = bflo(w.z); q[8 * c + 5] = bfhi(w.z); q[8 * c + 6] = bflo(w.w); q[8 * c + 7] = bfhi(w.w); } }
#pragma unroll
    for (int d = 0; d < 64; ++d) o[d] = 0.f;
    float m = -1e30f, l = 0.f;
    for (int k = 0; k < PAST; ++k) {
        const f32x4* kr = (const f32x4*)(F.ck + ((size_t)(b * PAST + k) * 8 + h) * 64); float s = 0.f;
#pragma unroll
        for (int c = 0; c < 16; ++c) { const f32x4 w = kr[c]; s += q[4 * c] * w.x + q[4 * c + 1] * w.y + q[4 * c + 2] * w.z + q[4 * c + 3] * w.w; }
        s += SKB[k];
        const float mn = fmaxf(m, s), a = __builtin_amdgcn_exp2f(m - mn), p = __builtin_amdgcn_exp2f(s - mn); l = l * a + p; m = mn;
        const f32x4* vr = (const f32x4*)(F.cv + ((size_t)(b * PAST + k) * 8 + h) * 64);
#pragma unroll
        for (int c = 0; c < 16; ++c) { const f32x4 w = vr[c]; o[4 * c] = o[4 * c] * a + p * w.x; o[4 * c + 1] = o[4 * c + 1] * a + p * w.y; o[4 * c + 2] = o[4 * c + 2] * a + p * w.z; o[4 * c + 3] = o[4 * c + 3] * a + p * w.w; }
    }
    for (int i = 0; i < 16; ++i) {
        const size_t kr_ = (size_t)MP + b * 16 + i; const v4u* kr = (const v4u*)(K + kr_ * 512 + h * 64); float s = 0.f;
#pragma unroll
        for (int c = 0; c < 8; ++c) { const v4u w = kr[c]; s += q[8 * c] * bflo(w.x) + q[8 * c + 1] * bfhi(w.x) + q[8 * c + 2] * bflo(w.y) + q[8 * c + 3] * bfhi(w.y) + q[8 * c + 4] * bflo(w.z) + q[8 * c + 5] * bfhi(w.z) + q[8 * c + 6] * bflo(w.w) + q[8 * c + 7] * bfhi(w.w); }
        s += SKB[PAST + i];
        if (i <= qi) {
            const float mn = fmaxf(m, s), a = __builtin_amdgcn_exp2f(m - mn), p = __builtin_amdgcn_exp2f(s - mn); l = l * a + p; m = mn;
            const v4u* vr = (const v4u*)(V + kr_ * 512 + h * 64);
#pragma unroll
            for (int c = 0; c < 8; ++c) { const v4u w = vr[c];
                o[8 * c] = o[8 * c] * a + p * bflo(w.x); o[8 * c + 1] = o[8 * c + 1] * a + p * bfhi(w.x); o[8 * c + 2] = o[8 * c + 2] * a + p * bflo(w.y); o[8 * c + 3] = o[8 * c + 3] * a + p * bfhi(w.y);
                o[8 * c + 4] = o[8 * c + 4] * a + p * bflo(w.z); o[8 * c + 5] = o[8 * c + 5] * a + p * bfhi(w.z); o[8 * c + 6] = o[8 * c + 6] * a + p * bflo(w.w); o[8 * c + 7] = o[8 * c + 7] * a + p * bfhi(w.w); }
        }
    }
    if (F.lane < 16) { const float rl = 1.0f / l; v4u* orow = (v4u*)(O + row * 512 + h * 64);
#pragma unroll
        for (int c = 0; c < 8; ++c) { v4u w; w.x = pk2(o[8 * c] * rl, o[8 * c + 1] * rl); w.y = pk2(o[8 * c + 2] * rl, o[8 * c + 3] * rl); w.z = pk2(o[8 * c + 4] * rl, o[8 * c + 5] * rl); w.w = pk2(o[8 * c + 6] * rl, o[8 * c + 7] * rl); orow[c] = w; } }
}

__device__ __forceinline__ void hgrn_chain(Frame& F, size_t row0, int T, int h, int v, float& S0, float& S1) {
    const bf16* HQ = WSP(bf16, WS_HQ); const bf16* KK = WSP(bf16, WS_KK); const bf16* HI = WSP(bf16, WS_HI); const float* LF = WSP(float, WS_LF); bf16* OH = WSP(bf16, WS_OH);
    const int d0 = F.lane, d1 = F.lane + 64;
    for (int t = 0; t < T; ++t) {
        const size_t base = (row0 + t) * 512 + h * 128;
        const float q0 = bf2f(HQ[base + d0]), q1 = bf2f(HQ[base + d1]), k0 = bf2f(KK[base + d0]), k1 = bf2f(KK[base + d1]), l0 = LF[base + d0], l1 = LF[base + d1], iv = bf2f(HI[base + v]);
        S0 = __expf(l0) * S0 + k0 * iv; S1 = __expf(l1) * S1 + k1 * iv;
        const float p = wave_sum(q0 * S0 + q1 * S1);
        if (F.lane == 0) OH[base + v] = (bf16)f2bf(p);
    }
}
__device__ __forceinline__ void ph_hgrn_naive(Frame& F) {
    const int gw = blockIdx.x * NWAVES + F.wave, NGW = F.G * NWAVES;
    for (int task = gw; task < 4096; task += NGW) { const int bh = task >> 7, v = task & 127, b = bh >> 2, h = bh & 3;
        const float* st = F.sh + (size_t)bh * 16384; float S0 = st[(size_t)F.lane * 128 + v], S1 = st[(size_t)(F.lane + 64) * 128 + v];
        hgrn_chain(F, (size_t)MP + b * 16, 16, h, v, S0, S1);
        float* so = F.out + OFF_SH + (size_t)bh * 16384; so[(size_t)F.lane * 128 + v] = S0; so[(size_t)(F.lane + 64) * 128 + v] = S1; }
}
__device__ __forceinline__ void ph_hgnorm(Frame& F) {
    const int gw = F.vcu * NWAVES + F.wave, NGW = F.G * NWAVES; unsigned* OH = WSP(unsigned, WS_OH); const unsigned* HG = WSP(unsigned, WS_HG);
    const float g0 = F.hgn[2 * F.lane], g1 = F.hgn[2 * F.lane + 1];
    for (int task = gw; task < MS * 4; task += NGW) { const size_t idx = ((size_t)MP * 4 + task) * 64 + F.lane; const unsigned w = OH[idx], g = HG[idx];
        const float a = bflo(w), b = bfhi(w); const float inv = 1.0f / sqrtf(wave_sum(a * a + b * b) * (1.f / 128) + RMS_EPS);
        OH[idx] = pk2(a * inv * g0 * bflo(g), b * inv * g1 * bfhi(g)); }
}
__device__ __forceinline__ void ph_merge(Frame& F) {
    const float* BRF = WSP(float, WS_BRF); const float* BRH = WSP(float, WS_BRH); bf16* MG = WSP(bf16, WS_MERGED);
    const size_t n8 = (size_t)MTOT * DMODEL / 8;
    for (size_t i = (size_t)F.vcu * NTHR + F.tid; i < n8; i += (size_t)F.G * NTHR) { const size_t m = i >> 7, c = (i & 127) * 8;
        const bf16* ga = m < MP ? (const bf16*)F.out + m * DMODEL + c : WSP(bf16, WS_GAS) + (m - MP) * DMODEL + c;
        const bf16* gb = m < MP ? (const bf16*)F.out + (size_t)MP * DMODEL + m * DMODEL + c : WSP(bf16, WS_GBS) + (m - MP) * DMODEL + c;
        const v4u a = *(const v4u*)ga, b = *(const v4u*)gb; const f32x4 f0 = *(const f32x4*)(BRF + m * DMODEL + c), f1 = *(const f32x4*)(BRF + m * DMODEL + c + 4), h0 = *(const f32x4*)(BRH + m * DMODEL + c), h1 = *(const f32x4*)(BRH + m * DMODEL + c + 4);
        v4u o; o.x = pk2(bflo(a.x) * f0.x + bflo(b.x) * h0.x, bfhi(a.x) * f0.y + bfhi(b.x) * h0.y); o.y = pk2(bflo(a.y) * f0.z + bflo(b.y) * h0.z, bfhi(a.y) * f0.w + bfhi(b.y) * h0.w);
        o.z = pk2(bflo(a.z) * f1.x + bflo(b.z) * h1.x, bfhi(a.z) * f1.y + bfhi(b.z) * h1.y); o.w = pk2(bflo(a.w) * f1.z + bflo(b.w) * h1.z, bfhi(a.w) * f1.w + bfhi(b.w) * h1.w);
        *(v4u*)(MG + m * DMODEL + c) = o; }
}
__device__ __forceinline__ void ph_norm1(Frame& F) {
    const int gw = F.vcu * NWAVES + F.wave, NGW = F.G * NWAVES; const float* MIX = WSP(float, WS_MIX); bf16* H2 = WSP(bf16, WS_H2);
    for (int m = gw; m < MTOT; m += NGW) {
        const float* xr = m < MP ? F.xp + (size_t)m * DMODEL : F.xs + (size_t)(m - MP) * DMODEL; float* yr = m < MP ? F.out + OFF_Y + (size_t)m * DMODEL : F.out + OFF_YS + (size_t)(m - MP) * DMODEL;
        f32x4 v[4]; float s = 0.f;
#pragma unroll
        for (int j = 0; j < 4; ++j) { v[j] = ((const GAS f32x4*)(MIX + (size_t)m * DMODEL))[F.lane + 64 * j]; s += (v[j].x * v[j].x + v[j].y * v[j].y) + (v[j].z * v[j].z + v[j].w * v[j].w); }
        const float inv = 1.0f / sqrtf(wave_sum(s) * (1.f / DMODEL) + RMS_EPS); float s2 = 0.f;
#pragma unroll
        for (int j = 0; j < 4; ++j) { const f32x4 g = ((const GAS f32x4*)F.g_post)[F.lane + 64 * j], x = ((const GAS f32x4*)xr)[F.lane + 64 * j]; v[j] = x + (v[j] * inv) * g;
            ((GAS f32x4*)yr)[F.lane + 64 * j] = v[j]; s2 += (v[j].x * v[j].x + v[j].y * v[j].y) + (v[j].z * v[j].z + v[j].w * v[j].w); }
        const float inv2 = 1.0f / sqrtf(wave_sum(s2) * (1.f / DMODEL) + RMS_EPS);
#pragma unroll
        for (int j = 0; j < 4; ++j) { const f32x4 g = ((const GAS f32x4*)F.g_pre2)[F.lane + 64 * j]; const f32x4 hv = (v[j] * inv2) * g;
            GAS unsigned long long* o8 = (GAS unsigned long long*)(H2 + (size_t)m * DMODEL) + F.lane + 64 * j; *o8 = (unsigned long long)pk2(hv.x, hv.y) | ((unsigned long long)pk2(hv.z, hv.w) << 32); }
    }
}
__device__ __forceinline__ float gelu_tanh(float c) { const float u = 0.7978845608028654f * (c + 0.044715f * c * c * c); const float t = 1.0f - 2.0f / (__expf(2.0f * u) + 1.0f); return 0.5f * c * (1.0f + t); }
__device__ __forceinline__ void ph_conv(Frame& F) {
    const bf16* A = WSP(bf16, WS_ABUF); bf16* G = WSP(bf16, WS_GBUF); constexpr int NG = DFF / 8; const size_t n8 = (size_t)MTOT * NG;
    for (size_t i = (size_t)F.vcu * NTHR + F.tid; i < n8; i += (size_t)F.G * NTHR) { const size_t m = i / NG; const int c = (int)(i % NG) * 8;
        float a0[8], a1[8], a2[8];
        { const v4u w = *(const v4u*)(A + m * DFF + c); a0[0] = bflo(w.x); a0[1] = bfhi(w.x); a0[2] = bflo(w.y); a0[3] = bfhi(w.y); a0[4] = bflo(w.z); a0[5] = bfhi(w.z); a0[6] = bflo(w.w); a0[7] = bfhi(w.w); }
        int t, b = 0; const bool samp = m >= MP; if (samp) { t = (int)(m - MP) & 15; b = (int)(m - MP) >> 4; } else t = (int)(m < 2 ? m : 2);
        if (t >= 1) { const v4u w = *(const v4u*)(A + (m - 1) * DFF + c); a1[0] = bflo(w.x); a1[1] = bfhi(w.x); a1[2] = bflo(w.y); a1[3] = bfhi(w.y); a1[4] = bflo(w.z); a1[5] = bfhi(w.z); a1[6] = bflo(w.w); a1[7] = bfhi(w.w); }
        else {
#pragma unroll
            for (int e = 0; e < 8; ++e) a1[e] = samp ? F.sc[((size_t)b * 2 + 1) * DFF + c + e] : 0.f; }
        if (t >= 2) { const v4u w = *(const v4u*)(A + (m - 2) * DFF + c); a2[0] = bflo(w.x); a2[1] = bfhi(w.x); a2[2] = bflo(w.y); a2[3] = bfhi(w.y); a2[4] = bflo(w.z); a2[5] = bfhi(w.z); a2[6] = bflo(w.w); a2[7] = bfhi(w.w); }
        else {
#pragma unroll
            for (int e = 0; e < 8; ++e) a2[e] = samp ? F.sc[((size_t)b * 2 + t) * DFF + c + e] : 0.f; }
        const v4u gw_ = *(const v4u*)(G + m * DFF + c); float g[8] = {bflo(gw_.x), bfhi(gw_.x), bflo(gw_.y), bfhi(gw_.y), bflo(gw_.z), bfhi(gw_.z), bflo(gw_.w), bfhi(gw_.w)}; float u[8];
#pragma unroll
        for (int e = 0; e < 8; ++e) { const float cv_ = F.cb[c + e] + F.cw[c + e] * a2[e] + F.cw[DFF + c + e] * a1[e] + F.cw[2 * DFF + c + e] * a0[e]; u[e] = gelu_tanh(cv_) * g[e]; }
        v4u o; o.x = pk2(u[0], u[1]); o.y = pk2(u[2], u[3]); o.z = pk2(u[4], u[5]); o.w = pk2(u[6], u[7]); *(v4u*)(G + m * DFF + c) = o; }
}
__device__ __forceinline__ void ph_norm2(Frame& F) {
    const int gw = F.vcu * NWAVES + F.wave, NGW = F.G * NWAVES; const float* FFN = WSP(float, WS_FFN);
    for (int m = gw; m < MTOT; m += NGW) {
        float* yr = m < MP ? F.out + OFF_Y + (size_t)m * DMODEL : F.out + OFF_YS + (size_t)(m - MP) * DMODEL;
        f32x4 v[4]; float s = 0.f;
#pragma unroll
        for (int j = 0; j < 4; ++j) { v[j] = ((const GAS f32x4*)(FFN + (size_t)m * DMODEL))[F.lane + 64 * j]; s += (v[j].x * v[j].x + v[j].y * v[j].y) + (v[j].z * v[j].z + v[j].w * v[j].w); }
        const float inv = 1.0f / sqrtf(wave_sum(s) * (1.f / DMODEL) + RMS_EPS);
#pragma unroll
        for (int j = 0; j < 4; ++j) { const f32x4 g = ((const GAS f32x4*)F.g_post2)[F.lane + 64 * j]; GAS f32x4* y4 = (GAS f32x4*)yr + F.lane + 64 * j; *y4 = *y4 + (v[j] * inv) * g; }
    }
}


namespace hg {
typedef short bf16x8 __attribute__((ext_vector_type(8)));
typedef float f32x4 __attribute__((ext_vector_type(4)));
typedef unsigned u32x4 __attribute__((ext_vector_type(4)));
typedef unsigned u32x2 __attribute__((ext_vector_type(2)));
constexpr int SEGL = 256, NSEG = MP / SEGL, CH = 32, QT_OFF = 0, KH_OFF = 8704, KT_OFF = 17408, IT_OFF = 27648, DEC_OFF = 37888, BQ_OFF = 38400, RS_OFF = 40448;
typedef float f32x2 __attribute__((ext_vector_type(2))); typedef __bf16 bf16x2 __attribute__((ext_vector_type(2)));
__device__ __forceinline__ unsigned cvtpk(float lo, float hi) { const f32x2 v = {lo, hi}; return __builtin_bit_cast(unsigned, __builtin_convertvector(v, bf16x2)); }
__device__ __forceinline__ bf16x8 pack8(const f32x4 a, const f32x4 b) { const u32x4 w = {cvtpk(a[0], a[1]), cvtpk(a[2], a[3]), cvtpk(b[0], b[1]), cvtpk(b[2], b[3])}; return __builtin_bit_cast(bf16x8, w); }
#define HG_MFMA(A, B, C) __builtin_amdgcn_mfma_f32_16x16x32_bf16(A, B, C, 0, 0, 0)
template <bool OUT> __device__ __forceinline__ void hgrn_seg(Frame& F, int seg, int h) {
    const int tid = F.tid, lane = F.lane, w = F.wave, c16 = lane & 15, g = lane >> 4, v0 = 16 * w, d = tid & 127, tq = tid >> 7;
    LAS unsigned char* L = F.lds + RING_OFF;
    LAS unsigned short* QT = (LAS unsigned short*)(L + QT_OFF); LAS unsigned short* KH = (LAS unsigned short*)(L + KH_OFF);
    LAS float* DEC = (LAS float*)(L + DEC_OFF); LAS float* BQ = (LAS float*)(L + BQ_OFF); LAS float* RS = (LAS float*)(L + RS_OFF);
    const bf16* HQ = WSP(bf16, WS_HQ); const bf16* KK = WSP(bf16, WS_KK); const bf16* HI = WSP(bf16, WS_HI); const float* LF = WSP(float, WS_LF); const bf16* HG = WSP(bf16, WS_HG); bf16* OH = WSP(bf16, WS_OH);
    float* SLOT = WSP(float, OUT ? WS_SS : WS_SL) + (size_t)(seg * 4 + h) * 16384;
    f32x4 T[8];
#pragma unroll
    for (int m = 0; m < 8; ++m) {
        if (OUT) {
#pragma unroll
            for (int r = 0; r < 4; ++r) T[m][r] = SLOT[(size_t)(16 * m + 4 * g + r) * 128 + v0 + c16]; }
        else T[m] = (f32x4){0.f, 0.f, 0.f, 0.f};
    }
    float segtot = 0.f;
    for (int c = 0; c < SEGL / CH; ++c) {
        const size_t row0 = (size_t)seg * SEGL + c * CH, gb = (row0 + 8 * tq) * 512 + h * 128 + d;
        float lfv[8], cs[8], qv[8], kv[8]; unsigned short iv[8];
#pragma unroll
        for (int j = 0; j < 8; ++j) { lfv[j] = LF[gb + (size_t)j * 512]; kv[j] = bf2f(KK[gb + (size_t)j * 512]); iv[j] = HI[gb + (size_t)j * 512]; if (OUT) qv[j] = bf2f(HQ[gb + (size_t)j * 512]); }
        float run = 0.f;
#pragma unroll
        for (int j = 0; j < 8; ++j) { run += lfv[j]; cs[j] = run; }
        BQ[tq * 128 + d] = run;
        __syncthreads();
        const float q0 = BQ[d], q1 = BQ[128 + d], q2 = BQ[256 + d], q3 = BQ[384 + d];
        const float pre = (tq > 0 ? q0 : 0.f) + (tq > 1 ? q1 : 0.f) + (tq > 2 ? q2 : 0.f), tot = (q0 + q1) + (q2 + q3);
        float kt[8];
#pragma unroll
        for (int j = 0; j < 8; ++j) { const float b = pre + cs[j]; const int t = 8 * tq + j;
            if (OUT) { QT[t * 136 + d] = (unsigned short)f2bf(qv[j] * __expf(b)); KH[t * 136 + d] = (unsigned short)f2bf(kv[j] * __expf(fminf(-b, 80.f))); }
            kt[j] = kv[j] * __expf(tot - b); }
        *(LAS u32x4*)(L + KT_OFF + d * 80 + 16 * tq) = (u32x4){cvtpk(kt[0], kt[1]), cvtpk(kt[2], kt[3]), cvtpk(kt[4], kt[5]), cvtpk(kt[6], kt[7])};
        *(LAS u32x4*)(L + IT_OFF + d * 80 + 16 * tq) = (u32x4){(unsigned)iv[0] | ((unsigned)iv[1] << 16), (unsigned)iv[2] | ((unsigned)iv[3] << 16), (unsigned)iv[4] | ((unsigned)iv[5] << 16), (unsigned)iv[6] | ((unsigned)iv[7] << 16)};
        if (tq == 0) { DEC[d] = __expf(tot); segtot += tot; }
        __syncthreads();
        f32x4 O0 = {0.f, 0.f, 0.f, 0.f}, O1 = {0.f, 0.f, 0.f, 0.f};
        if (OUT) {
            f32x4 X00 = {0.f, 0.f, 0.f, 0.f}, X01 = X00, X11 = X00;
#pragma unroll
            for (int ks = 0; ks < 4; ++ks) {
                const bf16x8 ka0 = *(const LAS bf16x8*)(L + KH_OFF + c16 * 272 + (32 * ks + 8 * g) * 2), ka1 = *(const LAS bf16x8*)(L + KH_OFF + (16 + c16) * 272 + (32 * ks + 8 * g) * 2);
                const bf16x8 qb0 = *(const LAS bf16x8*)(L + QT_OFF + c16 * 272 + (32 * ks + 8 * g) * 2), qb1 = *(const LAS bf16x8*)(L + QT_OFF + (16 + c16) * 272 + (32 * ks + 8 * g) * 2);
                X00 = HG_MFMA(ka0, qb0, X00); X01 = HG_MFMA(ka0, qb1, X01); X11 = HG_MFMA(ka1, qb1, X11);
            }
#pragma unroll
            for (int r = 0; r < 4; ++r) if (4 * g + r > c16) { X00[r] = 0.f; X11[r] = 0.f; }
            const bf16x8 Bt0 = pack8(X00, (f32x4){0.f, 0.f, 0.f, 0.f}), Bt1 = pack8(X01, X11);
            { const u32x2 lo = *(const LAS u32x2*)(L + IT_OFF + (v0 + c16) * 80 + (4 * g) * 2), hi = *(const LAS u32x2*)(L + IT_OFF + (v0 + c16) * 80 + (16 + 4 * g) * 2);
              const bf16x8 itp = __builtin_bit_cast(bf16x8, (u32x4){lo.x, lo.y, hi.x, hi.y});
              O0 = HG_MFMA(itp, Bt0, O0); O1 = HG_MFMA(itp, Bt1, O1); }
#pragma unroll
            for (int ks = 0; ks < 4; ++ks) {
                const bf16x8 Afr = pack8(T[2 * ks], T[2 * ks + 1]);
                const u32x2 a0 = *(const LAS u32x2*)(L + QT_OFF + c16 * 272 + (32 * ks + 4 * g) * 2), a1 = *(const LAS u32x2*)(L + QT_OFF + c16 * 272 + (32 * ks + 16 + 4 * g) * 2);
                const u32x2 b0 = *(const LAS u32x2*)(L + QT_OFF + (16 + c16) * 272 + (32 * ks + 4 * g) * 2), b1 = *(const LAS u32x2*)(L + QT_OFF + (16 + c16) * 272 + (32 * ks + 16 + 4 * g) * 2);
                O0 = HG_MFMA(Afr, __builtin_bit_cast(bf16x8, (u32x4){a0.x, a0.y, a1.x, a1.y}), O0); O1 = HG_MFMA(Afr, __builtin_bit_cast(bf16x8, (u32x4){b0.x, b0.y, b1.x, b1.y}), O1);
            }
        }
        { const bf16x8 itn = *(const LAS bf16x8*)(L + IT_OFF + (v0 + c16) * 80 + (8 * g) * 2);
#pragma unroll
          for (int m = 0; m < 8; ++m) { const f32x4 dec = *(const LAS f32x4*)(DEC + 16 * m + 4 * g); const bf16x8 ktf = *(const LAS bf16x8*)(L + KT_OFF + (16 * m + c16) * 80 + (8 * g) * 2);
              T[m] = HG_MFMA(ktf, itn, T[m] * dec); } }
        if (OUT) {
            float s0 = (O0[0] * O0[0] + O0[1] * O0[1]) + (O0[2] * O0[2] + O0[3] * O0[3]), s1 = (O1[0] * O1[0] + O1[1] * O1[1]) + (O1[2] * O1[2] + O1[3] * O1[3]);
            s0 += __shfl_xor(s0, 16); s0 += __shfl_xor(s0, 32); s1 += __shfl_xor(s1, 16); s1 += __shfl_xor(s1, 32);
            if (g == 0) { RS[w * 32 + c16] = s0; RS[w * 32 + 16 + c16] = s1; }
        }
        __syncthreads();
        if (OUT) {
            float t0 = 0.f, t1 = 0.f;
#pragma unroll
            for (int ww = 0; ww < 8; ++ww) { t0 += RS[ww * 32 + c16]; t1 += RS[ww * 32 + 16 + c16]; }
            const float i0 = 1.0f / sqrtf(t0 * (1.f / 128) + RMS_EPS), i1 = 1.0f / sqrtf(t1 * (1.f / 128) + RMS_EPS);
            const f32x4 gn = *(const f32x4*)(F.hgn + v0 + 4 * g);
            const size_t o0 = (row0 + c16) * 512 + h * 128 + v0 + 4 * g, o1 = o0 + (size_t)16 * 512;
            const u32x2 h0 = *(const u32x2*)(HG + o0), h1 = *(const u32x2*)(HG + o1);
            u32x2 r0, r1;
            r0.x = cvtpk(O0[0] * i0 * gn[0] * bflo(h0.x), O0[1] * i0 * gn[1] * bfhi(h0.x)); r0.y = cvtpk(O0[2] * i0 * gn[2] * bflo(h0.y), O0[3] * i0 * gn[3] * bfhi(h0.y));
            r1.x = cvtpk(O1[0] * i1 * gn[0] * bflo(h1.x), O1[1] * i1 * gn[1] * bfhi(h1.x)); r1.y = cvtpk(O1[2] * i1 * gn[2] * bflo(h1.y), O1[3] * i1 * gn[3] * bfhi(h1.y));
            *(u32x2*)(OH + o0) = r0; *(u32x2*)(OH + o1) = r1;
        }
    }
    if (!OUT) {
#pragma unroll
        for (int m = 0; m < 8; ++m)
#pragma unroll
            for (int r = 0; r < 4; ++r) SLOT[(size_t)(16 * m + 4 * g + r) * 128 + v0 + c16] = T[m][r];
        if (tq == 0) WSP(float, WS_DSEG)[(size_t)seg * 512 + h * 128 + d] = __expf(segtot);
    }
    __syncthreads();
}
#undef HG_MFMA
__device__ __forceinline__ void hgrn_scan(Frame& F) {
    const int e = blockIdx.x * NTHR + F.tid; if (e >= 16384) return;
    f32x4* SL4 = WSP(f32x4, WS_SL); f32x4* SS4 = WSP(f32x4, WS_SS); const float* DS = WSP(float, WS_DSEG); const int hd = e >> 5;
    f32x4 R = {0.f, 0.f, 0.f, 0.f};
#pragma unroll 8
    for (int s = 0; s < NSEG; ++s) { const f32x4 tmp = SL4[(size_t)s * 16384 + e]; const float dd = DS[(size_t)s * 512 + hd]; SS4[(size_t)s * 16384 + e] = R; R = R * dd + tmp; }
    ((f32x4*)(F.out + OFF_PH))[e] = R;
}
}
struct Args { const float* in[22]; float* out; unsigned char* ws; int ph_lo, ph_hi, li, pad; };
constexpr int NPHASE = 15;
__global__ void __launch_bounds__(NTHR, 2) skel_fwd(Args args) {
    extern __shared__ __attribute__((aligned(16))) unsigned char lds[];
    Frame F;
    F.lds = (LAS unsigned char*)lds; F.MISC = (volatile LAS unsigned*)(F.lds + MISC_OFF);
    F.tid = threadIdx.x; F.lane = F.tid & 63; F.wave = __builtin_amdgcn_readfirstlane(F.tid >> 6);
    F.G = gridDim.x; { const int bx = blockIdx.x; F.vcu = (F.G % 8 == 0) ? (bx % 8) * (F.G / 8) + bx / 8 : bx; }
    F.ws = args.ws; F.out = args.out; F.ctl = (gu32*)(args.ws + WS_CTL);
    F.xp = args.in[0]; F.xs = args.in[1]; F.ck = args.in[2]; F.cv = args.in[3]; F.clf = args.in[4]; F.sh = args.in[5]; F.sc = args.in[6]; F.g_pre = args.in[7]; F.g_post = args.in[8];
    F.w_in = args.in[9]; F.fbias = args.in[10]; F.lbl = args.in[11]; F.hgn = args.in[12]; F.w_bf = args.in[13]; F.w_bh = args.in[14]; F.w_out = args.in[15]; F.g_pre2 = args.in[16]; F.g_post2 = args.in[17];
    F.w_up = args.in[18]; F.cw = args.in[19]; F.cb = args.in[20]; F.w_dn = args.in[21];
    for (int u = F.tid; u < (LDS_BYTES - LDSCTL_OFF) / 4; u += NTHR) ((LAS unsigned*)(F.lds + LDSCTL_OFF))[u] = 0u;
    __syncthreads();
    XcdBarrier bar = xcd_barrier_post((unsigned*)(F.ctl + CW_BAR), F.MISC + 8);
    const int lo = args.ph_lo, hi = args.ph_hi;
#define IN(k) (lo <= (k) && (k) < hi)
#define SEAM(k) do { if (IN(k) && IN((k) + 1)) xcd_barrier(bar); } while (0)
    typedef pg8::bf16_t pbf;
    if (IN(0)) p0_prologue(F);
    SEAM(0);
    if (IN(1)) ph_cum(F);
    SEAM(1);
    if (IN(2)) {
        pg8::Gemm g{WSP(pbf, WS_H1), WSP(pbf, WS_WIN), MPAD, NINP, DMODEL}; pg8::StaticOrder S; S.init(MPAD, NINP, F.G, (int)blockIdx.x);
        pg8::EpiIn E{WSP(pbf, WS_Q), WSP(pbf, WS_K), WSP(pbf, WS_V), WSP(pbf, WS_HQ), WSP(pbf, WS_KK), WSP(pbf, WS_HI), WSP(pbf, WS_HG), WSP(float, WS_LF),
                     (pbf*)F.out, (pbf*)F.out + (size_t)MP * DMODEL, WSP(pbf, WS_GAS), WSP(pbf, WS_GBS), F.out + OFF_PK, F.out + OFF_PV, F.out + OFF_SK, F.out + OFF_SV, WSP(float, WS_LB), (unsigned*)(F.ctl + CW_KMX)};
        pg8::gemm_phase<pg8::EpiIn, pg8::StaticOrder, true, true>(F.lds + RING_OFF, g, S, E);
    }
    SEAM(2);
    if (IN(3)) { if (blockIdx.x < 256) hg::hgrn_seg<false>(F, blockIdx.x >> 2, blockIdx.x & 3); ph_attn_sample_naive(F); __syncthreads(); ph_attn(F); }
    SEAM(3);
    if (IN(4)) { hg::hgrn_scan(F); ph_hgrn_naive(F); }
    SEAM(4);
    if (IN(5)) { if (blockIdx.x < 256) hg::hgrn_seg<true>(F, blockIdx.x >> 2, blockIdx.x & 3); ph_hgnorm(F); }
    SEAM(5);
    if (IN(6)) { pg8::Gemm g{WSP(pbf, WS_Q), WSP(pbf, WS_WBF), MPAD, DMODEL, 512}; pg8::StaticOrder S; S.init(MPAD, DMODEL, F.G, (int)blockIdx.x); pg8::EpiF32 E{WSP(float, WS_BRF), DMODEL};
                 pg8::gemm_phase<pg8::EpiF32, pg8::StaticOrder, true, true>(F.lds + RING_OFF, g, S, E); }
    SEAM(6);
    if (IN(7)) { pg8::Gemm g{WSP(pbf, WS_OH), WSP(pbf, WS_WBH), MPAD, DMODEL, 512}; pg8::StaticOrder S; S.init(MPAD, DMODEL, F.G, (int)blockIdx.x); pg8::EpiF32 E{WSP(float, WS_BRH), DMODEL};
                 pg8::gemm_phase<pg8::EpiF32, pg8::StaticOrder, true, true>(F.lds + RING_OFF, g, S, E); }
    SEAM(7);
    if (IN(8)) ph_merge(F);
    SEAM(8);
    if (IN(9)) { pg8::Gemm g{WSP(pbf, WS_MERGED), WSP(pbf, WS_WOUT), MPAD, DMODEL, DMODEL}; pg8::StaticOrder S; S.init(MPAD, DMODEL, F.G, (int)blockIdx.x); pg8::EpiF32 E{WSP(float, WS_MIX), DMODEL};
                 pg8::gemm_phase<pg8::EpiF32, pg8::StaticOrder, true, true>(F.lds + RING_OFF, g, S, E); }
    SEAM(9);
    if (IN(10)) ph_norm1(F);
    SEAM(10);
    if (IN(11)) { pg8::Gemm g{WSP(pbf, WS_H2), WSP(pbf, WS_WUP), MPAD, 2 * DFF, DMODEL}; pg8::StaticOrder S; S.init(MPAD, 2 * DFF, F.G, (int)blockIdx.x);
                  pg8::EpiUpSplit E{WSP(pbf, WS_ABUF), WSP(pbf, WS_GBUF), F.out + OFF_PC, F.out + OFF_SC};
                  pg8::gemm_phase<pg8::EpiUpSplit, pg8::StaticOrder, true, true>(F.lds + RING_OFF, g, S, E); }
    SEAM(11);
    if (IN(12)) ph_conv(F);
    SEAM(12);
    if (IN(13)) { pg8::Gemm g{WSP(pbf, WS_GBUF), WSP(pbf, WS_WDN), MPAD, DMODEL, DFF}; pg8::StaticOrder S; S.init(MPAD, DMODEL, F.G, (int)blockIdx.x); pg8::EpiF32 E{WSP(float, WS_FFN), DMODEL};
                  pg8::gemm_phase<pg8::EpiF32, pg8::StaticOrder, true, true>(F.lds + RING_OFF, g, S, E); }
    SEAM(13);
    if (IN(14)) ph_norm2(F);
#undef IN
}

extern "C" void kernel_launch(void* const* d_in, const int* in_sizes, int n_in, void* d_out, int out_size, void* d_ws, size_t ws_size, hipStream_t stream) {
    static int grid = 0;
    if (grid == 0) {
        if (n_in != 22 || out_size != (int)OUT_TOTAL || ws_size < WS_END) { fprintf(stderr, "kernel_launch: unexpected shapes (n_in %d out %d ws %zu)\n", n_in, out_size, ws_size); grid = -1; return; }
        if (hipFuncSetAttribute((const void*)skel_fwd, hipFuncAttributeMaxDynamicSharedMemorySize, LDS_BYTES) != hipSuccess) { fprintf(stderr, "kernel_launch: hipFuncSetAttribute failed\n"); grid = -1; return; }
        grid = 256;
    }
    if (grid < 0) return;
    (void)hipMemsetAsync((char*)d_ws + WS_CTL, 0, CTL_ZERO_BYTES, stream);
    Args a{};
    for (int i = 0; i < 22; ++i) a.in[i] = (const float*)d_in[i];
    a.out = (float*)d_out; a.ws = (unsigned char*)d_ws;
    a.ph_lo = 0; a.ph_hi = NPHASE; a.li = 0; hipLaunchKernelGGL(skel_fwd, dim3(grid), dim3(NTHR), LDS_BYTES, stream, a);
}
```

```cpp
#include <hip/hip_runtime.h>
#include <cstdio>
#include <cstdint>
namespace pg8 {
#define PG8_LAS __attribute__((address_space(3)))
typedef unsigned short bf16_t;
typedef short bf16x8 __attribute__((ext_vector_type(8)));
typedef float f32x4 __attribute__((ext_vector_type(4)));
typedef unsigned u32x4 __attribute__((ext_vector_type(4)));
constexpr int BM = 256, BK = 64, HALF = 128, HTB = HALF * BK * 2  , STAGE_BYTES = 8 * HTB, NXCD = 8, WGM = 8;

__host__ __device__ __forceinline__ int lds_byte(int r, int c) { const int st = (r >> 4) * 2 + (c >> 5), rr = r & 15, cc = c & 31, ob = rr * 64 + cc * 2; return st * 1024 + (ob ^ (((ob >> 9) & 1) << 5)); }
__host__ __device__ __forceinline__ void stage_rc(int b, int& R, int& C) { const int st = b / 1024, sb = b % 1024, swz = sb ^ (((sb >> 9) & 1) << 5); R = (st >> 1) * 16 + swz / 64; C = (st & 1) * 32 + (swz % 64) / 2; }
__host__ __device__ __forceinline__ int perm32(int rho) { const int n = rho >> 4, i = rho & 15; return 8 * (i >> 2) + 4 * n + (i & 3); }

struct Unit { int pm, pn; };
struct Gemm { const bf16_t* A; const bf16_t* Bt; int M, N, K; };

struct StaticOrder {
    int nM, nN, nwg, G, c;
    __host__ __device__ void init(int M, int N, int G_, int c_) { nM = M / BM; nN = N / BM; nwg = nM * nN; G = G_; c = c_; }
    __host__ __device__ bool next(int i, Unit& u) const {
        const long L = (long)i * G + c; if (L >= nwg) return false;
        int wgid = (int)L; { const int q = nwg / NXCD, r = nwg % NXCD, xcd = wgid % NXCD, off = wgid / NXCD; wgid = (xcd < r ? xcd * (q + 1) : r * (q + 1) + (xcd - r) * q) + off; }
        const int nig = WGM * nN, gid = wgid / nig, fm = gid * WGM, gsz = (nM - fm) < WGM ? (nM - fm) : WGM;
        u.pm = fm + ((wgid % nig) % gsz); u.pn = (wgid % nig) / gsz; return true;
    }
    __device__ __forceinline__ void a_ready(const Unit&) const {}
    __device__ __forceinline__ void done(const Unit&) const {}
};

__device__ __forceinline__ unsigned cvt_pk_bf16(float lo, float hi) { unsigned r; asm volatile("v_cvt_pk_bf16_f32 %0, %1, %2" : "=v"(r) : "v"(lo), "v"(hi)); return r; }
typedef float f32x2 __attribute__((ext_vector_type(2)));
__device__ __forceinline__ f32x2 gelu_pk(f32x2 v) {
    const f32x2 av = __builtin_elementwise_abs(v), d = av * 0.2316418882f + 1.0f;
    f32x2 t; t.x = __builtin_amdgcn_rcpf(d.x); t.y = __builtin_amdgcn_rcpf(d.y);
    f32x2 q = t * 0.5307027145f + (-0.7265760135f); q = q * t + 0.7107068705f; q = q * t + (-0.142248368f); q = q * t + 0.127414796f; q = q * t;
    const f32x2 s = (v * v) * (-0.72134752044f);
    f32x2 e; e.x = __builtin_amdgcn_exp2f(s.x); e.y = __builtin_amdgcn_exp2f(s.y);
    const f32x2 m = v * (q * e), r = v - m;
    f32x2 o; o.x = v.x < 0.f ? m.x : r.x; o.y = v.y < 0.f ? m.y : r.y; return o;
}

template <int ACT  > struct EpiBf16 {
    static constexpr bool PERM = true, AFTER_DRAIN = false; static_assert(ACT == 0 || ACT == 1, "EpiBf16: ACT is 0 (none) or 1 (gelu_pk)");
    bf16_t* O; int ldc; const float* bias; int split_cols; size_t split_stride; float scale0;
    __device__ __forceinline__ void operator()(const f32x4 (&acc)[2][2][4][2], const Unit& u, int wr, int wc, int fr, int fq) const {
        const int row0 = u.pm * BM + wr * 64 + fr; int colt = u.pn * BM; bf16_t* base = O;
        float sc = 1.f; if (split_cols) { const int t = colt / split_cols; base += (size_t)t * split_stride; colt -= t * split_cols; if (t == 0) sc = scale0; }
        const int col0 = colt + wc * 32 + 8 * fq, bcol0 = u.pn * BM + wc * 32 + 8 * fq;
        f32x4 bv[2][2];
#pragma unroll
        for (int bj = 0; bj < 2; ++bj)
#pragma unroll
            for (int n = 0; n < 2; ++n) bv[bj][n] = bias ? *(const f32x4*)(bias + bcol0 + bj * HALF + 4 * n) : (f32x4){0.f, 0.f, 0.f, 0.f};
#pragma unroll
        for (int ai = 0; ai < 2; ++ai)
#pragma unroll
            for (int m = 0; m < 4; ++m) { bf16_t* rowp = base + (size_t)(row0 + ai * HALF + m * 16) * ldc + col0;
#pragma unroll
                for (int bj = 0; bj < 2; ++bj) { f32x4 v0 = acc[ai][bj][m][0] + bv[bj][0], v1 = acc[ai][bj][m][1] + bv[bj][1];
                    if (ACT == 1) { f32x2 a = gelu_pk((f32x2){v0[0], v0[1]}), b = gelu_pk((f32x2){v0[2], v0[3]}), c = gelu_pk((f32x2){v1[0], v1[1]}), d = gelu_pk((f32x2){v1[2], v1[3]});
                        v0 = (f32x4){a.x, a.y, b.x, b.y}; v1 = (f32x4){c.x, c.y, d.x, d.y}; }
                    v0 = v0 * sc; v1 = v1 * sc; u32x4 w; w.x = cvt_pk_bf16(v0[0], v0[1]); w.y = cvt_pk_bf16(v0[2], v0[3]); w.z = cvt_pk_bf16(v1[0], v1[1]); w.w = cvt_pk_bf16(v1[2], v1[3]);
                    *(u32x4*)(rowp + bj * HALF) = w; } }
    }
};

struct PanelStats {
    unsigned* xbuf;
    unsigned* cnt;
    unsigned* tmo;
    int ntn; float eps;
    unsigned code;
    __device__ __forceinline__ bool run(const f32x4 (&v)[2][2][4][2], const Unit& u, int wr, int wc, int fr, int fq, PG8_LAS unsigned char* lds, int wid, int lane) const {
        typedef float f32x2v __attribute__((ext_vector_type(2)));
        PG8_LAS f32x2v* P = (PG8_LAS f32x2v*)lds;
        PG8_LAS f32x2v* S = (PG8_LAS f32x2v*)(lds + 8192);
        PG8_LAS unsigned* flag = (PG8_LAS unsigned*)(lds + 8192 + 2048);
#pragma unroll
        for (int ai = 0; ai < 2; ++ai)
#pragma unroll
            for (int m = 0; m < 4; ++m) {
                float s = 0.f;
#pragma unroll
                for (int bj = 0; bj < 2; ++bj)
#pragma unroll
                    for (int n = 0; n < 2; ++n) { const f32x4 x = v[ai][bj][m][n]; s += (x[0] + x[1]) + (x[2] + x[3]); }
                s += __shfl_xor(s, 16); s += __shfl_xor(s, 32);
                const float mw = s * (1.0f / 64.0f); float q = 0.f;
#pragma unroll
                for (int bj = 0; bj < 2; ++bj)
#pragma unroll
                    for (int n = 0; n < 2; ++n) { const f32x4 d = v[ai][bj][m][n] - mw; q += (d[0] * d[0] + d[1] * d[1]) + (d[2] * d[2] + d[3] * d[3]); }
                q += __shfl_xor(q, 16); q += __shfl_xor(q, 32);
                if (fq == 0) P[(ai * HALF + wr * 64 + m * 16 + fr) * 4 + wc] = (f32x2v){mw, q};
            }
        asm volatile("s_waitcnt lgkmcnt(0)" ::: "memory"); __builtin_amdgcn_s_barrier(); asm volatile("" ::: "memory");
#if defined(BROKEN_EXCHANGE_NO_WAIT)
#warning BROKEN CONTROL BUILD: the row-statistics exchange does not wait; results are wrong by design
        if (blockIdx.x >= 64) { const long long t0_ = clock64(); while (clock64() - t0_ < 60000) __builtin_amdgcn_s_sleep(8); }
#endif
        const int row = wid * 32 + (lane & 31);
        if (lane < 32) {
            const f32x2v a = P[row * 4 + 0], b = P[row * 4 + 1], c = P[row * 4 + 2], d = P[row * 4 + 3];
            const float mt = (a.x + b.x + c.x + d.x) * 0.25f;
            const float da = a.x - mt, db = b.x - mt, dc = c.x - mt, dd = d.x - mt;
            const float m2 = (a.y + b.y) + (c.y + d.y) + 64.0f * ((da * da + db * db) + (dc * dc + dd * dd));
            unsigned long long* slot = (unsigned long long*)xbuf + ((size_t)(u.pm * BM + row) * 4 + u.pn);
            __hip_atomic_store(slot, ((unsigned long long)__float_as_uint(m2) << 32) | __float_as_uint(mt), __ATOMIC_RELAXED, __HIP_MEMORY_SCOPE_AGENT);
        }
        asm volatile("s_waitcnt vmcnt(0)" ::: "memory");
        if (lane == 0) __hip_atomic_fetch_add(cnt + 64 * u.pm, 1u, __ATOMIC_RELAXED, __HIP_MEMORY_SCOPE_AGENT);
        if (wid == 0) {
            bool dead = false; const unsigned long long t0 = __builtin_amdgcn_s_memrealtime(); const unsigned want = 8u * (unsigned)ntn;
            for (;;) {
#if defined(BROKEN_EXCHANGE_NO_WAIT)
                break;
#endif
                if ((unsigned)__builtin_amdgcn_readfirstlane(__hip_atomic_load(cnt + 64 * u.pm, __ATOMIC_RELAXED, __HIP_MEMORY_SCOPE_AGENT)) >= want) break;
                if (__builtin_amdgcn_s_memrealtime() - t0 > 2000000ull) {
                    if (lane == 0) { unsigned expect = 0u; __hip_atomic_compare_exchange_strong(tmo + 1, &expect, code | (unsigned)(u.pm & 0xff), __ATOMIC_RELAXED, __ATOMIC_RELAXED, __HIP_MEMORY_SCOPE_AGENT);
                                     __hip_atomic_store(tmo, 1u, __ATOMIC_RELAXED, __HIP_MEMORY_SCOPE_AGENT); }
                    dead = true; break; }
                __builtin_amdgcn_s_sleep(2);
            }
            __builtin_amdgcn_fence(__ATOMIC_ACQUIRE, "agent");
            if (lane == 0) flag[0] = dead ? 1u : 0u;
        }
        asm volatile("s_waitcnt vmcnt(0) lgkmcnt(0)" ::: "memory"); __builtin_amdgcn_s_barrier(); asm volatile("" ::: "memory");
        const bool bad = flag[0] != 0u;
        if (lane < 32) {
            const unsigned long long* slot = (const unsigned long long*)xbuf + (size_t)(u.pm * BM + row) * 4; float mt[4], m2[4]; float ms = 0.f;
#pragma unroll
            for (int t = 0; t < 4; ++t) { if (t < ntn) { const unsigned long long w = __hip_atomic_load(slot + t, __ATOMIC_RELAXED, __HIP_MEMORY_SCOPE_AGENT); mt[t] = __uint_as_float((unsigned)w); m2[t] = __uint_as_float((unsigned)(w >> 32)); } else { mt[t] = 0.f; m2[t] = 0.f; } ms += mt[t]; }
            const float mean = ms / (float)ntn; float q = 0.f;
#pragma unroll
            for (int t = 0; t < 4; ++t) if (t < ntn) { const float dm = mt[t] - mean; q += m2[t] + 256.0f * dm * dm; }
            S[row] = (f32x2v){mean, 1.0f / sqrtf(q / (256.0f * (float)ntn) + eps)};
        }
        asm volatile("s_waitcnt lgkmcnt(0)" ::: "memory"); __builtin_amdgcn_s_barrier(); asm volatile("" ::: "memory");
        return bad;
    }
};
struct EpiLnRes {
    static constexpr bool PERM = false, AFTER_DRAIN = true;
    const float* base; float* out; int ldc; const float* bias; PanelStats st; unsigned poison;
    __device__ __forceinline__ void fused(f32x4 (&acc)[2][2][4][2], const Unit& u, int wr, int wc, int fr, int fq, PG8_LAS unsigned char* lds, int wid, int lane) const {
        typedef float f32x2v __attribute__((ext_vector_type(2)));
        const PG8_LAS f32x2v* S = (const PG8_LAS f32x2v*)(lds + 8192);
        const int col0 = u.pn * BM + wc * 32 + 4 * fq;
#pragma unroll
        for (int bj = 0; bj < 2; ++bj)
#pragma unroll
            for (int n = 0; n < 2; ++n) { const f32x4 bv = bias ? *(const f32x4*)(bias + col0 + bj * HALF + n * 16) : (f32x4){0.f, 0.f, 0.f, 0.f};
#pragma unroll
                for (int ai = 0; ai < 2; ++ai)
#pragma unroll
                    for (int m = 0; m < 4; ++m) acc[ai][bj][m][n] += bv; }
        f32x4 pre[4][2][2];
#pragma unroll
        for (int m = 0; m < 4; ++m) { const size_t off = (size_t)(u.pm * BM + wr * 64 + m * 16 + fr) * ldc + col0;
#pragma unroll
            for (int bj = 0; bj < 2; ++bj)
#pragma unroll
                for (int n = 0; n < 2; ++n) pre[m][bj][n] = *(const f32x4*)(base + off + bj * HALF + n * 16); }
        const bool bad = st.run(acc, u, wr, wc, fr, fq, lds, wid, lane) || poison != 0u;
        const float qnan = __builtin_nanf("");
#pragma unroll
        for (int ai = 0; ai < 2; ++ai)
#pragma unroll
            for (int m = 0; m < 4; ++m) { const int r = ai * HALF + wr * 64 + m * 16 + fr; const f32x2v sr = S[r]; const size_t off = (size_t)(u.pm * BM + r) * ldc + col0;
#pragma unroll
                for (int bj = 0; bj < 2; ++bj)
#pragma unroll
                    for (int n = 0; n < 2; ++n) { const f32x4 bs = ai == 0 ? pre[m][bj][n] : *(const f32x4*)(base + off + bj * HALF + n * 16); f32x4 o = bs + (acc[ai][bj][m][n] - sr.x) * sr.y;
                        if (bad) o = (f32x4){qnan, qnan, qnan, qnan}; *(f32x4*)(out + off + bj * HALF + n * 16) = o; }
                if (m & 1) asm volatile("" ::: "memory"); }
    }
};
struct EpiLnResLn {
    static constexpr bool PERM = false, AFTER_DRAIN = true;
    const float* base; float* out; bf16_t* xn; int ldc; const float* bias; PanelStats st1, st2; unsigned poison;
    __device__ __forceinline__ void fused(f32x4 (&acc)[2][2][4][2], const Unit& u, int wr, int wc, int fr, int fq, PG8_LAS unsigned char* lds, int wid, int lane) const {
        typedef float f32x2v __attribute__((ext_vector_type(2))); typedef unsigned u32x2v __attribute__((ext_vector_type(2)));
        const PG8_LAS f32x2v* S = (const PG8_LAS f32x2v*)(lds + 8192);
        const int col0 = u.pn * BM + wc * 32 + 4 * fq;
#pragma unroll
        for (int bj = 0; bj < 2; ++bj)
#pragma unroll
            for (int n = 0; n < 2; ++n) { const f32x4 bv = bias ? *(const f32x4*)(bias + col0 + bj * HALF + n * 16) : (f32x4){0.f, 0.f, 0.f, 0.f};
#pragma unroll
                for (int ai = 0; ai < 2; ++ai)
#pragma unroll
                    for (int m = 0; m < 4; ++m) acc[ai][bj][m][n] += bv; }
        bool bad = st1.run(acc, u, wr, wc, fr, fq, lds, wid, lane) || poison != 0u;
        const float qnan = __builtin_nanf("");
#pragma unroll
        for (int ai = 0; ai < 2; ++ai)
#pragma unroll
            for (int m = 0; m < 4; ++m) { const int r = ai * HALF + wr * 64 + m * 16 + fr; const f32x2v sr = S[r]; const size_t off = (size_t)(u.pm * BM + r) * ldc + col0;
#pragma unroll
                for (int bj = 0; bj < 2; ++bj)
#pragma unroll
                    for (int n = 0; n < 2; ++n) { const f32x4 bs = *(const f32x4*)(base + off + bj * HALF + n * 16); acc[ai][bj][m][n] = bs + (acc[ai][bj][m][n] - sr.x) * sr.y; }
                asm volatile("" : "+v"(acc[ai][0][m][0]), "+v"(acc[ai][0][m][1]), "+v"(acc[ai][1][m][0]), "+v"(acc[ai][1][m][1]));
                if (m & 1) asm volatile("" ::: "memory"); }
        const bool bad1 = bad;
        bad = st2.run(acc, u, wr, wc, fr, fq, lds, wid, lane) || bad;
#pragma unroll
        for (int ai = 0; ai < 2; ++ai)
#pragma unroll
            for (int m = 0; m < 4; ++m) { const int r = ai * HALF + wr * 64 + m * 16 + fr; const f32x2v sr = S[r]; const size_t off = (size_t)(u.pm * BM + r) * ldc + col0;
#pragma unroll
                for (int bj = 0; bj < 2; ++bj)
#pragma unroll
                    for (int n = 0; n < 2; ++n) { const f32x4 x1 = acc[ai][bj][m][n]; *(f32x4*)(out + off + bj * HALF + n * 16) = bad1 ? (f32x4){qnan, qnan, qnan, qnan} : x1;
                        const f32x4 o = (x1 - sr.x) * sr.y; u32x2v w; w.x = cvt_pk_bf16(o[0], o[1]); w.y = cvt_pk_bf16(o[2], o[3]);
                        if (bad) { w.x = 0x7fc07fc0u; w.y = 0x7fc07fc0u; } *(u32x2v*)(xn + off + bj * HALF + n * 16) = w; }
                asm volatile("" ::: "memory"); }
    }
};

template <class Epi, class Sched, bool ALIGN_EPI = false, bool SP2 = false>
__device__ __forceinline__ void gemm_phase(PG8_LAS unsigned char* lds, const Gemm g, const Sched& S, const Epi& E) {
    const int tid = threadIdx.x, wid = __builtin_amdgcn_readfirstlane(tid >> 6), lane = tid & 63, wr = wid >> 2, wc = wid & 3, fr = lane & 15, fq = lane >> 4;
    const int K = g.K, nt = K / BK;
    unsigned voffA[2], voffB[2];
#pragma unroll
    for (int i = 0; i < 2; ++i) { int R, C; stage_rc(tid * 16 + i * 8192, R, C); const int Rb = Epi::PERM ? ((R & ~31) + perm32(R & 31)) : R;
        voffA[i] = (unsigned)(R * K + C) * 2u; voffB[i] = (unsigned)(Rb * K + C) * 2u; }
    const size_t kstep = (size_t)(BK * 2);
    const size_t hstep = (size_t)HALF * K * 2;
    const size_t tstep = 2 * hstep;
    const unsigned ldsw = (unsigned)wid * 1024u;
    const int aoff = lds_byte(wr * 64 + fr, fq * 8), boff = lds_byte(wc * 32 + fr, fq * 8);
#define PG8_SA(b, h) (((b) * 2 + (h)) * HTB)
#define PG8_SB(b, h) ((4 + (b) * 2 + (h)) * HTB)
#define PG8_STAGE(bufoff, gbase, voff) do { _Pragma("unroll") for (int _i = 0; _i < 2; ++_i) \
        __builtin_amdgcn_global_load_lds((const unsigned*)((const char*)(gbase) + (voff)[_i]), (PG8_LAS unsigned*)(lds + (bufoff) + ldsw + _i * 8192), 16, 0, 0); } while (0)
#define PG8_LDA(dst, b, h) do { _Pragma("unroll") for (int m = 0; m < 4; ++m) _Pragma("unroll") for (int k = 0; k < 2; ++k) dst[m][k] = *(const PG8_LAS bf16x8*)(lds + PG8_SA(b, h) + aoff + m * 2048 + k * 1024); } while (0)
#define PG8_LDB(dst, b, h) do { _Pragma("unroll") for (int n = 0; n < 2; ++n) _Pragma("unroll") for (int k = 0; k < 2; ++k) dst[n][k] = *(const PG8_LAS bf16x8*)(lds + PG8_SB(b, h) + boff + n * 2048 + k * 1024); } while (0)
#define PG8_MMA(ai, bj, At, Bt) do { __builtin_amdgcn_s_setprio(1); _Pragma("unroll") for (int m = 0; m < 4; ++m) _Pragma("unroll") for (int n = 0; n < 2; ++n) _Pragma("unroll") for (int k = 0; k < 2; ++k) \
        acc[ai][bj][m][n] = __builtin_amdgcn_mfma_f32_16x16x32_bf16(Bt[n][k], At[m][k], acc[ai][bj][m][n], 0, 0, 0); __builtin_amdgcn_s_setprio(0); } while (0)
#define PG8_WAIT_V(n) asm volatile("s_waitcnt vmcnt(" #n ")" ::: "memory")
#define PG8_WAIT_L(n) asm volatile("s_waitcnt lgkmcnt(" #n ")" ::: "memory")
#define PG8_BAR __builtin_amdgcn_s_barrier()
#define PG8_SCHED __builtin_amdgcn_sched_barrier(0)
    Unit cur, nxt; int ui = 0;
    if (!S.next(0, cur)) return;
    f32x4 acc[2][2][4][2];
#pragma unroll
    for (int a = 0; a < 2; ++a)
#pragma unroll
        for (int b = 0; b < 2; ++b)
#pragma unroll
            for (int m = 0; m < 4; ++m)
#pragma unroll
                for (int n = 0; n < 2; ++n) acc[a][b][m][n] = (f32x4){0.f, 0.f, 0.f, 0.f};
    bf16x8 At[4][2], B0[2][2], B1[2][2];
    const char* cA = (const char*)g.A + (size_t)cur.pm * tstep; const char* cB = (const char*)g.Bt + (size_t)cur.pn * tstep;
    S.a_ready(cur);
    if constexpr (SP2) {
        PG8_STAGE(PG8_SB(0, 0), cB, voffB); PG8_STAGE(PG8_SB(0, 1), cB + hstep, voffB); PG8_STAGE(PG8_SA(0, 0), cA, voffA); PG8_STAGE(PG8_SA(0, 1), cA + hstep, voffA);
        if (wr == 1) PG8_BAR;
        PG8_WAIT_V(2); PG8_BAR;
        PG8_STAGE(PG8_SB(1, 0), cB + kstep, voffB); PG8_STAGE(PG8_SA(1, 0), cA + kstep, voffA); PG8_STAGE(PG8_SB(1, 1), cB + hstep + kstep, voffB);
        PG8_WAIT_V(6); PG8_BAR;
    } else {
        PG8_STAGE(PG8_SB(0, 0), cB, voffB); PG8_STAGE(PG8_SA(0, 0), cA, voffA); PG8_STAGE(PG8_SB(0, 1), cB + hstep, voffB); PG8_STAGE(PG8_SA(0, 1), cA + hstep, voffA);
        if (wr == 1) PG8_BAR;
        PG8_WAIT_V(4); PG8_BAR;
        PG8_STAGE(PG8_SB(1, 0), cB + kstep, voffB); PG8_STAGE(PG8_SA(1, 0), cA + kstep, voffA); PG8_STAGE(PG8_SB(1, 1), cB + hstep + kstep, voffB);
        PG8_WAIT_V(6); PG8_BAR;
    }
    for (;;) {
        const bool has_next = S.next(ui + 1, nxt);
        const char* nA = has_next ? (const char*)g.A + (size_t)nxt.pm * tstep : cA; const char* nB = has_next ? (const char*)g.Bt + (size_t)nxt.pn * tstep : cB;
        for (int t = 0; t < nt; t += 2) {
            const bool last = (t == nt - 2);
            const char* a1 = cA + (size_t)(t + 1) * kstep;
            const char* a2 = last ? nA : cA + (size_t)(t + 2) * kstep; const char* b2 = last ? nB : cB + (size_t)(t + 2) * kstep;
            const char* a3 = a2 + kstep; const char* b3 = b2 + kstep;
            if (last && has_next) S.a_ready(nxt);
            if constexpr (SP2) {
            PG8_LDB(B0, 0, 0); PG8_LDB(B1, 0, 1); PG8_SCHED; PG8_LDA(At, 0, 0); PG8_STAGE(PG8_SA(1, 1), a1 + hstep, voffA);
            PG8_WAIT_V(8); PG8_WAIT_L(0); PG8_BAR; PG8_MMA(0, 0, At, B0); PG8_MMA(0, 1, At, B1); PG8_BAR; PG8_SCHED;
            PG8_LDA(At, 0, 1); PG8_STAGE(PG8_SB(0, 0), b2, voffB); PG8_STAGE(PG8_SB(0, 1), b2 + hstep, voffB); PG8_STAGE(PG8_SA(0, 0), a2, voffA);
            PG8_WAIT_V(8); PG8_WAIT_L(0); PG8_BAR; PG8_MMA(1, 0, At, B0); PG8_MMA(1, 1, At, B1); PG8_BAR; PG8_SCHED;
            PG8_LDB(B0, 1, 0); PG8_LDB(B1, 1, 1); PG8_SCHED; PG8_LDA(At, 1, 0); PG8_STAGE(PG8_SA(0, 1), a2 + hstep, voffA);
            PG8_WAIT_V(8); PG8_WAIT_L(0); PG8_BAR; PG8_MMA(0, 0, At, B0); PG8_MMA(0, 1, At, B1); PG8_BAR; PG8_SCHED;
            PG8_LDA(At, 1, 1); PG8_STAGE(PG8_SB(1, 0), b3, voffB); PG8_STAGE(PG8_SB(1, 1), b3 + hstep, voffB); PG8_STAGE(PG8_SA(1, 0), a3, voffA);
            PG8_WAIT_V(8); PG8_WAIT_L(0); PG8_BAR; PG8_MMA(1, 0, At, B0); PG8_MMA(1, 1, At, B1); PG8_BAR; PG8_SCHED;
            } else {
            PG8_LDB(B0, 0, 0); PG8_SCHED; PG8_LDA(At, 0, 0); PG8_STAGE(PG8_SA(1, 1), a1 + hstep, voffA);
            PG8_WAIT_L(8); PG8_BAR; PG8_WAIT_L(0); PG8_MMA(0, 0, At, B0); PG8_BAR; PG8_SCHED;
            PG8_LDB(B1, 0, 1); PG8_STAGE(PG8_SB(0, 0), b2, voffB);
            PG8_BAR; PG8_WAIT_L(0); PG8_MMA(0, 1, At, B1); PG8_BAR;
            PG8_LDA(At, 0, 1); PG8_STAGE(PG8_SA(0, 0), a2, voffA);
            PG8_BAR; PG8_WAIT_L(0); PG8_MMA(1, 0, At, B0); PG8_BAR; PG8_SCHED;
            PG8_STAGE(PG8_SB(0, 1), b2 + hstep, voffB);
            PG8_WAIT_V(6); PG8_BAR; PG8_MMA(1, 1, At, B1); PG8_BAR;
            PG8_LDB(B0, 1, 0); PG8_SCHED; PG8_LDA(At, 1, 0); PG8_STAGE(PG8_SA(0, 1), a2 + hstep, voffA);
            PG8_WAIT_L(8); PG8_BAR; PG8_WAIT_L(0); PG8_MMA(0, 0, At, B0); PG8_BAR; PG8_SCHED;
            PG8_LDB(B1, 1, 1); PG8_STAGE(PG8_SB(1, 0), b3, voffB);
            PG8_BAR; PG8_WAIT_L(0); PG8_MMA(0, 1, At, B1); PG8_BAR;
            PG8_LDA(At, 1, 1); PG8_STAGE(PG8_SA(1, 0), a3, voffA);
            PG8_BAR; PG8_WAIT_L(0); PG8_MMA(1, 0, At, B0); PG8_BAR; PG8_SCHED;
            PG8_STAGE(PG8_SB(1, 1), b3 + hstep, voffB);
            PG8_WAIT_V(6); PG8_BAR; PG8_MMA(1, 1, At, B1); PG8_BAR;
            }
        }
        if constexpr (ALIGN_EPI) { if (wr == 0) PG8_BAR; }
        if constexpr (!Epi::AFTER_DRAIN) { E(acc, cur, wr, wc, fr, fq); S.done(cur); }
        if (!has_next) break;
#pragma unroll
        for (int a = 0; a < 2; ++a)
#pragma unroll
            for (int b = 0; b < 2; ++b)
#pragma unroll
                for (int m = 0; m < 4; ++m)
#pragma unroll
                    for (int n = 0; n < 2; ++n) acc[a][b][m][n] = (f32x4){0.f, 0.f, 0.f, 0.f};
        cur = nxt; cA = nA; cB = nB; ++ui;
        if constexpr (ALIGN_EPI) { if (wr == 1) PG8_BAR; }
    }
    PG8_WAIT_V(0);
    if constexpr (!ALIGN_EPI) { if (wr == 0) PG8_BAR; }
    PG8_BAR;
    if constexpr (Epi::AFTER_DRAIN) { E.fused(acc, cur, wr, wc, fr, fq, lds, wid, lane); S.done(cur); }
#undef PG8_SA
#undef PG8_SB
#undef PG8_STAGE
#undef PG8_LDA
#undef PG8_LDB
#undef PG8_MMA
#undef PG8_WAIT_V
#undef PG8_WAIT_L
#undef PG8_BAR
#undef PG8_SCHED
}
}

namespace pg8 {
__device__ __forceinline__ float sigm(float x) { return 1.0f / (1.0f + __expf(-x)); }
typedef __bf16 bf16x2_v __attribute__((ext_vector_type(2)));
__device__ __forceinline__ unsigned cvtpk_v(float lo, float hi) { const f32x2 v = {lo, hi}; return __builtin_bit_cast(unsigned, __builtin_convertvector(v, bf16x2_v)); }
__device__ __forceinline__ u32x4 pack8(const f32x4 a, const f32x4 b) { u32x4 w; w.x = cvtpk_v(a[0], a[1]); w.y = cvtpk_v(a[2], a[3]); w.z = cvtpk_v(b[0], b[1]); w.w = cvtpk_v(b[2], b[3]); return w; }

struct EpiF32 {
    static constexpr bool PERM = false, AFTER_DRAIN = false;
    float* C; int ldc;
    __device__ __forceinline__ void operator()(const f32x4 (&acc)[2][2][4][2], const Unit& u, int wr, int wc, int fr, int fq) const {
        const int row0 = u.pm * BM + wr * 64 + fr, col0 = u.pn * BM + wc * 32 + 4 * fq;
#pragma unroll
        for (int ai = 0; ai < 2; ++ai)
#pragma unroll
            for (int m = 0; m < 4; ++m) { float* rowp = C + (size_t)(row0 + ai * HALF + m * 16) * ldc + col0;
#pragma unroll
                for (int bj = 0; bj < 2; ++bj)
#pragma unroll
                    for (int n = 0; n < 2; ++n) *(f32x4*)(rowp + bj * HALF + n * 16) = acc[ai][bj][m][n]; }
    }
};

constexpr int MPROMPT = 16384; constexpr float QSCALE = 0.125f * 1.4426950408889634f;
struct EpiIn {
    static constexpr bool PERM = true, AFTER_DRAIN = false;
    bf16_t *Q, *K, *V, *HQ, *KK, *HI, *HG; float* LF; bf16_t *GA, *GB, *GAs, *GBs; float *okp, *ovp, *oks, *ovs; const float* lb; unsigned* mx;
    template <int TYPE> __device__ __forceinline__ void tile(const f32x4 (&acc)[2][2][4][2], const Unit& u, int ct, int wr, int wc, int fr, int fq) const {
        const bool samp = (u.pm == MPROMPT / BM);
        const int colb = ct * BM + wc * 32 + 8 * fq;
        float mxs[2] = {0.f, 0.f};
        f32x4 lbv[2][2];
        if (TYPE == 4) {
#pragma unroll
            for (int bj = 0; bj < 2; ++bj) { lbv[bj][0] = *(const f32x4*)(lb + colb + bj * HALF); lbv[bj][1] = *(const f32x4*)(lb + colb + bj * HALF + 4); }
        }
#pragma unroll
        for (int ai = 0; ai < 2; ++ai)
#pragma unroll
            for (int m = 0; m < 4; ++m) {
                const int row = u.pm * BM + ai * HALF + wr * 64 + m * 16 + fr; const int lrow = row - MPROMPT;
#pragma unroll
                for (int bj = 0; bj < 2; ++bj) {
                    const int col = colb + bj * HALF; f32x4 v0 = acc[ai][bj][m][0], v1 = acc[ai][bj][m][1];
                    if (TYPE <= 1 && !samp) { const float sc = TYPE == 0 ? QSCALE : 1.0f; const f32x4 a = v0 * sc, b = v1 * sc;
                        float s = (a[0] * a[0] + a[1] * a[1]) + (a[2] * a[2] + a[3] * a[3]) + (b[0] * b[0] + b[1] * b[1]) + (b[2] * b[2] + b[3] * b[3]);
                        s += __shfl_xor(s, 16); s += __shfl_xor(s, 32); mxs[bj] = fmaxf(mxs[bj], s); }
                    if (TYPE == 0) { *(u32x4*)(Q + (size_t)row * 512 + col) = pack8(v0 * QSCALE, v1 * QSCALE); }
                    else if (TYPE == 1 || TYPE == 2) {
                        bf16_t* B = TYPE == 1 ? K : V; *(u32x4*)(B + (size_t)row * 512 + col) = pack8(v0, v1);
                        float* o = nullptr;
                        if (!samp) o = (TYPE == 1 ? okp : ovp) + (size_t)row * 512 + col; else if (lrow < 128) o = (TYPE == 1 ? oks : ovs) + (size_t)lrow * 512 + col;
                        if (o) { *(f32x4*)o = v0; *(f32x4*)(o + 4) = v1; }
                    }
                    else if (TYPE == 3) { *(u32x4*)(HQ + (size_t)row * 512 + col) = pack8(v0, v1); }
                    else if (TYPE == 4) {
                        f32x4 f0, f1, l0, l1;
#pragma unroll
                        for (int j = 0; j < 4; ++j) { const float a = lbv[bj][0][j], b = lbv[bj][1][j];
                            f0[j] = a + (1.0f - a) * sigm(v0[j]); f1[j] = b + (1.0f - b) * sigm(v1[j]); l0[j] = __logf(f0[j]); l1[j] = __logf(f1[j]); }
                        float* lp = LF + (size_t)row * 512 + col; *(f32x4*)lp = l0; *(f32x4*)(lp + 4) = l1;
                        *(u32x4*)(KK + (size_t)row * 512 + col) = pack8(1.0f - f0, 1.0f - f1);
                    }
                    else if (TYPE == 5) { *(u32x4*)(HI + (size_t)row * 512 + col) = pack8(v0, v1); }
                    else {
                        f32x4 s0, s1;
#pragma unroll
                        for (int j = 0; j < 4; ++j) { s0[j] = sigm(v0[j]); s1[j] = sigm(v1[j]); }
                        if (TYPE == 6) *(u32x4*)(HG + (size_t)row * 512 + col) = pack8(s0, s1);
                        else { bf16_t* G = samp ? ((TYPE == 7 ? GAs : GBs) + (size_t)lrow * 1024) : ((TYPE == 7 ? GA : GB) + (size_t)row * 1024); *(u32x4*)(G + col) = pack8(s0, s1); }
                    }
                }
            }
        if (TYPE <= 1 && !samp) {
#pragma unroll
            for (int bj = 0; bj < 2; ++bj) { float r = mxs[bj]; r = fmaxf(r, __shfl_xor(r, 1)); r = fmaxf(r, __shfl_xor(r, 2)); r = fmaxf(r, __shfl_xor(r, 4)); r = fmaxf(r, __shfl_xor(r, 8));
                const int hd = ct * 4 + 2 * bj + (wc >> 1), half = wc & 1;
                if (fr == 0 && fq == 0) atomicMax(TYPE == 1 ? mx + hd * 2 + half : mx + 128 + (u.pm * 8 + hd) * 2 + half, __float_as_uint(r)); }
        }
    }
    __device__ __forceinline__ void operator()(const f32x4 (&acc)[2][2][4][2], const Unit& u, int wr, int wc, int fr, int fq) const {
        const int pn = u.pn;
        if (pn < 14) { const int ct = pn & 1;
            switch (pn >> 1) { case 0: tile<0>(acc, u, ct, wr, wc, fr, fq); break; case 1: tile<1>(acc, u, ct, wr, wc, fr, fq); break; case 2: tile<2>(acc, u, ct, wr, wc, fr, fq); break;
                               case 3: tile<3>(acc, u, ct, wr, wc, fr, fq); break; case 4: tile<4>(acc, u, ct, wr, wc, fr, fq); break; case 5: tile<5>(acc, u, ct, wr, wc, fr, fq); break;
                               default: tile<6>(acc, u, ct, wr, wc, fr, fq); break; } }
        else if (pn < 18) tile<7>(acc, u, pn - 14, wr, wc, fr, fq);
        else tile<8>(acc, u, pn - 18, wr, wc, fr, fq);
    }
};

constexpr int DFF = 2816;
struct EpiUpSplit {
    static constexpr bool PERM = true, AFTER_DRAIN = false;
    bf16_t *A, *G; float *cp, *cs;
    __device__ __forceinline__ void operator()(const f32x4 (&acc)[2][2][4][2], const Unit& u, int wr, int wc, int fr, int fq) const {
        const int cidx = 128 * u.pn + wc * 32 + 8 * fq;
#pragma unroll
        for (int ai = 0; ai < 2; ++ai)
#pragma unroll
            for (int m = 0; m < 4; ++m) {
                const int row = u.pm * BM + ai * HALF + wr * 64 + m * 16 + fr; const int lrow = row - MPROMPT;
                *(u32x4*)(A + (size_t)row * DFF + cidx) = pack8(acc[ai][0][m][0], acc[ai][0][m][1]);
                *(u32x4*)(G + (size_t)row * DFF + cidx) = pack8(acc[ai][1][m][0], acc[ai][1][m][1]);
                float* o = nullptr;
                if (row == MPROMPT - 2 || row == MPROMPT - 1) o = cp + (size_t)(row - (MPROMPT - 2)) * DFF + cidx;
                else if (lrow >= 0 && lrow < 128 && (lrow & 15) >= 14) o = cs + (size_t)((lrow >> 4) * 2 + ((lrow & 15) - 14)) * DFF + cidx;
                if (o) { *(f32x4*)o = acc[ai][0][m][0]; *(f32x4*)(o + 4) = acc[ai][0][m][1]; }
            }
    }
};
}
#include <hip/hip_bf16.h>
#include <cmath>
namespace attn_body {
using bf16=__hip_bfloat16;
using bf16x8=__attribute__((ext_vector_type(8)))short;
using s16x4=__attribute__((ext_vector_type(4)))short;
using f32x16=__attribute__((ext_vector_type(16)))float;
using u32x4=__attribute__((ext_vector_type(4)))unsigned;
constexpr int BATCH=1,NHEAD=8,SEQ=16384,D=64,DM=NHEAD*D;
constexpr int NW=8,QBLK=32,QB=QBLK*NW,KVBLK=64,NQB=SEQ/QB;
constexpr int ATTN_PITCH=DM, ATTN_UNIT_ROWS=QB;
__device__ __forceinline__ int crow(int r,int hi){return (r&3)+8*(r>>2)+4*hi;}
#define SBAR() __builtin_amdgcn_sched_barrier(0)
__device__ __forceinline__ void cmask(f32x16&p0,f32x16&p1,int jb,int qrel,int hi){
  const float NEG=-INFINITY; int kb=64*jb+4*hi;
  #pragma unroll
  for(int r=0;r<16;++r){int kv=kb+(r&3)+8*(r>>2); if(kv>qrel)p0[r]=NEG; if(kv+32>qrel)p1[r]=NEG;}
}

constexpr int NSLOT=3, SLOTB=8192;
constexpr int LDS_K=0, LDS_V=NSLOT*SLOTB, LDS_WS=2*NSLOT*SLOTB, LDS_OST=LDS_WS+NW*64*4, LDS_KB=LDS_OST+NW*4096, LDS_BYTES=LDS_KB+SEQ*4;
constexpr float C2=0.125f*1.4426950408889634f;
__device__ __forceinline__ void glds16(const void*gsrc,unsigned lds_dst){unsigned keep;
  asm volatile("s_mov_b32 %0, m0\n\ts_mov_b32 m0, %2\n\ts_nop 0\n\tglobal_load_lds_dwordx4 %1, off\n\ts_mov_b32 m0, %0":"=&s"(keep):"v"(gsrc),"s"(lds_dst):"memory");}
__device__ __forceinline__ float max3f(float a,float b,float c){float r;asm("v_max3_f32 %0, %1, %2, %3":"=v"(r):"v"(a),"v"(b),"v"(c));return r;}
__device__ __forceinline__ float max2f(float a,float b){float r;asm("v_max_f32_e32 %0, %1, %2":"=v"(r):"v"(a),"v"(b));return r;}
__device__ __forceinline__ float fadd_s(float a,float b){float r;asm("v_add_f32_e32 %0, %1, %2":"=v"(r):"v"(a),"v"(b));return r;}
__device__ __forceinline__ float fsub_s(float a,float b){float r;asm("v_sub_f32_e32 %0, %1, %2":"=v"(r):"v"(a),"v"(b));return r;}
typedef float f32x2_t __attribute__((ext_vector_type(2))); typedef __bf16 bf16x2_t __attribute__((ext_vector_type(2)));
__device__ __forceinline__ unsigned cvtpk_s(float lo,float hi){f32x2_t v={lo,hi};bf16x2_t b=__builtin_convertvector(v,bf16x2_t);return __builtin_bit_cast(unsigned,b);}
#define WAIT_BAR(N) asm volatile("s_waitcnt vmcnt(" #N ") lgkmcnt(0)\n\ts_barrier":::"memory")

__device__ __forceinline__ void split3(float x,unsigned&h,unsigned&m,unsigned&l){
  h=__float_as_uint(x)&0xffff0000u; const float r1=x-__uint_as_float(h);
  m=__float_as_uint(r1)&0xffff0000u; const float r2=r1-__uint_as_float(m);
  l=__float_as_uint(r2)&0xffff0000u; }
__device__ __forceinline__ bf16x8 mk_kaug(float kb,int hi){ unsigned h,m,l; split3(kb,h,m,l); const unsigned msk=hi?0u:0xffffffffu;
  const u32x4 w={((h>>16)|m)&msk,((l>>16)&msk)|(hi?0u:0x3F800000u),hi?0u:0x3F803F80u,0u}; return __builtin_bit_cast(bf16x8,w); }
__device__ __forceinline__ bf16x8 mk_qaug(float mhat,int hi){ unsigned h,m,l; split3(-mhat,h,m,l); const unsigned msk=hi?0u:0xffffffffu;
  const u32x4 w={hi?0u:0x3F803F80u,(hi?0u:0x00003F80u)|(h&msk),((m>>16)|l)&msk,0u}; return __builtin_bit_cast(bf16x8,w); }
__device__ __forceinline__ void qkt(f32x16&p0,f32x16&p1,const char*Kslot,const bf16x8*qr,bf16x8 ka0,bf16x8 ka1,bf16x8 qa,int r32,int hi){
  p0=__builtin_amdgcn_mfma_f32_32x32x16_bf16(ka0,qa,f32x16{},0,0,0); p1=__builtin_amdgcn_mfma_f32_32x32x16_bf16(ka1,qa,f32x16{},0,0,0);
  const char*kb=Kslot+hi*1024+r32*16;
  #pragma unroll
  for(int d0=0;d0<4;++d0){
    const bf16x8 b0=*reinterpret_cast<const bf16x8*>(kb+d0*2048);
    const bf16x8 b1=*reinterpret_cast<const bf16x8*>(kb+d0*2048+512);
    p0=__builtin_amdgcn_mfma_f32_32x32x16_bf16(b0,qr[d0],p0,0,0,0);p1=__builtin_amdgcn_mfma_f32_32x32x16_bf16(b1,qr[d0],p1,0,0,0);}
}
typedef __attribute__((address_space(3))) const char* lds_cptr;
typedef short v4i16_t __attribute__((ext_vector_type(4))); typedef float f32x4_t __attribute__((ext_vector_type(4)));
__device__ __forceinline__ void kload8(bf16x8*kf,lds_cptr kp){
  kf[0]=*(const __attribute__((address_space(3))) bf16x8*)(kp);      kf[1]=*(const __attribute__((address_space(3))) bf16x8*)(kp+512);
  kf[2]=*(const __attribute__((address_space(3))) bf16x8*)(kp+2048); kf[3]=*(const __attribute__((address_space(3))) bf16x8*)(kp+2560);
  kf[4]=*(const __attribute__((address_space(3))) bf16x8*)(kp+4096); kf[5]=*(const __attribute__((address_space(3))) bf16x8*)(kp+4608);
  kf[6]=*(const __attribute__((address_space(3))) bf16x8*)(kp+6144); kf[7]=*(const __attribute__((address_space(3))) bf16x8*)(kp+6656);
}
__device__ __forceinline__ void kload2(bf16x8*kf,lds_cptr kp,int j){ kf[2*j]=*(const __attribute__((address_space(3))) bf16x8*)(kp+j*2048); kf[2*j+1]=*(const __attribute__((address_space(3))) bf16x8*)(kp+j*2048+512); }
__device__ __forceinline__ s16x4 vtr(lds_cptr p){ return __builtin_bit_cast(s16x4,__builtin_amdgcn_ds_read_tr16_b64_v4i16((__attribute__((address_space(3))) v4i16_t*)p)); }
__device__ __forceinline__ float rowmax(const f32x16&p0,const f32x16&p1){
  float a=max3f(p0[0],p0[1],p1[0]),b=max3f(p0[2],p0[3],p1[1]);a=max3f(a,p1[2],p1[3]);
  #pragma unroll
  for(int r=4;r<16;r+=4){a=max3f(a,p0[r],p0[r+1]);b=max3f(b,p0[r+2],p0[r+3]);a=max3f(a,p1[r],p1[r+1]);b=max3f(b,p1[r+2],p1[r+3]);}
  const float m=max2f(a,b);
  auto rr=__builtin_amdgcn_permlane32_swap(__float_as_uint(m),__float_as_uint(m),false,false);
  return max2f(__uint_as_float(rr[0]),__uint_as_float(rr[1]));
}
__device__ __forceinline__ void pv(f32x16*o,int vb,bf16x8 pa0,bf16x8 pa1,bf16x8 pa2,bf16x8 pa3){
  #pragma unroll
  for(int d0=0;d0<2;++d0){s16x4 lo[4],hi[4];
    #pragma unroll
    for(int ks=0;ks<4;++ks){
      asm volatile("ds_read_b64_tr_b16 %0,%1 offset:%c2":"=&v"(lo[ks]):"v"(vb),"i"(d0*4096+ks*1024):"memory");
      asm volatile("ds_read_b64_tr_b16 %0,%1 offset:%c2":"=&v"(hi[ks]):"v"(vb),"i"(d0*4096+ks*1024+512):"memory");}
    asm volatile("s_waitcnt lgkmcnt(0)":::"memory");SBAR();
    #define PK(k) (bf16x8){lo[k][0],lo[k][1],lo[k][2],lo[k][3],hi[k][0],hi[k][1],hi[k][2],hi[k][3]}
    o[d0]=__builtin_amdgcn_mfma_f32_32x32x16_bf16(pa0,PK(0),o[d0],0,0,0);
    o[d0]=__builtin_amdgcn_mfma_f32_32x32x16_bf16(pa1,PK(1),o[d0],0,0,0);
    o[d0]=__builtin_amdgcn_mfma_f32_32x32x16_bf16(pa2,PK(2),o[d0],0,0,0);
    o[d0]=__builtin_amdgcn_mfma_f32_32x32x16_bf16(pa3,PK(3),o[d0],0,0,0);
    #undef PK
  }
}

#ifndef ATTN_STORE16
#define ATTN_STORE16(p,v) (*(u32x4*)(p)=(v))
#endif
template<int THRL> __device__ __forceinline__ void attn_unit(int h,int qb,int tskip,const float*__restrict__ kbh,const bf16*Q,const bf16*__restrict__ K,const bf16*__restrict__ V,bf16*O,char*shm){
  int tid_=threadIdx.x; asm volatile("":"+v"(tid_));
  const int tid=tid_,lane=tid&63,r32=lane&31,hi=lane>>5; const int wid=__builtin_amdgcn_readfirstlane(tid>>6);
  const long rowbase=0; const int q0=qb*QB;
  const bf16*Qw=Q+(rowbase+q0+wid*QBLK)*DM+h*D;
  const bf16*Kh=K+(long)tskip*KVBLK*DM+h*D,*Vh=V+(long)tskip*KVBLK*DM+h*D;
  const unsigned lds0=(unsigned)(uintptr_t)shm;
  float*wsf=(float*)(shm+LDS_WS)+wid*64;
  const bf16*ksrc=Kh+(long)lane*DM+wid*8;
  const bf16*vsrc=Vh+(long)(16*(wid&3)+(lane>>2))*DM+(wid>>2)*32+(lane&3)*8;
  const unsigned kdst=lds0+LDS_K+wid*1024, vdst=lds0+LDS_V+wid*1024;
  #define DMA_K(t,slot) glds16(ksrc+(long)(t)*KVBLK*DM,(unsigned)__builtin_amdgcn_readfirstlane(kdst+(slot)))
  #define DMA_V(t,slot) glds16(vsrc+(long)(t)*KVBLK*DM,(unsigned)__builtin_amdgcn_readfirstlane(vdst+(slot)))
  const int vb0=(int)(lds0+LDS_V)+((lane>>4)&1)*32+(lane&3)*8+(4*hi+((lane&15)>>2))*64;
  const char*Kbase=shm+LDS_K; bf16x8 kf[8];
  const lds_cptr shm3=(lds_cptr)shm; const lds_cptr kp0=shm3+LDS_K+hi*1024+r32*16; const lds_cptr vp0=shm3+LDS_V+((lane>>4)&1)*32+(lane&3)*8+(4*hi+((lane&15)>>2))*64;
  const int NT=(q0+QB)/KVBLK-tskip;
  DMA_K(0,0);DMA_V(0,0);DMA_K(1,SLOTB);
  bf16x8 qr[4];
  #pragma unroll
  for(int d0=0;d0<4;++d0)qr[d0]=*reinterpret_cast<const bf16x8*>(&Qw[(long)r32*DM+d0*16+hi*8]);
  { const float*kg=kbh+(long)tskip*KVBLK; __attribute__((address_space(3))) float*kl=(__attribute__((address_space(3))) float*)(shm3+LDS_KB);
    for(int i=tid;i<NT*KVBLK;i+=NW*64)kl[i]=kg[i]; }
  const __attribute__((address_space(3))) float*kl3=(const __attribute__((address_space(3))) float*)(shm3+LDS_KB)+r32;
  bf16x8 qa=mk_qaug(0.f,hi); float kbv0,kbv1;
  float mhat=0.f,l_reg=0.f;f32x16 o[2];o[0]=f32x16{};o[1]=f32x16{};
  const int qrel=wid*QBLK+r32;
  #define CMASK(P0,P1,t) do{int jb_=(t)-(NT-4); if(jb_>=0)cmask(P0,P1,jb_,qrel,hi);}while(0)
  bool resc=false;
  #define START(P0,P1) do{ const float rm=rowmax(P0,P1); resc=false; \
    { const float dl=rm; mhat=fadd_s(mhat,dl); qa=mk_qaug(mhat,hi); \
      _Pragma("unroll") for(int r=0;r<16;++r){P0[r]=fsub_s(P0[r],dl);P1[r]=fsub_s(P1[r],dl);} \
      } \
    _Pragma("unroll") for(int r=0;r<16;++r)P0[r]=__builtin_amdgcn_exp2f(P0[r]); }while(0)
  #define RESC() do{ if(resc){ asm volatile("s_waitcnt lgkmcnt(0)":::"memory"); \
      _Pragma("unroll") for(int d_=0;d_<2;++d_) _Pragma("unroll") for(int r=0;r<16;++r)o[d_][r]*=wsf[crow(r,hi)]; } }while(0)
  f32x16 pA0,pA1,pB0,pB1;
  int sl_prev=0,sl_cur=0,sl_next=SLOTB;
  #define ROT() do{sl_prev=sl_cur;sl_cur=sl_next;sl_next=(sl_next==(NSLOT-1)*SLOTB)?0:sl_next+SLOTB;}while(0)
  DMA_K(2,2*SLOTB);
  WAIT_BAR(3);
  kbv0=kl3[0];kbv1=kl3[32];
  qkt(pA0,pA1,Kbase,qr,mk_kaug(kbv0,hi),mk_kaug(kbv1,hi),qa,r32,hi);asm volatile("s_nop 15\n\ts_nop 7":"+v"(pA0),"+v"(pA1));CMASK(pA0,pA1,0);
  kbv0=kl3[64];kbv1=kl3[96];
  START(pA0,pA1);
  _Pragma("unroll") for(int r=0;r<16;++r)pA1[r]=__builtin_amdgcn_exp2f(pA1[r]);
  WAIT_BAR(0);
  DMA_K(3,0);DMA_V(1,SLOTB);
  ROT();
  kload8(kf,kp0+sl_cur);
  WAIT_BAR(2);
  s16x4 vlo[8],vhi[8]; u32x4 pw0,pw1,pw2,pw3;
  #define PKW(P,B) cvtpk_s(P[B],P[B+1])
  #define PAF(k) __builtin_bit_cast(bf16x8,pw##k)
  #define VFR(i) (bf16x8){vlo[i][0],vlo[i][1],vlo[i][2],vlo[i][3],vhi[i][0],vhi[i][1],vhi[i][2],vhi[i][3]}
  #define PIN(x) asm volatile("":"+v"(x))
  #define MX3(a,b,c) __builtin_fmaxf(__builtin_fmaxf((a),(b)),(c))
  #define GAPA(MF,A0,A1,A2,A3,W0,W1,PW) do{ MF; sacc+=A0; sacc+=A1; sacc+=A2; sacc+=A3; PIN(sacc); W0; W1; PIN(PW); SBAR(); }while(0)
  #define EX(v) __builtin_amdgcn_exp2f(v)
  #define GAPB(MF,X,B) do{ MF; X[B]=EX(X[B]); X[B+1]=EX(X[B+1]); X[B+2]=EX(X[B+2]); X[B+3]=EX(X[B+3]); PIN(X); SBAR(); }while(0)
  #define VRD(i) do{ vlo[i]=vtr(vp_+(((i)>>2)*4096+((i)&3)*1024)); vhi[i]=vtr(vp_+(((i)>>2)*4096+((i)&3)*1024+512)); }while(0)
  #define KRD(G,j) do{ if(G){ kload2(kf,kp0+sl_next,j); SBAR(); } }while(0)
  #define STEP(C0,C1,P0,P1,t,GK,GV,GL) do{ SBAR(); \
    const lds_cptr vp_=vp0+sl_prev; \
    { const bf16x8 ka0_=mk_kaug(kbv0,hi),ka1_=mk_kaug(kbv1,hi); \
      C0=__builtin_amdgcn_mfma_f32_32x32x16_bf16(ka0_,qa,f32x16{},0,0,0); C1=__builtin_amdgcn_mfma_f32_32x32x16_bf16(ka1_,qa,f32x16{},0,0,0); \
      kbv0=kl3[((t)+1)*64]; kbv1=kl3[((t)+1)*64+32]; } SBAR(); \
    VRD(0); SBAR(); float sacc=(P0[0]+P0[1]); \
    GAPA(C0=__builtin_amdgcn_mfma_f32_32x32x16_bf16(kf[0],qr[0],C0,0,0,0), P0[2],P0[3],P0[4],P0[5],     pw0[0]=PKW(P0,0), pw0[1]=PKW(P0,2), pw0); \
    VRD(4); SBAR(); GAPA(C1=__builtin_amdgcn_mfma_f32_32x32x16_bf16(kf[1],qr[0],C1,0,0,0), P0[6],P0[7],P0[8],P0[9],     pw0[2]=PKW(P0,4), pw0[3]=PKW(P0,6), pw0); \
    VRD(1); SBAR(); GAPA(C0=__builtin_amdgcn_mfma_f32_32x32x16_bf16(kf[2],qr[1],C0,0,0,0),   P0[10],P0[11],P0[12],P0[13], pw1[0]=PKW(P0,8), pw1[1]=PKW(P0,10), pw1); \
    VRD(5); SBAR(); GAPA(C1=__builtin_amdgcn_mfma_f32_32x32x16_bf16(kf[3],qr[1],C1,0,0,0),   P0[14],P0[15],P1[0],P1[1],   pw1[2]=PKW(P0,12),pw1[3]=PKW(P0,14), pw1); \
    VRD(2); SBAR(); GAPA(C0=__builtin_amdgcn_mfma_f32_32x32x16_bf16(kf[4],qr[2],C0,0,0,0),   P1[2],P1[3],P1[4],P1[5],     pw2[0]=PKW(P1,0), pw2[1]=PKW(P1,2), pw2); \
    VRD(6); SBAR(); GAPA(C1=__builtin_amdgcn_mfma_f32_32x32x16_bf16(kf[5],qr[2],C1,0,0,0),   P1[6],P1[7],P1[8],P1[9],     pw2[2]=PKW(P1,4), pw2[3]=PKW(P1,6), pw2); \
    VRD(3); SBAR(); GAPA(C0=__builtin_amdgcn_mfma_f32_32x32x16_bf16(kf[6],qr[3],C0,0,0,0),   P1[10],P1[11],P1[12],P1[13], pw3[0]=PKW(P1,8), pw3[1]=PKW(P1,10), pw3); \
    VRD(7); SBAR(); GAPA(C1=__builtin_amdgcn_mfma_f32_32x32x16_bf16(kf[7],qr[3],C1,0,0,0),   P1[14],P1[15],0.f,0.f,       pw3[2]=PKW(P1,12),pw3[3]=PKW(P1,14), pw3); \
    l_reg+=sacc; \
    if(GK){DMA_K((t)+3,sl_cur);} if(GV){DMA_V((t)+1,sl_next);} \
    CMASK(C0,C1,t); \
    { float a=MX3(C0[0],C0[1],C1[0]),b=MX3(C0[2],C0[3],C1[1]); a=MX3(a,C1[2],C1[3]); \
      _Pragma("unroll") for(int r=4;r<16;r+=4){a=MX3(a,C0[r],C0[r+1]);b=MX3(b,C0[r+2],C0[r+3]);a=MX3(a,C1[r],C1[r+1]);b=MX3(b,C1[r+2],C1[r+3]);} \
      float rm=__builtin_fmaxf(a,b); { auto rr=__builtin_amdgcn_permlane32_swap(__float_as_uint(rm),__float_as_uint(rm),false,false); rm=__builtin_fmaxf(__uint_as_float(rr[0]),__uint_as_float(rr[1])); } \
      resc=false; \
      if(__builtin_expect(__any(rm>(float)THRL),0)){ const float dl=__builtin_fmaxf(rm,0.f); mhat+=dl; qa=mk_qaug(mhat,hi); \
        _Pragma("unroll") for(int r=0;r<16;++r){C0[r]-=dl;C1[r]-=dl;} \
        const float f=__builtin_amdgcn_exp2f(-dl); l_reg*=f; if(hi==0)wsf[r32]=f; resc=true; } } \
    SBAR(); \
    GAPB(o[0]=__builtin_amdgcn_mfma_f32_32x32x16_bf16(PAF(0),VFR(0),o[0],0,0,0), C0,0); \
    GAPB(o[1]=__builtin_amdgcn_mfma_f32_32x32x16_bf16(PAF(0),VFR(4),o[1],0,0,0), C0,4); \
    KRD(GL,0); GAPB(o[0]=__builtin_amdgcn_mfma_f32_32x32x16_bf16(PAF(1),VFR(1),o[0],0,0,0), C0,8); \
    KRD(GL,1); GAPB(o[1]=__builtin_amdgcn_mfma_f32_32x32x16_bf16(PAF(1),VFR(5),o[1],0,0,0), C0,12); \
    KRD(GL,2); GAPB(o[0]=__builtin_amdgcn_mfma_f32_32x32x16_bf16(PAF(2),VFR(2),o[0],0,0,0), C1,0); \
    KRD(GL,3); GAPB(o[1]=__builtin_amdgcn_mfma_f32_32x32x16_bf16(PAF(2),VFR(6),o[1],0,0,0), C1,4); \
    GAPB(o[0]=__builtin_amdgcn_mfma_f32_32x32x16_bf16(PAF(3),VFR(3),o[0],0,0,0), C1,8); \
    GAPB(o[1]=__builtin_amdgcn_mfma_f32_32x32x16_bf16(PAF(3),VFR(7),o[1],0,0,0), C1,12); \
    }while(0)
  int t=1;
  #undef CMASK
  #define CMASK(P0,P1,t) do{}while(0)
  for(;t+5<NT;t+=2){
    STEP(pB0,pB1,pA0,pA1,t,true,true,true);     WAIT_BAR(2); RESC(); ROT();
    STEP(pA0,pA1,pB0,pB1,t+1,true,true,true);   WAIT_BAR(2); RESC(); ROT();
  }
  #undef CMASK
  #define CMASK(P0,P1,t) do{int jb_=(t)-(NT-4); if(jb_>=0)cmask(P0,P1,jb_,qrel,hi);}while(0)
  #define ENDW(tt) do{ if((tt)+3<NT){WAIT_BAR(2);} else if((tt)+2<NT){WAIT_BAR(1);} else {WAIT_BAR(0);} }while(0)
  for(;t+1<NT;t+=2){
    STEP(pB0,pB1,pA0,pA1,t,(t+3<NT),(t+1<NT),(t+1<NT));       ENDW(t);   RESC(); ROT();
    STEP(pA0,pA1,pB0,pB1,t+1,(t+4<NT),(t+2<NT),(t+2<NT));     ENDW(t+1); RESC(); ROT();
  }
  STEP(pB0,pB1,pA0,pA1,NT-1,false,false,false); RESC();
  { float sacc=pB0[0]+pB0[1]; _Pragma("unroll") for(int r=2;r<16;++r)sacc+=pB0[r]; _Pragma("unroll") for(int r=0;r<16;++r)sacc+=pB1[r]; l_reg+=sacc;
    pw0=(u32x4){PKW(pB0,0),PKW(pB0,2),PKW(pB0,4),PKW(pB0,6)};pw1=(u32x4){PKW(pB0,8),PKW(pB0,10),PKW(pB0,12),PKW(pB0,14)};pw2=(u32x4){PKW(pB1,0),PKW(pB1,2),PKW(pB1,4),PKW(pB1,6)};pw3=(u32x4){PKW(pB1,8),PKW(pB1,10),PKW(pB1,12),PKW(pB1,14)};
    SBAR(); pv(o,vb0+sl_cur,PAF(0),PAF(1),PAF(2),PAF(3)); }
  #undef PKW
  #undef PAF
  #undef VFR
  #undef PIN
  #undef MX3
  #undef GAPA
  #undef GAPB
  #undef EX
  #undef VRD
  #undef KRD
  #undef STEP
  #undef ENDW
  {auto rr=__builtin_amdgcn_permlane32_swap(__float_as_uint(l_reg),__float_as_uint(l_reg),false,false);l_reg=__uint_as_float(rr[0])+__uint_as_float(rr[1]);}
  if(hi==0)wsf[32+r32]=l_reg;asm volatile("s_waitcnt lgkmcnt(0)":::"memory");
  float rli[16];
  #pragma unroll
  for(int r=0;r<16;++r)rli[r]=__builtin_amdgcn_rcpf(wsf[32+crow(r,hi)]);
  bf16*Ow=O+(rowbase+q0+wid*QBLK)*DM+h*D;
  { bf16*stg=(bf16*)(shm+LDS_OST)+wid*2048;
    #pragma unroll
    for(int r=0;r<16;++r){const int orow=crow(r,hi);
      #pragma unroll
      for(int d0=0;d0<2;++d0)stg[orow*64+d0*32+r32]=__float2bfloat16(o[d0][r]*rli[r]);}
    asm volatile("s_waitcnt lgkmcnt(0)":::"memory");
    #pragma unroll
    for(int i=0;i<4;++i){const int row=i*8+(lane>>3),ch=lane&7; const u32x4 v=*(const u32x4*)(stg+row*64+ch*8); ATTN_STORE16(Ow+(long)row*DM+ch*8,v);} }
  asm volatile("s_waitcnt lgkmcnt(0)\n\ts_barrier":::"memory");
  #undef DMA_K
  #undef DMA_V
  #undef CMASK
  #undef START
  #undef RESC
  #undef ROT
}
constexpr int ATTN_LDS_BYTES=LDS_BYTES;
#undef SBAR
#undef WAIT_BAR
}

constexpr int NWAVES = 8, NTHR = 512;
constexpr int DMODEL = 1024, MP = 16384, MS = 128, MTOT = MP + MS, MPAD = 16640;
constexpr int FW = 512, NINP = 5632, NIN = 5640, DFF = 2816, PAST = 4096, SKS = 4112;
constexpr float RMS_EPS = 1e-6f, LOG2E = 1.4426950408889634f, C2 = 0.125f * 1.4426950408889634f;

constexpr size_t OFF_Y = 0, OFF_YS = 16777216, OFF_PK = 16908288, OFF_PV = 25296896, OFF_PLF = 33685504, OFF_PH = 33816576, OFF_PC = 33882112,
                 OFF_SK = 33887744, OFF_SV = 33953280, OFF_SLF = 34018816, OFF_SH = 34019840, OFF_SC = 34544128, OUT_TOTAL = 34589184;
constexpr size_t MiB = 1u << 20;
constexpr size_t SZ512 = (size_t)MPAD * 512 * 2, SZ1024 = (size_t)MPAD * 1024 * 2;
constexpr size_t WS_CTL = 0, CTL_ZERO_BYTES = 1 * MiB;
constexpr size_t WS_LB = 1 * MiB, WS_KB = WS_LB + 65536, WS_SKB = WS_KB + 524288;
constexpr size_t WS_GAS = 3 * MiB, WS_GBS = WS_GAS + 524288;
constexpr size_t WS_WIN = 4 * MiB, WS_WBF = 15 * MiB, WS_WBH = 16 * MiB, WS_WOUT = 17 * MiB, WS_WUP = 19 * MiB, WS_WDN = 30 * MiB;
constexpr size_t WS_H1 = 36 * MiB;
constexpr size_t WS_Q = WS_H1 + SZ1024, WS_OH = WS_Q + SZ512, WS_K = WS_OH + SZ512, WS_V = WS_K + SZ512, WS_HQ = WS_V + SZ512, WS_KK = WS_HQ + SZ512,
                 WS_HI = WS_KK + SZ512, WS_HG = WS_HI + SZ512, WS_LF = WS_HG + SZ512, WS_END1 = WS_LF + 2 * SZ512;
constexpr size_t WS_BRF = WS_K, WS_BRH = WS_K + 4 * SZ512, WS_MERGED = WS_H1, WS_MIX = WS_K, WS_H2 = WS_H1;
constexpr size_t WS_ABUF = WS_Q, WS_GBUF = WS_ABUF + (size_t)MPAD * DFF * 2, WS_FFN = WS_Q, WS_END = WS_GBUF + (size_t)MPAD * DFF * 2;
constexpr size_t WS_SL = 232 * MiB, WS_DSEG = 248 * MiB, WS_SS = WS_H1, WS_PART = 249 * MiB;
static_assert(WS_END <= 256 * MiB && WS_END1 <= WS_SL && WS_DSEG + 131072 <= WS_PART && WS_PART + 5 * MiB <= 256 * MiB, "d_ws map");
constexpr int CW_TMO = 0, CW_CODE = 1, CW_BAR = 4096;
constexpr int RING_OFF = 0, RING_BYTES = 131072, LDSCTL_OFF = 149504, MISC_OFF = LDSCTL_OFF + 320, LDS_BYTES = 150528;
constexpr int CW_KMX = 8192, CW_QMX = CW_KMX + 128;
static_assert(attn_body::ATTN_LDS_BYTES <= LDSCTL_OFF, "attention LDS");

#define GAS __attribute__((address_space(1)))
#define LAS __attribute__((address_space(3)))
typedef unsigned short bf16;
typedef unsigned v4u __attribute__((ext_vector_type(4)));
typedef float f32x4 __attribute__((ext_vector_type(4)));
typedef short bf16x8 __attribute__((ext_vector_type(8)));
typedef GAS unsigned gu32;
typedef GAS unsigned long long gu64;
#define RLX_AGENT __ATOMIC_RELAXED, __HIP_MEMORY_SCOPE_AGENT
#define LDS_WAIT() asm volatile("s_waitcnt lgkmcnt(0)" ::: "memory")
#define VM_WAIT() asm volatile("s_waitcnt vmcnt(0)" ::: "memory")
__device__ __forceinline__ unsigned long long rt() { return __builtin_amdgcn_s_memrealtime(); }
__device__ __forceinline__ unsigned f2bf(float f) { unsigned u = __builtin_bit_cast(unsigned, f); return (u + 0x7fffu + ((u >> 16) & 1u)) >> 16; }
__device__ __forceinline__ unsigned pk2(float lo, float hi) { return f2bf(lo) | (f2bf(hi) << 16); }

#define XB_TMO      128
#define XB_XCNT(j)  (256  + 64 * (j))
#define XB_XSUB(j)  (1280 + 64 * (j))
#define XB_XGEN(j)  (2304 + 64 * (j))
#define XB_TOP      3328
#define XB_TOPGEN   3392
#define XCD_BAR_WORDS 3456
#define XB_SPIN_CAP (1u << 26)

__device__ __forceinline__ unsigned xb_ld(unsigned* p)              { return __hip_atomic_load(p, __ATOMIC_RELAXED, __HIP_MEMORY_SCOPE_AGENT); }
__device__ __forceinline__ unsigned xb_add(unsigned* p, unsigned v) { return __hip_atomic_fetch_add(p, v, __ATOMIC_RELAXED, __HIP_MEMORY_SCOPE_AGENT); }
__device__ __forceinline__ unsigned xb_xcc_id() { return (unsigned)__builtin_amdgcn_s_getreg((3 << 11) | 20) & 0xFu; }
#define XB_SPIN(cond, bar) do { unsigned _sp = 0; while (cond) { __builtin_amdgcn_s_sleep(1); \
    if ((++_sp & 255u) == 0u) { if (xb_ld(&(bar)[XB_TMO])) break; if (_sp > XB_SPIN_CAP) { atomicAdd(&(bar)[XB_TMO], 1u); break; } } } } while (0)

struct XcdBarrier {
    unsigned* bar; unsigned x;
    volatile LAS unsigned* st;
};

__device__ __forceinline__ XcdBarrier xcd_barrier_post(unsigned* bar, volatile LAS unsigned* st) {
    XcdBarrier b; b.bar = bar; b.x = xb_xcc_id(); b.st = st;
    if (threadIdx.x == 0) (void)xb_add(&bar[XB_XCNT(b.x)], 1u);
    return b;
}
__device__ __forceinline__ void xcd_barrier_complete(unsigned* bar, unsigned x, unsigned& nloc, unsigned& nx) {
    const unsigned G = gridDim.x * gridDim.y * gridDim.z;
    unsigned sum, cnt, mine, sp = 0u;
    for (;;) {
        sum = 0u; cnt = 0u; mine = 0u;
#pragma unroll
        for (unsigned j = 0; j < 16; ++j) { const unsigned c = xb_ld(&bar[XB_XCNT(j)]); sum += c; cnt += (c > 0u) ? 1u : 0u; mine = (j == x) ? c : mine; }
        if (sum == G) break;
        __builtin_amdgcn_s_sleep(1);
        if ((++sp & 255u) == 0u) { if (xb_ld(&bar[XB_TMO])) break; if (sp > XB_SPIN_CAP) { atomicAdd(&bar[XB_TMO], 1u); break; } }
    }
    nloc = mine > 0u ? mine : 1u; nx = cnt > 0u ? cnt : 1u;
}

__device__ __forceinline__ void xcd_barrier(const XcdBarrier& b) {
    asm volatile("s_waitcnt vmcnt(0)" ::: "memory");
    __syncthreads();
    if (threadIdx.x == 0) {
        unsigned* bar = b.bar;
        __builtin_amdgcn_s_waitcnt(0);
        unsigned nloc = b.st[0], nx = b.st[1];
        if (nloc == 0u) { xcd_barrier_complete(bar, b.x, nloc, nx); b.st[0] = nloc; b.st[1] = nx; }
        const unsigned old = xb_add(&bar[XB_XSUB(b.x)], 1u);
        const unsigned gen = old / nloc;
        if (old + 1u == (gen + 1u) * nloc) {
            __builtin_amdgcn_fence(__ATOMIC_RELEASE, "agent");
            asm volatile("s_waitcnt vmcnt(0)" ::: "memory");
            const unsigned og = xb_add(&bar[XB_TOP], 1u);
            const unsigned tg = og / nx;
            if (og + 1u == (tg + 1u) * nx) xb_add(&bar[XB_TOPGEN], 1u);
            else XB_SPIN(xb_ld(&bar[XB_TOPGEN]) == tg, bar);
            __builtin_amdgcn_fence(__ATOMIC_ACQUIRE, "agent");
            xb_add(&bar[XB_XGEN(b.x)], 1u);
            asm volatile("s_waitcnt vmcnt(0)" ::: "memory");
        } else {
            XB_SPIN(xb_ld(&bar[XB_XGEN(b.x)]) == gen, bar);
            __builtin_amdgcn_fence(__ATOMIC_ACQUIRE, "agent");
            asm volatile("s_waitcnt vmcnt(0)" ::: "memory");
        }
    }
    __syncthreads();
}


__device__ __forceinline__ float wave_sum(float v) {
#pragma unroll
    for (int o = 1; o < 64; o <<= 1) v += __shfl_xor(v, o);
    return v;
}
__device__ __forceinline__ float bf2f(unsigned short b) { return __builtin_bit_cast(float, (unsigned)b << 16); }
__device__ __forceinline__ float bflo(unsigned u) { return __builtin_bit_cast(float, u << 16); }
__device__ __forceinline__ float bfhi(unsigned u) { return __builtin_bit_cast(float, u & 0xffff0000u); }
__device__ __forceinline__ float sigm(float x) { return 1.0f / (1.0f + __expf(-x)); }

struct Frame {
    LAS unsigned char* lds; volatile LAS unsigned* MISC; gu32* ctl;
    int tid, lane, wave, vcu, G;
    const float *xp, *xs, *ck, *cv, *clf, *sh, *sc, *g_pre, *g_post, *w_in, *fbias, *lbl, *hgn, *w_bf, *w_bh, *w_out, *g_pre2, *g_post2, *w_up, *cw, *cb, *w_dn;
    float* out; unsigned char* ws;
};
#define WSP(T, off) ((T*)(F.ws + (off)))

__device__ __forceinline__ void tr_item(const float* W, int ldW, bf16* WT, int Kd, int k0, int nsrc0, int drow0, LAS float* scr, int lane) {
#pragma unroll 8
    for (int i = 0; i < 32; ++i) { const int kk = 2 * i + (lane >> 5); scr[kk * 33 + (lane & 31)] = W[(size_t)(k0 + kk) * ldW + nsrc0 + (lane & 31)]; }
    LDS_WAIT(); asm volatile("" ::: "memory");
    const int c = lane & 7;
#pragma unroll
    for (int j = 0; j < 4; ++j) { const int n = (lane >> 3) + 8 * j; const LAS float* s = scr + (8 * c) * 33 + n;
        v4u o; o.x = pk2(s[0 * 33], s[1 * 33]); o.y = pk2(s[2 * 33], s[3 * 33]); o.z = pk2(s[4 * 33], s[5 * 33]); o.w = pk2(s[6 * 33], s[7 * 33]);
        *(GAS v4u*)(WT + (size_t)(drow0 + n) * Kd + k0 + 8 * c) = o; }
    LDS_WAIT(); asm volatile("" ::: "memory");
}
__device__ __forceinline__ void p0_prologue(Frame& F) {
    LAS float* scr = (LAS float*)(F.lds + RING_OFF + F.wave * 16384);
    const int gw = F.vcu * NWAVES + F.wave, NGW = F.G * NWAVES;
    constexpr int I0 = 16 * 48, I1 = 16 * 128, I2 = 8 * 32, I3 = 8 * 32, I4 = 16 * 32, I5 = 16 * 176, I6 = 44 * 32, NITEMS = I0 + I1 + I2 + I3 + I4 + I5 + I6;
    for (int it = gw; it < NITEMS; it += NGW) {
        int r = it;
        if (r < I0) { const int kb = r / 48, nb = r % 48; tr_item(F.w_in, NIN, WSP(bf16, WS_WIN), 1024, 64 * kb, 32 * nb, 32 * nb, scr, F.lane); continue; } r -= I0;
        if (r < I1) { const int kb = r / 128, nb = r % 128; tr_item(F.w_in, NIN, WSP(bf16, WS_WIN), 1024, 64 * kb, 1544 + 32 * nb, 1536 + 32 * nb, scr, F.lane); continue; } r -= I1;
        if (r < I2) { const int kb = r / 32, nb = r % 32; tr_item(F.w_bf, 1024, WSP(bf16, WS_WBF), 512, 64 * kb, 32 * nb, 32 * nb, scr, F.lane); continue; } r -= I2;
        if (r < I3) { const int kb = r / 32, nb = r % 32; tr_item(F.w_bh, 1024, WSP(bf16, WS_WBH), 512, 64 * kb, 32 * nb, 32 * nb, scr, F.lane); continue; } r -= I3;
        if (r < I4) { const int kb = r / 32, nb = r % 32; tr_item(F.w_out, 1024, WSP(bf16, WS_WOUT), 1024, 64 * kb, 32 * nb, 32 * nb, scr, F.lane); continue; } r -= I4;
        if (r < I5) { const int kb = r / 176, nb = r % 176; const int drow = nb < 88 ? (nb >> 2) * 256 + (nb & 3) * 32 : ((nb - 88) >> 2) * 256 + 128 + ((nb - 88) & 3) * 32;
                      tr_item(F.w_up, 2 * DFF, WSP(bf16, WS_WUP), 1024, 64 * kb, 32 * nb, drow, scr, F.lane); continue; } r -= I5;
        { const int kb = r / 32, nb = r % 32; tr_item(F.w_dn, 1024, WSP(bf16, WS_WDN), DFF, 64 * kb, 32 * nb, 32 * nb, scr, F.lane); }
    }
    __syncthreads();
    LAS float* wf = (LAS float*)(F.lds + RING_OFF);
    for (int i = F.tid; i < 8192; i += NTHR) wf[i] = F.w_in[(size_t)(i >> 3) * NIN + 1536 + (i & 7)];
    __syncthreads();
    bf16* H1 = WSP(bf16, WS_H1);
    for (int m = gw; m < MTOT; m += NGW) {
        const float* xr = m < MP ? F.xp + (size_t)m * DMODEL : F.xs + (size_t)(m - MP) * DMODEL;
        f32x4 v[4]; float s = 0.f;
#pragma unroll
        for (int j = 0; j < 4; ++j) { v[j] = ((const GAS f32x4*)xr)[F.lane + 64 * j]; s += (v[j].x * v[j].x + v[j].y * v[j].y) + (v[j].z * v[j].z + v[j].w * v[j].w); }
        const float inv = 1.0f / sqrtf(wave_sum(s) * (1.f / DMODEL) + RMS_EPS);
        float ff[8];
#pragma unroll
        for (int i = 0; i < 8; ++i) ff[i] = 0.f;
#pragma unroll
        for (int j = 0; j < 4; ++j) { const f32x4 g = ((const GAS f32x4*)F.g_pre)[F.lane + 64 * j]; v[j] = (v[j] * inv) * g;
            GAS unsigned long long* o8 = (GAS unsigned long long*)(H1 + (size_t)m * DMODEL) + F.lane + 64 * j;
            *o8 = (unsigned long long)pk2(v[j].x, v[j].y) | ((unsigned long long)pk2(v[j].z, v[j].w) << 32);
#pragma unroll
            for (int e = 0; e < 4; ++e) { const LAS f32x4* wr = (const LAS f32x4*)(wf + (size_t)(4 * (F.lane + 64 * j) + e) * 8); const f32x4 a = wr[0], b = wr[1]; const float hv = v[j][e];
                ff[0] += hv * a.x; ff[1] += hv * a.y; ff[2] += hv * a.z; ff[3] += hv * a.w; ff[4] += hv * b.x; ff[5] += hv * b.y; ff[6] += hv * b.z; ff[7] += hv * b.w; } }
#pragma unroll
        for (int i = 0; i < 8; ++i) ff[i] = wave_sum(ff[i]);
        float mine = ff[0];
#pragma unroll
        for (int i = 1; i < 8; ++i) mine = (F.lane == i) ? ff[i] : mine;
        if (F.lane < 8) { const float xv = mine + F.fbias[F.lane]; const float ls = fminf(xv, 0.f) - log1pf(__expf(-fabsf(xv)));
            float* o = m < MP ? F.out + OFF_PLF + (size_t)m * 8 : F.out + OFF_SLF + (size_t)(m - MP) * 8; o[F.lane] = ls; }
    }
    { const int gt = F.vcu * NTHR + F.tid; const int n16 = (MPAD - MTOT) * DMODEL * 2 / 16; for (int i = gt; i < n16; i += F.G * NTHR) ((GAS v4u*)(H1 + (size_t)MTOT * DMODEL))[i] = (v4u){0u, 0u, 0u, 0u}; }
    if (blockIdx.x == 0) { float* LB = WSP(float, WS_LB); for (int c = F.tid; c < 512; c += NTHR) LB[c] = sigm(F.lbl[c] - F.lbl[512 + c]); }
}

__device__ __forceinline__ void ph_cum(Frame& F) {
    const int bid = blockIdx.x; LAS double* ld = (LAS double*)(F.lds + RING_OFF);
    if (bid == 0) {
        const float* plf = F.out + OFF_PLF; float* KB = WSP(float, WS_KB); const int h = F.tid & 7, c = F.tid >> 3;
        double s = 0.0; for (int t = 256 * c; t < 256 * c + 256; ++t) s += (double)plf[(size_t)t * 8 + h];
        ld[c * 8 + h] = s; __syncthreads();
        double run = 0.0; for (int cc = 0; cc < c; ++cc) run += ld[cc * 8 + h];
        for (int t = 256 * c; t < 256 * c + 256; ++t) { run += (double)plf[(size_t)t * 8 + h]; KB[(size_t)h * MP + t] = (float)(-run * 1.4426950408889634); }
    } else if (bid <= 8) {
        const int b = bid - 1, h = F.tid & 7, c = F.tid >> 3; const float* cl = F.clf + (size_t)b * PAST * 8; float* SKB = WSP(float, WS_SKB) + (size_t)(b * 8 + h) * SKS;
        double s = 0.0; for (int j = 64 * c; j < 64 * c + 64; ++j) s += (double)cl[(size_t)j * 8 + h];
        ld[c * 8 + h] = s; __syncthreads();
        double run = 0.0; for (int cc = c + 1; cc < 64; ++cc) run += ld[cc * 8 + h];
        for (int j = 64 * c + 63; j >= 64 * c; --j) { SKB[j] = (float)(run * 1.4426950408889634); run += (double)cl[(size_t)j * 8 + h]; }
        if (c == 0) { const float* slf = F.out + OFF_SLF + (size_t)b * 16 * 8; double r2 = 0.0; for (int i = 0; i < 16; ++i) { r2 += (double)slf[i * 8 + h]; SKB[PAST + i] = (float)(-r2 * 1.4426950408889634); } }
    }
}

__device__ __forceinline__ void ph_attn(Frame& F) {
    typedef attn_body::bf16 abf;
    const abf* Q = WSP(abf, WS_Q); const abf* K = WSP(abf, WS_K); const abf* V = WSP(abf, WS_V); abf* O = WSP(abf, WS_Q); const float* KB = WSP(float, WS_KB);
    const int c = blockIdx.x; if (c >= 256) return;
    if (F.wave == 0) {
        const unsigned* qmx = (const unsigned*)(F.ctl + CW_QMX); const unsigned* kmx = (const unsigned*)(F.ctl + CW_KMX);
        for (int ui = 0; ui < 2; ++ui) { const int id = ui == 0 ? c : 511 - c, qb = id >> 3, h = id & 7; const float* kbh = KB + (size_t)h * MP;
            const float q2 = __uint_as_float(qmx[(qb * 8 + h) * 2]) + __uint_as_float(qmx[(qb * 8 + h) * 2 + 1]), k2 = __uint_as_float(kmx[h * 2]) + __uint_as_float(kmx[h * 2 + 1]);
            const float U2 = sqrtf(q2 * k2) * 1.02f, thr = kbh[256 * qb] - 30.0f - 2.0f * U2; const int nb = 4 * qb; int tfirst = nb;
            for (int r = 0; r < 4; ++r) { const int t = 64 * r + F.lane; const bool need = (t < nb) && (kbh[64 * t + 63] >= thr); const unsigned long long mk = __ballot(need);
                if (mk) { tfirst = 64 * r + (int)__ffsll((long long)mk) - 1; break; } }
            if (F.lane == 0) F.MISC[16 + ui] = (unsigned)(tfirst & ~1); }
    }
    __syncthreads();
    for (int ui = 0; ui < 2; ++ui) { const int id = ui == 0 ? c : 511 - c, qb = id >> 3, h = id & 7; const int tskip = (int)F.MISC[16 + ui];
        attn_body::attn_unit<40>(h, qb, tskip, KB + (size_t)h * MP, Q, K, V, O, (char*)F.lds); }
}
__device__ __forceinline__ void ph_attn_naive(Frame& F) {
    const bf16* Q = WSP(bf16, WS_Q); const bf16* K = WSP(bf16, WS_K); const bf16* V = WSP(bf16, WS_V); bf16* O = WSP(bf16, WS_Q); const float* KB = WSP(float, WS_KB);
    for (int unit = blockIdx.x; unit < 256; unit += F.G) {
        const int h = unit >> 5, qb = unit & 31, qi = qb * 512 + F.tid;
        float q[64], o[64];
        { const v4u* qr = (const v4u*)(Q + (size_t)qi * 512 + h * 64);
#pragma unroll
          for (int c = 0; c < 8; ++c) { const v4u w = qr[c]; q[8 * c] = bflo(w.x); q[8 * c + 1] = bfhi(w.x); q[8 * c + 2] = bflo(w.y); q[8 * c + 3] = bfhi(w.y); q[8 * c + 4] = bflo(w.z); q[8 * c + 5] = bfhi(w.z); q[8 * c + 6] = bflo(w.w); q[8 * c + 7] = bfhi(w.w); } }
#pragma unroll
        for (int d = 0; d < 64; ++d) o[d] = 0.f;
        float m = -1e30f, l = 0.f; const int kend = qb * 512 + 511;
        for (int k = 0; k <= kend; ++k) {
            const v4u* kr = (const v4u*)(K + (size_t)k * 512 + h * 64); float s = 0.f;
#pragma unroll
            for (int c = 0; c < 8; ++c) { const v4u w = kr[c]; s += q[8 * c] * bflo(w.x) + q[8 * c + 1] * bfhi(w.x) + q[8 * c + 2] * bflo(w.y) + q[8 * c + 3] * bfhi(w.y) + q[8 * c + 4] * bflo(w.z) + q[8 * c + 5] * bfhi(w.z) + q[8 * c + 6] * bflo(w.w) + q[8 * c + 7] * bfhi(w.w); }
            s += KB[(size_t)h * MP + k];
            if (k <= qi) {
                const float mn = fmaxf(m, s), a = __builtin_amdgcn_exp2f(m - mn), p = __builtin_amdgcn_exp2f(s - mn); l = l * a + p; m = mn;
                const v4u* vr = (const v4u*)(V + (size_t)k * 512 + h * 64);
#pragma unroll
                for (int c = 0; c < 8; ++c) { const v4u w = vr[c];
                    o[8 * c] = o[8 * c] * a + p * bflo(w.x); o[8 * c + 1] = o[8 * c + 1] * a + p * bfhi(w.x); o[8 * c + 2] = o[8 * c + 2] * a + p * bflo(w.y); o[8 * c + 3] = o[8 * c + 3] * a + p * bfhi(w.y);
                    o[8 * c + 4] = o[8 * c + 4] * a + p * bflo(w.z); o[8 * c + 5] = o[8 * c + 5] * a + p * bfhi(w.z); o[8 * c + 6] = o[8 * c + 6] * a + p * bflo(w.w); o[8 * c + 7] = o[8 * c + 7] * a + p * bfhi(w.w); }
            }
        }
        const float rl = 1.0f / l; v4u* orow = (v4u*)(O + (size_t)qi * 512 + h * 64);
#pragma unroll
        for (int c = 0; c < 8; ++c) { v4u w; w.x = pk2(o[8 * c] * rl, o[8 * c + 1] * rl); w.y = pk2(o[8 * c + 2] * rl, o[8 * c + 3] * rl); w.z = pk2(o[8 * c + 4] * rl, o[8 * c + 5] * rl); w.w = pk2(o[8 * c + 6] * rl, o[8 * c + 7] * rl); orow[c] = w; }
    }
}
__device__ __forceinline__ void ph_attn_sample_naive(Frame& F) {
    const bf16* Q = WSP(bf16, WS_Q); const bf16* K = WSP(bf16, WS_K); const bf16* V = WSP(bf16, WS_V); bf16* O = WSP(bf16, WS_Q);
    const int task = blockIdx.x * NWAVES + F.wave; if (task >= 64) return;
    const int b = task >> 3, h = task & 7, qi = F.lane & 15; const size_t row = (size_t)MP + b * 16 + qi; const float* SKB = WSP(float, WS_SKB) + (size_t)(b * 8 + h) * SKS;
    float q[64], o[64];
    { const v4u* qr = (const v4u*)(Q + row * 512 + h * 64);
#pragma unroll
      for (int c = 0; c < 8; ++c) { const v4u w = qr[c]; q[8 * c] = bflo(w.x); q[8 * c + 1] = bfhi(w.x); q[8 * c + 2] = bflo(w.y); q[8 * c + 3] = bfhi(w.y); q[8 * c + 4] = bflo(w.z); q[8 * c + 5] = bfhi(w.z); q[8 * c + 6] = bflo(w.w); q[8 * c + 7] = bfhi(w.w); } }
#pragma unroll
    for (int d = 0; d < 64; ++d) o[d] = 0.f;
    float m = -1e30f, l = 0.f;
    for (int k = 0; k < PAST; ++k) {
        const f32x4* kr = (const f32x4*)(F.ck + ((size_t)(b * PAST + k) * 8 + h) * 64); float s = 0.f;
#pragma unroll
        for (int c = 0; c < 16; ++c) { const f32x4 w = kr[c]; s += q[4 * c] * w.x + q[4 * c + 1] * w.y + q[4 * c + 2] * w.z + q[4 * c + 3] * w.w; }
        s += SKB[k];
        const float mn = fmaxf(m, s), a = __builtin_amdgcn_exp2f(m - mn), p = __builtin_amdgcn_exp2f(s - mn); l = l * a + p; m = mn;
        const f32x4* vr = (const f32x4*)(F.cv + ((size_t)(b * PAST + k) * 8 + h) * 64);
#pragma unroll
        for (int c = 0; c < 16; ++c) { const f32x4 w = vr[c]; o[4 * c] = o[4 * c] * a + p * w.x; o[4 * c + 1] = o[4 * c + 1] * a + p * w.y; o[4 * c + 2] = o[4 * c + 2] * a + p * w.z; o[4 * c + 3] = o[4 * c + 3] * a + p * w.w; }
    }
    for (int i = 0; i < 16; ++i) {
        const size_t kr_ = (size_t)MP + b * 16 + i; const v4u* kr = (const v4u*)(K + kr_ * 512 + h * 64); float s = 0.f;
#pragma unroll
        for (int c = 0; c < 8; ++c) { const v4u w = kr[c]; s += q[8 * c] * bflo(w.x) + q[8 * c + 1] * bfhi(w.x) + q[8 * c + 2] * bflo(w.y) + q[8 * c + 3] * bfhi(w.y) + q[8 * c + 4] * bflo(w.z) + q[8 * c + 5] * bfhi(w.z) + q[8 * c + 6] * bflo(w.w) + q[8 * c + 7] * bfhi(w.w); }
        s += SKB[PAST + i];
        if (i <= qi) {
            const float mn = fmaxf(m, s), a = __builtin_amdgcn_exp2f(m - mn), p = __builtin_amdgcn_exp2f(s - mn); l = l * a + p; m = mn;
            const v4u* vr = (const v4u*)(V + kr_ * 512 + h * 64);
#pragma unroll
            for (int c = 0; c < 8; ++c) { const v4u w = vr[c];
                o[8 * c] = o[8 * c] * a + p * bflo(w.x); o[8 * c + 1] = o[8 * c + 1] * a + p * bfhi(w.x); o[8 * c + 2] = o[8 * c + 2] * a + p * bflo(w.y); o[8 * c + 3] = o[8 * c + 3] * a + p * bfhi(w.y);
                o[8 * c + 4] = o[8 * c + 4] * a + p * bflo(w.z); o[8 * c + 5] = o[8 * c + 5] * a + p * bfhi(w.z); o[8 * c + 6] = o[8 * c + 6] * a + p * bflo(w.w); o[8 * c + 7] = o[8 * c + 7] * a + p * bfhi(w.w); }
        }
    }
    if (F.lane < 16) { const float rl = 1.0f / l; v4u* orow = (v4u*)(O + row * 512 + h * 64);
#pragma unroll
        for (int c = 0; c < 8; ++c) { v4u w; w.x = pk2(o[8 * c] * rl, o[8 * c + 1] * rl); w.y = pk2(o[8 * c + 2] * rl, o[8 * c + 3] * rl); w.z = pk2(o[8 * c + 4] * rl, o[8 * c + 5] * rl); w.w = pk2(o[8 * c + 6] * rl, o[8 * c + 7] * rl); orow[c] = w; } }
}

__device__ __forceinline__ void hgrn_chain(Frame& F, size_t row0, int T, int h, int v, float& S0, float& S1) {
    const bf16* HQ = WSP(bf16, WS_HQ); const bf16* KK = WSP(bf16, WS_KK); const bf16* HI = WSP(bf16, WS_HI); const float* LF = WSP(float, WS_LF); bf16* OH = WSP(bf16, WS_OH);
    const int d0 = F.lane, d1 = F.lane + 64;
    for (int t = 0; t < T; ++t) {
        const size_t base = (row0 + t) * 512 + h * 128;
        const float q0 = bf2f(HQ[base + d0]), q1 = bf2f(HQ[base + d1]), k0 = bf2f(KK[base + d0]), k1 = bf2f(KK[base + d1]), l0 = LF[base + d0], l1 = LF[base + d1], iv = bf2f(HI[base + v]);
        S0 = __expf(l0) * S0 + k0 * iv; S1 = __expf(l1) * S1 + k1 * iv;
        const float p = wave_sum(q0 * S0 + q1 * S1);
        if (F.lane == 0) OH[base + v] = (bf16)f2bf(p);
    }
}
__device__ __forceinline__ void ph_hgrn_naive(Frame& F) {
    const int gw = blockIdx.x * NWAVES + F.wave, NGW = F.G * NWAVES;
    for (int task = gw; task < 4096; task += NGW) { const int bh = task >> 7, v = task & 127, b = bh >> 2, h = bh & 3;
        const float* st = F.sh + (size_t)bh * 16384; float S0 = st[(size_t)F.lane * 128 + v], S1 = st[(size_t)(F.lane + 64) * 128 + v];
        hgrn_chain(F, (size_t)MP + b * 16, 16, h, v, S0, S1);
        float* so = F.out + OFF_SH + (size_t)bh * 16384; so[(size_t)F.lane * 128 + v] = S0; so[(size_t)(F.lane + 64) * 128 + v] = S1; }
}
__device__ __forceinline__ void ph_hgnorm(Frame& F) {
    const int gw = F.vcu * NWAVES + F.wave, NGW = F.G * NWAVES; unsigned* OH = WSP(unsigned, WS_OH); const unsigned* HG = WSP(unsigned, WS_HG);
    const float g0 = F.hgn[2 * F.lane], g1 = F.hgn[2 * F.lane + 1];
    for (int task = gw; task < MS * 4; task += NGW) { const size_t idx = ((size_t)MP * 4 + task) * 64 + F.lane; const unsigned w = OH[idx], g = HG[idx];
        const float a = bflo(w), b = bfhi(w); const float inv = 1.0f / sqrtf(wave_sum(a * a + b * b) * (1.f / 128) + RMS_EPS);
        OH[idx] = pk2(a * inv * g0 * bflo(g), b * inv * g1 * bfhi(g)); }
}
__device__ __forceinline__ void ph_merge(Frame& F) {
    const float* BRF = WSP(float, WS_BRF); const float* BRH = WSP(float, WS_BRH); bf16* MG = WSP(bf16, WS_MERGED);
    const size_t n8 = (size_t)MTOT * DMODEL / 8;
    for (size_t i = (size_t)F.vcu * NTHR + F.tid; i < n8; i += (size_t)F.G * NTHR) { const size_t m = i >> 7, c = (i & 127) * 8;
        const bf16* ga = m < MP ? (const bf16*)F.out + m * DMODEL + c : WSP(bf16, WS_GAS) + (m - MP) * DMODEL + c;
        const bf16* gb = m < MP ? (const bf16*)F.out + (size_t)MP * DMODEL + m * DMODEL + c : WSP(bf16, WS_GBS) + (m - MP) * DMODEL + c;
        const v4u a = *(const v4u*)ga, b = *(const v4u*)gb; const f32x4 f0 = *(const f32x4*)(BRF + m * DMODEL + c), f1 = *(const f32x4*)(BRF + m * DMODEL + c + 4), h0 = *(const f32x4*)(BRH + m * DMODEL + c), h1 = *(const f32x4*)(BRH + m * DMODEL + c + 4);
        v4u o; o.x = pk2(bflo(a.x) * f0.x + bflo(b.x) * h0.x, bfhi(a.x) * f0.y + bfhi(b.x) * h0.y); o.y = pk2(bflo(a.y) * f0.z + bflo(b.y) * h0.z, bfhi(a.y) * f0.w + bfhi(b.y) * h0.w);
        o.z = pk2(bflo(a.z) * f1.x + bflo(b.z) * h1.x, bfhi(a.z) * f1.y + bfhi(b.z) * h1.y); o.w = pk2(bflo(a.w) * f1.z + bflo(b.w) * h1.z, bfhi(a.w) * f1.w + bfhi(b.w) * h1.w);
        *(v4u*)(MG + m * DMODEL + c) = o; }
}
__device__ __forceinline__ void ph_norm1(Frame& F) {
    const int gw = F.vcu * NWAVES + F.wave, NGW = F.G * NWAVES; const float* MIX = WSP(float, WS_MIX); bf16* H2 = WSP(bf16, WS_H2);
    for (int m = gw; m < MTOT; m += NGW) {
        const float* xr = m < MP ? F.xp + (size_t)m * DMODEL : F.xs + (size_t)(m - MP) * DMODEL; float* yr = m < MP ? F.out + OFF_Y + (size_t)m * DMODEL : F.out + OFF_YS + (size_t)(m - MP) * DMODEL;
        f32x4 v[4]; float s = 0.f;
#pragma unroll
        for (int j = 0; j < 4; ++j) { v[j] = ((const GAS f32x4*)(MIX + (size_t)m * DMODEL))[F.lane + 64 * j]; s += (v[j].x * v[j].x + v[j].y * v[j].y) + (v[j].z * v[j].z + v[j].w * v[j].w); }
        const float inv = 1.0f / sqrtf(wave_sum(s) * (1.f / DMODEL) + RMS_EPS); float s2 = 0.f;
#pragma unroll
        for (int j = 0; j < 4; ++j) { const f32x4 g = ((const GAS f32x4*)F.g_post)[F.lane + 64 * j], x = ((const GAS f32x4*)xr)[F.lane + 64 * j]; v[j] = x + (v[j] * inv) * g;
            ((GAS f32x4*)yr)[F.lane + 64 * j] = v[j]; s2 += (v[j].x * v[j].x + v[j].y * v[j].y) + (v[j].z * v[j].z + v[j].w * v[j].w); }
        const float inv2 = 1.0f / sqrtf(wave_sum(s2) * (1.f / DMODEL) + RMS_EPS);
#pragma unroll
        for (int j = 0; j < 4; ++j) { const f32x4 g = ((const GAS f32x4*)F.g_pre2)[F.lane + 64 * j]; const f32x4 hv = (v[j] * inv2) * g;
            GAS unsigned long long* o8 = (GAS unsigned long long*)(H2 + (size_t)m * DMODEL) + F.lane + 64 * j; *o8 = (unsigned long long)pk2(hv.x, hv.y) | ((unsigned long long)pk2(hv.z, hv.w) << 32); }
    }
}
__device__ __forceinline__ float gelu_tanh(float c) { const float u = 0.7978845608028654f * (c + 0.044715f * c * c * c); const float t = 1.0f - 2.0f / (__expf(2.0f * u) + 1.0f); return 0.5f * c * (1.0f + t); }
__device__ __forceinline__ void ph_conv(Frame& F) {
    const bf16* A = WSP(bf16, WS_ABUF); bf16* G = WSP(bf16, WS_GBUF); constexpr int NG = DFF / 8; const size_t n8 = (size_t)MTOT * NG;
    for (size_t i = (size_t)F.vcu * NTHR + F.tid; i < n8; i += (size_t)F.G * NTHR) { const size_t m = i / NG; const int c = (int)(i % NG) * 8;
        float a0[8], a1[8], a2[8];
        { const v4u w = *(const v4u*)(A + m * DFF + c); a0[0] = bflo(w.x); a0[1] = bfhi(w.x); a0[2] = bflo(w.y); a0[3] = bfhi(w.y); a0[4] = bflo(w.z); a0[5] = bfhi(w.z); a0[6] = bflo(w.w); a0[7] = bfhi(w.w); }
        int t, b = 0; const bool samp = m >= MP; if (samp) { t = (int)(m - MP) & 15; b = (int)(m - MP) >> 4; } else t = (int)(m < 2 ? m : 2);
        if (t >= 1) { const v4u w = *(const v4u*)(A + (m - 1) * DFF + c); a1[0] = bflo(w.x); a1[1] = bfhi(w.x); a1[2] = bflo(w.y); a1[3] = bfhi(w.y); a1[4] = bflo(w.z); a1[5] = bfhi(w.z); a1[6] = bflo(w.w); a1[7] = bfhi(w.w); }
        else {
#pragma unroll
            for (int e = 0; e < 8; ++e) a1[e] = samp ? F.sc[((size_t)b * 2 + 1) * DFF + c + e] : 0.f; }
        if (t >= 2) { const v4u w = *(const v4u*)(A + (m - 2) * DFF + c); a2[0] = bflo(w.x); a2[1] = bfhi(w.x); a2[2] = bflo(w.y); a2[3] = bfhi(w.y); a2[4] = bflo(w.z); a2[5] = bfhi(w.z); a2[6] = bflo(w.w); a2[7] = bfhi(w.w); }
        else {
#pragma unroll
            for (int e = 0; e < 8; ++e) a2[e] = samp ? F.sc[((size_t)b * 2 + t) * DFF + c + e] : 0.f; }
        const v4u gw_ = *(const v4u*)(G + m * DFF + c); float g[8] = {bflo(gw_.x), bfhi(gw_.x), bflo(gw_.y), bfhi(gw_.y), bflo(gw_.z), bfhi(gw_.z), bflo(gw_.w), bfhi(gw_.w)}; float u[8];
#pragma unroll
        for (int e = 0; e < 8; ++e) { const float cv_ = F.cb[c + e] + F.cw[c + e] * a2[e] + F.cw[DFF + c + e] * a1[e] + F.cw[2 * DFF + c + e] * a0[e]; u[e] = gelu_tanh(cv_) * g[e]; }
        v4u o; o.x = pk2(u[0], u[1]); o.y = pk2(u[2], u[3]); o.z = pk2(u[4], u[5]); o.w = pk2(u[6], u[7]); *(v4u*)(G + m * DFF + c) = o; }
}
__device__ __forceinline__ void ph_norm2(Frame& F) {
    const int gw = F.vcu * NWAVES + F.wave, NGW = F.G * NWAVES; const float* FFN = WSP(float, WS_FFN);
    for (int m = gw; m < MTOT; m += NGW) {
        float* yr = m < MP ? F.out + OFF_Y + (size_t)m * DMODEL : F.out + OFF_YS + (size_t)(m - MP) * DMODEL;
        f32x4 v[4]; float s = 0.f;
#pragma unroll
        for (int j = 0; j < 4; ++j) { v[j] = ((const GAS f32x4*)(FFN + (size_t)m * DMODEL))[F.lane + 64 * j]; s += (v[j].x * v[j].x + v[j].y * v[j].y) + (v[j].z * v[j].z + v[j].w * v[j].w); }
        const float inv = 1.0f / sqrtf(wave_sum(s) * (1.f / DMODEL) + RMS_EPS);
#pragma unroll
        for (int j = 0; j < 4; ++j) { const f32x4 g = ((const GAS f32x4*)F.g_post2)[F.lane + 64 * j]; GAS f32x4* y4 = (GAS f32x4*)yr + F.lane + 64 * j; *y4 = *y4 + (v[j] * inv) * g; }
    }
}


namespace hg {
typedef short bf16x8 __attribute__((ext_vector_type(8)));
typedef float f32x4 __attribute__((ext_vector_type(4)));
typedef unsigned u32x4 __attribute__((ext_vector_type(4)));
typedef unsigned u32x2 __attribute__((ext_vector_type(2)));
constexpr int SEGL = 256, NSEG = MP / SEGL, CH = 32, QT_OFF = 0, KH_OFF = 8704, KT_OFF = 17408, IT_OFF = 27648, DEC_OFF = 37888, BQ_OFF = 38400, RS_OFF = 40448;
typedef float f32x2 __attribute__((ext_vector_type(2))); typedef __bf16 bf16x2 __attribute__((ext_vector_type(2)));
__device__ __forceinline__ unsigned cvtpk(float lo, float hi) { const f32x2 v = {lo, hi}; return __builtin_bit_cast(unsigned, __builtin_convertvector(v, bf16x2)); }
__device__ __forceinline__ bf16x8 pack8(const f32x4 a, const f32x4 b) { const u32x4 w = {cvtpk(a[0], a[1]), cvtpk(a[2], a[3]), cvtpk(b[0], b[1]), cvtpk(b[2], b[3])}; return __builtin_bit_cast(bf16x8, w); }
#define HG_MFMA(A, B, C) __builtin_amdgcn_mfma_f32_16x16x32_bf16(A, B, C, 0, 0, 0)
template <bool OUT> __device__ __forceinline__ void hgrn_seg(Frame& F, int seg, int h) {
    const int tid = F.tid, lane = F.lane, w = F.wave, c16 = lane & 15, g = lane >> 4, v0 = 16 * w, d = tid & 127, tq = tid >> 7;
    LAS unsigned char* L = F.lds + RING_OFF;
    LAS unsigned short* QT = (LAS unsigned short*)(L + QT_OFF); LAS unsigned short* KH = (LAS unsigned short*)(L + KH_OFF);
    LAS float* DEC = (LAS float*)(L + DEC_OFF); LAS float* BQ = (LAS float*)(L + BQ_OFF); LAS float* RS = (LAS float*)(L + RS_OFF);
    const bf16* HQ = WSP(bf16, WS_HQ); const bf16* KK = WSP(bf16, WS_KK); const bf16* HI = WSP(bf16, WS_HI); const float* LF = WSP(float, WS_LF); const bf16* HG = WSP(bf16, WS_HG); bf16* OH = WSP(bf16, WS_OH);
    float* SLOT = WSP(float, OUT ? WS_SS : WS_SL) + (size_t)(seg * 4 + h) * 16384;
    f32x4 T[8];
#pragma unroll
    for (int m = 0; m < 8; ++m) {
        if (OUT) {
#pragma unroll
            for (int r = 0; r < 4; ++r) T[m][r] = SLOT[(size_t)(16 * m + 4 * g + r) * 128 + v0 + c16]; }
        else T[m] = (f32x4){0.f, 0.f, 0.f, 0.f};
    }
    float segtot = 0.f;
    for (int c = 0; c < SEGL / CH; ++c) {
        const size_t row0 = (size_t)seg * SEGL + c * CH, gb = (row0 + 8 * tq) * 512 + h * 128 + d;
        float lfv[8], cs[8], qv[8], kv[8]; unsigned short iv[8];
#pragma unroll
        for (int j = 0; j < 8; ++j) { lfv[j] = LF[gb + (size_t)j * 512]; kv[j] = bf2f(KK[gb + (size_t)j * 512]); iv[j] = HI[gb + (size_t)j * 512]; if (OUT) qv[j] = bf2f(HQ[gb + (size_t)j * 512]); }
        float run = 0.f;
#pragma unroll
        for (int j = 0; j < 8; ++j) { run += lfv[j]; cs[j] = run; }
        BQ[tq * 128 + d] = run;
        __syncthreads();
        const float q0 = BQ[d], q1 = BQ[128 + d], q2 = BQ[256 + d], q3 = BQ[384 + d];
        const float pre = (tq > 0 ? q0 : 0.f) + (tq > 1 ? q1 : 0.f) + (tq > 2 ? q2 : 0.f), tot = (q0 + q1) + (q2 + q3);
        float kt[8];
#pragma unroll
        for (int j = 0; j < 8; ++j) { const float b = pre + cs[j]; const int t = 8 * tq + j;
            if (OUT) { QT[t * 136 + d] = (unsigned short)f2bf(qv[j] * __expf(b)); KH[t * 136 + d] = (unsigned short)f2bf(kv[j] * __expf(fminf(-b, 80.f))); }
            kt[j] = kv[j] * __expf(tot - b); }
        *(LAS u32x4*)(L + KT_OFF + d * 80 + 16 * tq) = (u32x4){cvtpk(kt[0], kt[1]), cvtpk(kt[2], kt[3]), cvtpk(kt[4], kt[5]), cvtpk(kt[6], kt[7])};
        *(LAS u32x4*)(L + IT_OFF + d * 80 + 16 * tq) = (u32x4){(unsigned)iv[0] | ((unsigned)iv[1] << 16), (unsigned)iv[2] | ((unsigned)iv[3] << 16), (unsigned)iv[4] | ((unsigned)iv[5] << 16), (unsigned)iv[6] | ((unsigned)iv[7] << 16)};
        if (tq == 0) { DEC[d] = __expf(tot); segtot += tot; }
        __syncthreads();
        f32x4 O0 = {0.f, 0.f, 0.f, 0.f}, O1 = {0.f, 0.f, 0.f, 0.f};
        if (OUT) {
            f32x4 X00 = {0.f, 0.f, 0.f, 0.f}, X01 = X00, X11 = X00;
#pragma unroll
            for (int ks = 0; ks < 4; ++ks) {
                const bf16x8 ka0 = *(const LAS bf16x8*)(L + KH_OFF + c16 * 272 + (32 * ks + 8 * g) * 2), ka1 = *(const LAS bf16x8*)(L + KH_OFF + (16 + c16) * 272 + (32 * ks + 8 * g) * 2);
                const bf16x8 qb0 = *(const LAS bf16x8*)(L + QT_OFF + c16 * 272 + (32 * ks + 8 * g) * 2), qb1 = *(const LAS bf16x8*)(L + QT_OFF + (16 + c16) * 272 + (32 * ks + 8 * g) * 2);
                X00 = HG_MFMA(ka0, qb0, X00); X01 = HG_MFMA(ka0, qb1, X01); X11 = HG_MFMA(ka1, qb1, X11);
            }
#pragma unroll
            for (int r = 0; r < 4; ++r) if (4 * g + r > c16) { X00[r] = 0.f; X11[r] = 0.f; }
            const bf16x8 Bt0 = pack8(X00, (f32x4){0.f, 0.f, 0.f, 0.f}), Bt1 = pack8(X01, X11);
            { const u32x2 lo = *(const LAS u32x2*)(L + IT_OFF + (v0 + c16) * 80 + (4 * g) * 2), hi = *(const LAS u32x2*)(L + IT_OFF + (v0 + c16) * 80 + (16 + 4 * g) * 2);
              const bf16x8 itp = __builtin_bit_cast(bf16x8, (u32x4){lo.x, lo.y, hi.x, hi.y});
              O0 = HG_MFMA(itp, Bt0, O0); O1 = HG_MFMA(itp, Bt1, O1); }
#pragma unroll
            for (int ks = 0; ks < 4; ++ks) {
                const bf16x8 Afr = pack8(T[2 * ks], T[2 * ks + 1]);
                const u32x2 a0 = *(const LAS u32x2*)(L + QT_OFF + c16 * 272 + (32 * ks + 4 * g) * 2), a1 = *(const LAS u32x2*)(L + QT_OFF + c16 * 272 + (32 * ks + 16 + 4 * g) * 2);
                const u32x2 b0 = *(const LAS u32x2*)(L + QT_OFF + (16 + c16) * 272 + (32 * ks + 4 * g) * 2), b1 = *(const LAS u32x2*)(L + QT_OFF + (16 + c16) * 272 + (32 * ks + 16 + 4 * g) * 2);
                O0 = HG_MFMA(Afr, __builtin_bit_cast(bf16x8, (u32x4){a0.x, a0.y, a1.x, a1.y}), O0); O1 = HG_MFMA(Afr, __builtin_bit_cast(bf16x8, (u32x4){b0.x, b0.y, b1.x, b1.y}), O1);
            }
        }
        { const bf16x8 itn = *(const LAS bf16x8*)(L + IT_OFF + (v0 + c16) * 80 + (8 * g) * 2);
#pragma unroll
          for (int m = 0; m < 8; ++m) { const f32x4 dec = *(const LAS f32x4*)(DEC + 16 * m + 4 * g); const bf16x8 ktf = *(const LAS bf16x8*)(L + KT_OFF + (16 * m + c16) * 80 + (8 * g) * 2);
              T[m] = HG_MFMA(ktf, itn, T[m] * dec); } }
        if (OUT) {
            float s0 = (O0[0] * O0[0] + O0[1] * O0[1]) + (O0[2] * O0[2] + O0[3] * O0[3]), s1 = (O1[0] * O1[0] + O1[1] * O1[1]) + (O1[2] * O1[2] + O1[3] * O1[3]);
            s0 += __shfl_xor(s0, 16); s0 += __shfl_xor(s0, 32); s1 += __shfl_xor(s1, 16); s1 += __shfl_xor(s1, 32);
            if (g == 0) { RS[w * 32 + c16] = s0; RS[w * 32 + 16 + c16] = s1; }
        }
        __syncthreads();
        if (OUT) {
            float t0 = 0.f, t1 = 0.f;
#pragma unroll
            for (int ww = 0; ww < 8; ++ww) { t0 += RS[ww * 32 + c16]; t1 += RS[ww * 32 + 16 + c16]; }
            const float i0 = 1.0f / sqrtf(t0 * (1.f / 128) + RMS_EPS), i1 = 1.0f / sqrtf(t1 * (1.f / 128) + RMS_EPS);
            const f32x4 gn = *(const f32x4*)(F.hgn + v0 + 4 * g);
            const size_t o0 = (row0 + c16) * 512 + h * 128 + v0 + 4 * g, o1 = o0 + (size_t)16 * 512;
            const u32x2 h0 = *(const u32x2*)(HG + o0), h1 = *(const u32x2*)(HG + o1);
            u32x2 r0, r1;
            r0.x = cvtpk(O0[0] * i0 * gn[0] * bflo(h0.x), O0[1] * i0 * gn[1] * bfhi(h0.x)); r0.y = cvtpk(O0[2] * i0 * gn[2] * bflo(h0.y), O0[3] * i0 * gn[3] * bfhi(h0.y));
            r1.x = cvtpk(O1[0] * i1 * gn[0] * bflo(h1.x), O1[1] * i1 * gn[1] * bfhi(h1.x)); r1.y = cvtpk(O1[2] * i1 * gn[2] * bflo(h1.y), O1[3] * i1 * gn[3] * bfhi(h1.y));
            *(u32x2*)(OH + o0) = r0; *(u32x2*)(OH + o1) = r1;
        }
    }
    if (!OUT) {
#pragma unroll
        for (int m = 0; m < 8; ++m)
#pragma unroll
            for (int r = 0; r < 4; ++r) SLOT[(size_t)(16 * m + 4 * g + r) * 128 + v0 + c16] = T[m][r];
        if (tq == 0) WSP(float, WS_DSEG)[(size_t)seg * 512 + h * 128 + d] = __expf(segtot);
    }
    __syncthreads();
}
#undef HG_MFMA
__device__ __forceinline__ void hgrn_scan(Frame& F) {
    const int e = blockIdx.x * NTHR + F.tid; if (e >= 16384) return;
    f32x4* SL4 = WSP(f32x4, WS_SL); f32x4* SS4 = WSP(f32x4, WS_SS); const float* DS = WSP(float, WS_DSEG); const int hd = e >> 5;
    f32x4 R = {0.f, 0.f, 0.f, 0.f};
#pragma unroll 8
    for (int s = 0; s < NSEG; ++s) { const f32x4 tmp = SL4[(size_t)s * 16384 + e]; const float dd = DS[(size_t)s * 512 + hd]; SS4[(size_t)s * 16384 + e] = R; R = R * dd + tmp; }
    ((f32x4*)(F.out + OFF_PH))[e] = R;
}
}

namespace sa {
typedef short bf16x8 __attribute__((ext_vector_type(8)));
typedef float f32x4 __attribute__((ext_vector_type(4)));
typedef unsigned u32x4 __attribute__((ext_vector_type(4)));
typedef unsigned u32x2 __attribute__((ext_vector_type(2)));
typedef short s16x4 __attribute__((ext_vector_type(4)));
typedef float f32x2 __attribute__((ext_vector_type(2))); typedef __bf16 bf16x2 __attribute__((ext_vector_type(2)));
constexpr int NCH = 17, NITEM = 64 * NCH, PSTRIDE = 32 + 16 * 64, VRS = 136, WLDS = 32 * VRS;
__device__ __forceinline__ unsigned cvtpk(float lo, float hi) { const f32x2 v = {lo, hi}; return __builtin_bit_cast(unsigned, __builtin_convertvector(v, bf16x2)); }
__device__ __forceinline__ bf16x8 pk8(const f32x4 a, const f32x4 b) { const u32x4 w = {cvtpk(a[0], a[1]), cvtpk(a[2], a[3]), cvtpk(b[0], b[1]), cvtpk(b[2], b[3])}; return __builtin_bit_cast(bf16x8, w); }
__device__ __forceinline__ s16x4 vtr(const LAS unsigned char* p) { return __builtin_bit_cast(s16x4, __builtin_amdgcn_ds_read_tr16_b64_v4i16((LAS s16x4*)p)); }
#define SA_MFMA(A, B, C) __builtin_amdgcn_mfma_f32_16x16x32_bf16(A, B, C, 0, 0, 0)
__device__ __forceinline__ void sattn_item(Frame& F, int item, LAS unsigned char* wl) {
    const int lane = F.lane, c16 = lane & 15, g = lane >> 4, pair = item / NCH, c = item % NCH, b = pair >> 3, h = pair & 7;
    const bool isnew = (c == 16);
    const bf16* Qb = WSP(bf16, WS_Q); const bf16* Kb = WSP(bf16, WS_K); const bf16* Vb = WSP(bf16, WS_V); const float* SKB = WSP(float, WS_SKB) + (size_t)pair * SKS;
    const size_t nrow0 = (size_t)MP + b * 16;
    bf16x8 qf[2];
#pragma unroll
    for (int ks = 0; ks < 2; ++ks) qf[ks] = *(const bf16x8*)(Qb + (nrow0 + c16) * 512 + h * 64 + 32 * ks + 8 * g);
    float m = -1e30f, l = 0.f; f32x4 O[4];
#pragma unroll
    for (int dt = 0; dt < 4; ++dt) O[dt] = (f32x4){0.f, 0.f, 0.f, 0.f};
    const int ntile = isnew ? 1 : 8;
    f32x4 kq[8], vq[8];
#define SA_LOAD_TILE(t_) do { const int key0_ = 256 * c + 32 * (t_); \
        _Pragma("unroll") for (int hf = 0; hf < 2; ++hf) _Pragma("unroll") for (int ks = 0; ks < 2; ++ks) { const float* kr = F.ck + ((size_t)(b * PAST + key0_ + 16 * hf + c16) * 8 + h) * 64 + 32 * ks + 8 * g; \
            kq[(hf * 2 + ks) * 2] = *(const f32x4*)kr; kq[(hf * 2 + ks) * 2 + 1] = *(const f32x4*)(kr + 4); } \
        _Pragma("unroll") for (int i = 0; i < 8; ++i) { const int idx = i * 64 + lane; vq[i] = *(const f32x4*)(F.cv + ((size_t)(b * PAST + key0_ + (idx >> 4)) * 8 + h) * 64 + 4 * (idx & 15)); } } while (0)
    if (!isnew) SA_LOAD_TILE(0);
    for (int t = 0; t < ntile; ++t) {
        bf16x8 kf[2][2]; f32x4 kb0, kb1;
        if (!isnew) {
#pragma unroll
            for (int hf = 0; hf < 2; ++hf)
#pragma unroll
                for (int ks = 0; ks < 2; ++ks) kf[hf][ks] = pk8(kq[(hf * 2 + ks) * 2], kq[(hf * 2 + ks) * 2 + 1]);
#pragma unroll
            for (int i = 0; i < 8; ++i) { const int idx = i * 64 + lane; *(LAS u32x2*)(wl + (idx >> 4) * VRS + (idx & 15) * 8) = (u32x2){cvtpk(vq[i][0], vq[i][1]), cvtpk(vq[i][2], vq[i][3])}; }
            const int key0 = 256 * c + 32 * t;
            kb0 = *(const f32x4*)(SKB + key0 + 4 * g); kb1 = *(const f32x4*)(SKB + key0 + 16 + 4 * g);
            if (t + 1 < ntile) SA_LOAD_TILE(t + 1);
        } else {
#pragma unroll
            for (int ks = 0; ks < 2; ++ks) { kf[0][ks] = *(const bf16x8*)(Kb + (nrow0 + c16) * 512 + h * 64 + 32 * ks + 8 * g); kf[1][ks] = (bf16x8){0, 0, 0, 0, 0, 0, 0, 0}; }
#pragma unroll
            for (int i = 0; i < 8; ++i) { const int idx = i * 64 + lane, key = idx >> 4; u32x2 w = {0u, 0u};
                if (key < 16) w = *(const u32x2*)(Vb + (nrow0 + key) * 512 + h * 64 + 4 * (idx & 15));
                *(LAS u32x2*)(wl + key * VRS + (idx & 15) * 8) = w; }
            kb0 = *(const f32x4*)(SKB + PAST + 4 * g); kb1 = (f32x4){0.f, 0.f, 0.f, 0.f};
        }
        f32x4 S0 = {0.f, 0.f, 0.f, 0.f}, S1 = S0;
        S0 = SA_MFMA(kf[0][0], qf[0], S0); S0 = SA_MFMA(kf[0][1], qf[1], S0); S1 = SA_MFMA(kf[1][0], qf[0], S1); S1 = SA_MFMA(kf[1][1], qf[1], S1);
        S0 = S0 + kb0; S1 = S1 + kb1;
        if (isnew) {
#pragma unroll
            for (int r = 0; r < 4; ++r) { if (4 * g + r > c16) S0[r] = -1e30f; S1[r] = -1e30f; }
        }
        float mx = fmaxf(fmaxf(fmaxf(S0[0], S0[1]), fmaxf(S0[2], S0[3])), fmaxf(fmaxf(S1[0], S1[1]), fmaxf(S1[2], S1[3])));
        mx = fmaxf(mx, __shfl_xor(mx, 16)); mx = fmaxf(mx, __shfl_xor(mx, 32));
        const float mn = fmaxf(m, mx), a = __builtin_amdgcn_exp2f(m - mn); m = mn;
        f32x4 p0, p1;
#pragma unroll
        for (int r = 0; r < 4; ++r) { p0[r] = __builtin_amdgcn_exp2f(S0[r] - mn); p1[r] = __builtin_amdgcn_exp2f(S1[r] - mn); }
        float rs = ((p0[0] + p0[1]) + (p0[2] + p0[3])) + ((p1[0] + p1[1]) + (p1[2] + p1[3]));
        rs += __shfl_xor(rs, 16); rs += __shfl_xor(rs, 32); l = l * a + rs;
        const bf16x8 pf = pk8(p0, p1);
        float ar[4];
#pragma unroll
        for (int r = 0; r < 4; ++r) ar[r] = __shfl(a, 4 * g + r);
#pragma unroll
        for (int dt = 0; dt < 4; ++dt) {
            const s16x4 lo = vtr(wl + (4 * g + (c16 >> 2)) * VRS + (16 * dt + 4 * (c16 & 3)) * 2), hi = vtr(wl + (16 + 4 * g + (c16 >> 2)) * VRS + (16 * dt + 4 * (c16 & 3)) * 2);
            const bf16x8 vf = {lo[0], lo[1], lo[2], lo[3], hi[0], hi[1], hi[2], hi[3]};
            f32x4 o = O[dt];
#pragma unroll
            for (int r = 0; r < 4; ++r) o[r] *= ar[r];
            O[dt] = SA_MFMA(pf, vf, o);
        }
    }
    float* P = WSP(float, WS_PART) + (size_t)item * PSTRIDE;
    if (g == 0) { P[c16] = m; P[16 + c16] = l; }
#pragma unroll
    for (int dt = 0; dt < 4; ++dt)
#pragma unroll
        for (int r = 0; r < 4; ++r) P[32 + (4 * g + r) * 64 + 16 * dt + c16] = O[dt][r];
}
#undef SA_MFMA
#undef SA_LOAD_TILE
__device__ __forceinline__ void sattn_phase(Frame& F) {
    LAS unsigned char* wl = F.lds + RING_OFF + 65536 + F.wave * WLDS;
    for (int item = blockIdx.x * NWAVES + F.wave; item < NITEM; item += F.G * NWAVES) sattn_item(F, item, wl);
}
__device__ __forceinline__ void sattn_combine(Frame& F) {
    bf16* O = WSP(bf16, WS_Q); const float* PART = WSP(float, WS_PART);
    for (int task = blockIdx.x * NWAVES + F.wave; task < 1024; task += F.G * NWAVES) { const int pair = task >> 4, q = task & 15, b = pair >> 3, h = pair & 7;
        float M = -1e30f;
        for (int c = 0; c < NCH; ++c) M = fmaxf(M, PART[(size_t)(pair * NCH + c) * PSTRIDE + q]);
        float L = 0.f, o = 0.f;
        for (int c = 0; c < NCH; ++c) { const float* P = PART + (size_t)(pair * NCH + c) * PSTRIDE; const float wgt = __builtin_amdgcn_exp2f(P[q] - M); L += P[16 + q] * wgt; o += P[32 + q * 64 + F.lane] * wgt; }
        O[((size_t)MP + b * 16 + q) * 512 + h * 64 + F.lane] = (bf16)f2bf(o / L); }
}
}

struct Args { const float* in[22]; float* out; unsigned char* ws; int ph_lo, ph_hi, li, pad; };
constexpr int NPHASE = 15;
__global__ void __launch_bounds__(NTHR, 2) skel_fwd(Args args) {
    extern __shared__ __attribute__((aligned(16))) unsigned char lds[];
    Frame F;
    F.lds = (LAS unsigned char*)lds; F.MISC = (volatile LAS unsigned*)(F.lds + MISC_OFF);
    F.tid = threadIdx.x; F.lane = F.tid & 63; F.wave = __builtin_amdgcn_readfirstlane(F.tid >> 6);
    F.G = gridDim.x; { const int bx = blockIdx.x; F.vcu = (F.G % 8 == 0) ? (bx % 8) * (F.G / 8) + bx / 8 : bx; }
    F.ws = args.ws; F.out = args.out; F.ctl = (gu32*)(args.ws + WS_CTL);
    F.xp = args.in[0]; F.xs = args.in[1]; F.ck = args.in[2]; F.cv = args.in[3]; F.clf = args.in[4]; F.sh = args.in[5]; F.sc = args.in[6]; F.g_pre = args.in[7]; F.g_post = args.in[8];
    F.w_in = args.in[9]; F.fbias = args.in[10]; F.lbl = args.in[11]; F.hgn = args.in[12]; F.w_bf = args.in[13]; F.w_bh = args.in[14]; F.w_out = args.in[15]; F.g_pre2 = args.in[16]; F.g_post2 = args.in[17];
    F.w_up = args.in[18]; F.cw = args.in[19]; F.cb = args.in[20]; F.w_dn = args.in[21];
    for (int u = F.tid; u < (LDS_BYTES - LDSCTL_OFF) / 4; u += NTHR) ((LAS unsigned*)(F.lds + LDSCTL_OFF))[u] = 0u;
    __syncthreads();
    XcdBarrier bar = xcd_barrier_post((unsigned*)(F.ctl + CW_BAR), F.MISC + 8);
    const int lo = args.ph_lo, hi = args.ph_hi;
#define IN(k) (lo <= (k) && (k) < hi)
#define SEAM(k) do { if (IN(k) && IN((k) + 1)) xcd_barrier(bar); } while (0)
    typedef pg8::bf16_t pbf;
    if (IN(0)) p0_prologue(F);
    SEAM(0);
    if (IN(1)) ph_cum(F);
    SEAM(1);
    if (IN(2)) {
        pg8::Gemm g{WSP(pbf, WS_H1), WSP(pbf, WS_WIN), MPAD, NINP, DMODEL}; pg8::StaticOrder S; S.init(MPAD, NINP, F.G, (int)blockIdx.x);
        pg8::EpiIn E{WSP(pbf, WS_Q), WSP(pbf, WS_K), WSP(pbf, WS_V), WSP(pbf, WS_HQ), WSP(pbf, WS_KK), WSP(pbf, WS_HI), WSP(pbf, WS_HG), WSP(float, WS_LF),
                     (pbf*)F.out, (pbf*)F.out + (size_t)MP * DMODEL, WSP(pbf, WS_GAS), WSP(pbf, WS_GBS), F.out + OFF_PK, F.out + OFF_PV, F.out + OFF_SK, F.out + OFF_SV, WSP(float, WS_LB), (unsigned*)(F.ctl + CW_KMX)};
        pg8::gemm_phase<pg8::EpiIn, pg8::StaticOrder, true, true>(F.lds + RING_OFF, g, S, E);
    }
    SEAM(2);
    if (IN(3)) { sa::sattn_phase(F); __syncthreads(); if (blockIdx.x < 256) hg::hgrn_seg<false>(F, blockIdx.x >> 2, blockIdx.x & 3); ph_attn(F); }
    SEAM(3);
    if (IN(4)) { sa::sattn_combine(F); hg::hgrn_scan(F); ph_hgrn_naive(F); }
    SEAM(4);
    if (IN(5)) { if (blockIdx.x < 256) hg::hgrn_seg<true>(F, blockIdx.x >> 2, blockIdx.x & 3); ph_hgnorm(F); }
    SEAM(5);
    if (IN(6)) { pg8::Gemm g{WSP(pbf, WS_Q), WSP(pbf, WS_WBF), MPAD, DMODEL, 512}; pg8::StaticOrder S; S.init(MPAD, DMODEL, F.G, (int)blockIdx.x); pg8::EpiF32 E{WSP(float, WS_BRF), DMODEL};
                 pg8::gemm_phase<pg8::EpiF32, pg8::StaticOrder, true, true>(F.lds + RING_OFF, g, S, E); }
    SEAM(6);
    if (IN(7)) { pg8::Gemm g{WSP(pbf, WS_OH), WSP(pbf, WS_WBH), MPAD, DMODEL, 512}; pg8::StaticOrder S; S.init(MPAD, DMODEL, F.G, (int)blockIdx.x); pg8::EpiF32 E{WSP(float, WS_BRH), DMODEL};
                 pg8::gemm_phase<pg8::EpiF32, pg8::StaticOrder, true, true>(F.lds + RING_OFF, g, S, E); }
    SEAM(7);
    if (IN(8)) ph_merge(F);
    SEAM(8);
    if (IN(9)) { pg8::Gemm g{WSP(pbf, WS_MERGED), WSP(pbf, WS_WOUT), MPAD, DMODEL, DMODEL}; pg8::StaticOrder S; S.init(MPAD, DMODEL, F.G, (int)blockIdx.x); pg8::EpiF32 E{WSP(float, WS_MIX), DMODEL};
                 pg8::gemm_phase<pg8::EpiF32, pg8::StaticOrder, true, true>(F.lds + RING_OFF, g, S, E); }
    SEAM(9);
    if (IN(10)) ph_norm1(F);
    SEAM(10);
    if (IN(11)) { pg8::Gemm g{WSP(pbf, WS_H2), WSP(pbf, WS_WUP), MPAD, 2 * DFF, DMODEL}; pg8::StaticOrder S; S.init(MPAD, 2 * DFF, F.G, (int)blockIdx.x);
                  pg8::EpiUpSplit E{WSP(pbf, WS_ABUF), WSP(pbf, WS_GBUF), F.out + OFF_PC, F.out + OFF_SC};
                  pg8::gemm_phase<pg8::EpiUpSplit, pg8::StaticOrder, true, true>(F.lds + RING_OFF, g, S, E); }
    SEAM(11);
    if (IN(12)) ph_conv(F);
    SEAM(12);
    if (IN(13)) { pg8::Gemm g{WSP(pbf, WS_GBUF), WSP(pbf, WS_WDN), MPAD, DMODEL, DFF}; pg8::StaticOrder S; S.init(MPAD, DMODEL, F.G, (int)blockIdx.x); pg8::EpiF32 E{WSP(float, WS_FFN), DMODEL};
                  pg8::gemm_phase<pg8::EpiF32, pg8::StaticOrder, true, true>(F.lds + RING_OFF, g, S, E); }
    SEAM(13);
    if (IN(14)) ph_norm2(F);
#undef IN
}

extern "C" void kernel_launch(void* const* d_in, const int* in_sizes, int n_in, void* d_out, int out_size, void* d_ws, size_t ws_size, hipStream_t stream) {
    static int grid = 0;
    if (grid == 0) {
        if (n_in != 22 || out_size != (int)OUT_TOTAL || ws_size < WS_END) { fprintf(stderr, "kernel_launch: unexpected shapes (n_in %d out %d ws %zu)\n", n_in, out_size, ws_size); grid = -1; return; }
        if (hipFuncSetAttribute((const void*)skel_fwd, hipFuncAttributeMaxDynamicSharedMemorySize, LDS_BYTES) != hipSuccess) { fprintf(stderr, "kernel_launch: hipFuncSetAttribute failed\n"); grid = -1; return; }
        grid = 256;
    }
    if (grid < 0) return;
    (void)hipMemsetAsync((char*)d_ws + WS_CTL, 0, CTL_ZERO_BYTES, stream);
    Args a{};
    for (int i = 0; i < 22; ++i) a.in[i] = (const float*)d_in[i];
    a.out = (float*)d_out; a.ws = (unsigned char*)d_ws;
    a.ph_lo = 0; a.ph_hi = NPHASE; a.li = 0; hipLaunchKernelGGL(skel_fwd, dim3(grid), dim3(NTHR), LDS_BYTES, stream, a);
}
```
